# Optimizing an MI355X kernel written in HIP

```python
import math
import jax, jax.numpy as jnp
from jax import lax
import numpy as np

D_MODEL = 1024
BATCH = 2
SEQ = 8192
DEPTH = 2

GRID_W = 64
CTX_LEN = 256
D_MIX = D_MODEL
GROUP_W = D_MIX // 4
HEAD_DIM = 64
NA_HEADS = GROUP_W // HEAD_DIM
NA_WIN_ROWS = 8
NA_WIN_COLS = 16
CONV_CH = GROUP_W
CONV_K = 31
GQA_Q_HEADS = GROUP_W // HEAD_DIM
GQA_KV_HEADS = GQA_Q_HEADS // 2
DIFF_HEADS = 4
DIFF_QK_DIM = GROUP_W // (2 * DIFF_HEADS)
DIFF_V_DIM = 2 * DIFF_QK_DIM
N_EXPERTS = 16
D_EXPERT = D_MODEL
EC_CAPACITY_FACTOR = 2

Q_BLOCK = 128
ROPE_BASE = 10000.0
EPS = 1e-6

IN_SPLITS = (
    NA_HEADS * HEAD_DIM, NA_HEADS * HEAD_DIM, NA_HEADS * HEAD_DIM,
    2 * CONV_CH,
    GQA_Q_HEADS * HEAD_DIM, GQA_KV_HEADS * HEAD_DIM, GQA_KV_HEADS * HEAD_DIM,
    2 * DIFF_HEADS * DIFF_QK_DIM, 2 * DIFF_HEADS * DIFF_QK_DIM, DIFF_HEADS * DIFF_V_DIM,
)
D_IN = sum(IN_SPLITS)
IN_OFFSETS = tuple(int(v) for v in np.cumsum(IN_SPLITS)[:-1])

kernel_name = "hybrid_parallel_group_diffusion_block"


def rms_norm(x, g):
    xf = x.astype(jnp.float32)
    y = xf * lax.rsqrt(jnp.mean(xf * xf, axis=-1, keepdims=True) + EPS)
    return (y * g.astype(jnp.float32)).astype(x.dtype)


def layer_norm(x, g, b):
    xf = x.astype(jnp.float32)
    mu = jnp.mean(xf, axis=-1, keepdims=True)
    xc = xf - mu
    y = xc * lax.rsqrt(jnp.mean(xc * xc, axis=-1, keepdims=True) + EPS)
    return (y * g.astype(jnp.float32) + b.astype(jnp.float32)).astype(x.dtype)


def softmax_f32(s):
    return jax.nn.softmax(s.astype(jnp.float32), axis=-1)


def axial_rope(x, rows, cols):
    d = x.shape[-1]
    half = d // 2
    nf = half // 2
    inv = 1.0 / (ROPE_BASE ** (jnp.arange(nf, dtype=jnp.float32) / nf))
    ang = jnp.concatenate([rows[:, None] * inv, cols[:, None] * inv], axis=-1)
    cos = jnp.cos(ang)[None, :, None, :]
    sin = jnp.sin(ang)[None, :, None, :]
    xf = x.astype(jnp.float32)
    x1, x2 = xf[..., :half], xf[..., half:]
    return jnp.concatenate([x1 * cos - x2 * sin, x2 * cos + x1 * sin], axis=-1).astype(x.dtype)


def block_sweep(fn, *qs):
    B, S = qs[0].shape[:2]
    nb = S // Q_BLOCK
    blocks = tuple(jnp.swapaxes(q.reshape(B, nb, Q_BLOCK, *q.shape[2:]), 0, 1) for q in qs)
    out = lax.map(lambda bs: fn(*bs), blocks)
    return jnp.swapaxes(out, 0, 1).reshape(B, S, *out.shape[3:])


def mha(q, k, v, scale):
    s = jnp.einsum('bqhd,bkhd->bhqk', q, k) * scale
    p = softmax_f32(s).astype(v.dtype)
    return jnp.einsum('bhqk,bkhd->bqhd', p, v)


def neighborhood_attention(q, k, v, qc, kc, vc, rpb, need_ctx):
    B, S, H, d = q.shape
    R = S // GRID_W
    KH = min(NA_WIN_ROWS, R)
    scale = d ** -0.5
    r = jnp.arange(R)
    row_idx = jnp.clip(r - KH // 2, 0, R - KH)[:, None] + jnp.arange(KH)[None, :]
    j = jnp.arange(GRID_W)
    col_start = jnp.clip(j - NA_WIN_COLS // 2, 0, GRID_W - NA_WIN_COLS)
    col_valid = (j[None, :] >= col_start[:, None]) & (j[None, :] < col_start[:, None] + NA_WIN_COLS)
    dr = row_idx - r[:, None] + NA_WIN_ROWS - 1
    dc = jnp.clip(j[None, :] - j[:, None], -(NA_WIN_COLS - 1), NA_WIN_COLS - 1) + NA_WIN_COLS - 1
    bias = rpb[:, dr[:, None, :, None], dc[None, :, None, :]].astype(jnp.float32)
    bias = jnp.where(col_valid[None, None, :, None, :], bias, -jnp.inf)
    qg = q.reshape(B, R, GRID_W, H, d)
    kg = k.reshape(B, R, GRID_W, H, d)[:, row_idx]
    vg = v.reshape(B, R, GRID_W, H, d)[:, row_idx]
    s_win = jnp.einsum('brqhd,brkwhd->bhrqkw', qg, kg).astype(jnp.float32) * scale + bias[None]
    s_ctx = jnp.einsum('brqhd,bchd->bhrqc', qg, kc).astype(jnp.float32) * scale
    nwin = KH * GRID_W
    s = jnp.concatenate([s_win.reshape(B, H, R, GRID_W, nwin), s_ctx], axis=-1)
    p = softmax_f32(s).astype(v.dtype)
    p_win = p[..., :nwin].reshape(B, H, R, GRID_W, KH, GRID_W)
    p_ctx = p[..., nwin:]
    o = jnp.einsum('bhrqkw,brkwhd->brqhd', p_win, vg) + jnp.einsum('bhrqc,bchd->brqhd', p_ctx, vc)
    o_lat = o.reshape(B, S, H * d)
    o_ctx = mha(qc, kc, vc, scale).reshape(B, qc.shape[1], H * d) if need_ctx else None
    return o_lat, o_ctx


def conformer_conv(u, dw_w, dw_b, ln_g, ln_b, pw_w, pw_b):
    a, g = jnp.split(u, 2, axis=-1)
    z = a * jax.nn.sigmoid(g)
    z = lax.conv_general_dilated(
        z, dw_w[:, None, :], window_strides=(1,), padding=((CONV_K // 2, CONV_K // 2),),
        dimension_numbers=('NWC', 'WIO', 'NWC'), feature_group_count=CONV_CH) + dw_b
    z = jax.nn.silu(layer_norm(z, ln_g, ln_b))
    return z @ pw_w + pw_b


def gqa_attention(q, k, v, qc, kc, vc, qn_g, kn_g, rows, cols, need_ctx):
    B, S, Hq, d = q.shape
    G = Hq // GQA_KV_HEADS
    scale = d ** -0.5
    q = axial_rope(rms_norm(q, qn_g), rows, cols)
    k = axial_rope(rms_norm(k, kn_g), rows, cols)
    qc = rms_norm(qc, qn_g)
    kc = rms_norm(kc, kn_g)
    k_all = jnp.concatenate([kc, k], axis=1)
    v_all = jnp.concatenate([vc, v], axis=1)

    def attend(qb, kk, vv):
        Bq, Lq = qb.shape[:2]
        qb = qb.reshape(Bq, Lq, GQA_KV_HEADS, G, d)
        s = jnp.einsum('bqkgd,bskd->bkgqs', qb, kk) * scale
        p = softmax_f32(s).astype(vv.dtype)
        return jnp.einsum('bkgqs,bskd->bqkgd', p, vv).reshape(Bq, Lq, Hq * d)

    o_lat = block_sweep(lambda qb: attend(qb, k_all, v_all), q)
    o_ctx = attend(qc, kc, vc) if need_ctx else None
    return o_lat, o_ctx


def diff_attention(q1, q2, k1, k2, v, q1c, q2c, k1c, k2c, vc, lam, lam_init, dn_g, rows, cols, need_ctx):
    B, S, H, dq = q1.shape
    scale = dq ** -0.5
    q1, q2 = axial_rope(q1, rows, cols), axial_rope(q2, rows, cols)
    k1a = jnp.concatenate([k1c, axial_rope(k1, rows, cols)], axis=1)
    k2a = jnp.concatenate([k2c, axial_rope(k2, rows, cols)], axis=1)
    va = jnp.concatenate([vc, v], axis=1)

    def attend(q1b, q2b, kk1, kk2, vv):
        Bq, Lq = q1b.shape[:2]
        p1 = softmax_f32(jnp.einsum('bqhd,bshd->bhqs', q1b, kk1) * scale)
        p2 = softmax_f32(jnp.einsum('bqhd,bshd->bhqs', q2b, kk2) * scale)
        p = (p1 - lam * p2).astype(vv.dtype)
        o = jnp.einsum('bhqs,bshd->bqhd', p, vv)
        o = rms_norm(o, dn_g) * (1.0 - lam_init)
        return o.reshape(Bq, Lq, H * vv.shape[-1])

    o_lat = block_sweep(lambda a, b: attend(a, b, k1a, k2a, va), q1, q2)
    o_ctx = attend(q1c, q2c, k1c, k2c, vc) if need_ctx else None
    return o_lat, o_ctx


def token_mixers(u, uc, w_in, rpb, dw_w, dw_b, ln_g, ln_b, pw_w, pw_b, qn_g, kn_g,
                 lq1, lk1, lq2, lk2, dn_g, lam_init, rows, cols, need_ctx):
    B, S, _ = u.shape
    Lc = uc.shape[1]
    p = jnp.split(u @ w_in, IN_OFFSETS, axis=-1)
    pc = jnp.split(uc @ w_in, IN_OFFSETS, axis=-1)
    oa, oca = neighborhood_attention(
        p[0].reshape(B, S, NA_HEADS, HEAD_DIM), p[1].reshape(B, S, NA_HEADS, HEAD_DIM),
        p[2].reshape(B, S, NA_HEADS, HEAD_DIM), pc[0].reshape(B, Lc, NA_HEADS, HEAD_DIM),
        pc[1].reshape(B, Lc, NA_HEADS, HEAD_DIM), pc[2].reshape(B, Lc, NA_HEADS, HEAD_DIM), rpb, need_ctx)
    ob = conformer_conv(p[3], dw_w, dw_b, ln_g, ln_b, pw_w, pw_b)
    ocb = conformer_conv(pc[3], dw_w, dw_b, ln_g, ln_b, pw_w, pw_b) if need_ctx else None
    oc_, occ = gqa_attention(
        p[4].reshape(B, S, GQA_Q_HEADS, HEAD_DIM), p[5].reshape(B, S, GQA_KV_HEADS, HEAD_DIM),
        p[6].reshape(B, S, GQA_KV_HEADS, HEAD_DIM), pc[4].reshape(B, Lc, GQA_Q_HEADS, HEAD_DIM),
        pc[5].reshape(B, Lc, GQA_KV_HEADS, HEAD_DIM), pc[6].reshape(B, Lc, GQA_KV_HEADS, HEAD_DIM),
        qn_g, kn_g, rows, cols, need_ctx)
    qd = p[7].reshape(B, S, DIFF_HEADS, 2, DIFF_QK_DIM)
    kd = p[8].reshape(B, S, DIFF_HEADS, 2, DIFF_QK_DIM)
    qdc = pc[7].reshape(B, Lc, DIFF_HEADS, 2, DIFF_QK_DIM)
    kdc = pc[8].reshape(B, Lc, DIFF_HEADS, 2, DIFF_QK_DIM)
    lam = (jnp.exp(jnp.sum(lq1.astype(jnp.float32) * lk1.astype(jnp.float32)))
           - jnp.exp(jnp.sum(lq2.astype(jnp.float32) * lk2.astype(jnp.float32))) + lam_init)
    od, ocd = diff_attention(
        qd[..., 0, :], qd[..., 1, :], kd[..., 0, :], kd[..., 1, :], p[9].reshape(B, S, DIFF_HEADS, DIFF_V_DIM),
        qdc[..., 0, :], qdc[..., 1, :], kdc[..., 0, :], kdc[..., 1, :], pc[9].reshape(B, Lc, DIFF_HEADS, DIFF_V_DIM),
        lam, lam_init, dn_g, rows, cols, need_ctx)
    y = jnp.concatenate([oa, ob, oc_, od], axis=-1)
    yc = jnp.concatenate([oca, ocb, occ, ocd], axis=-1) if need_ctx else None
    return y, yc


def expert_choice_ffn(h, w_router, w_gate, w_up, w_down):
    B, N, D = h.shape
    cap = EC_CAPACITY_FACTOR * N // N_EXPERTS
    aff = softmax_f32(jnp.einsum('bnd,de->bne', h, w_router))
    g, idx = lax.top_k(jnp.swapaxes(aff, 1, 2), cap)
    bi = jnp.arange(B)[:, None, None]
    xe = h[bi, idx]
    a = jnp.einsum('becd,edf->becf', xe, w_gate)
    up = jnp.einsum('becd,edf->becf', xe, w_up)
    y = jnp.einsum('becf,efd->becd', jax.nn.silu(a) * up, w_down)
    y = y * g[..., None].astype(y.dtype)
    return jnp.zeros_like(h).at[bi, idx].add(y)


def setup_inputs(seed: int = 0) -> dict:
    key = jax.random.key(seed)
    ks = jax.random.split(key, 32)
    f32 = jnp.float32
    L = DEPTH

    def nrm(k, shape, scale):
        return jax.random.normal(k, shape, f32) * scale

    return {
        "x": nrm(ks[0], (BATCH, SEQ, D_MODEL), 1.0),
        "c": nrm(ks[1], (BATCH, D_MODEL), 1.0),
        "ctx": nrm(ks[2], (BATCH, CTX_LEN, D_MODEL), 1.0),
        "c_ctx": nrm(ks[3], (D_MODEL,), 1.0),
        "norm1_g": 1.0 + nrm(ks[4], (L, D_MODEL), 0.05),
        "w_mod": nrm(ks[5], (L, D_MODEL, 6 * D_MODEL), 0.5 * D_MODEL ** -0.5),
        "b_mod": nrm(ks[6], (L, 6 * D_MODEL), 0.02),
        "w_in": nrm(ks[7], (L, D_MODEL, D_IN), D_MODEL ** -0.5),
        "na_rpb": nrm(ks[8], (L, NA_HEADS, 2 * NA_WIN_ROWS - 1, 2 * NA_WIN_COLS - 1), 0.1),
        "conv_dw_w": nrm(ks[9], (L, CONV_K, CONV_CH), CONV_K ** -0.5),
        "conv_dw_b": nrm(ks[10], (L, CONV_CH), 0.02),
        "conv_ln_g": 1.0 + nrm(ks[11], (L, CONV_CH), 0.05),
        "conv_ln_b": nrm(ks[12], (L, CONV_CH), 0.02),
        "conv_pw_w": nrm(ks[13], (L, CONV_CH, CONV_CH), CONV_CH ** -0.5),
        "conv_pw_b": nrm(ks[14], (L, CONV_CH), 0.02),
        "gqa_qn_g": 1.0 + nrm(ks[15], (L, HEAD_DIM), 0.05),
        "gqa_kn_g": 1.0 + nrm(ks[16], (L, HEAD_DIM), 0.05),
        "diff_lq1": nrm(ks[17], (L, DIFF_QK_DIM), 0.1),
        "diff_lk1": nrm(ks[18], (L, DIFF_QK_DIM), 0.1),
        "diff_lq2": nrm(ks[19], (L, DIFF_QK_DIM), 0.1),
        "diff_lk2": nrm(ks[20], (L, DIFF_QK_DIM), 0.1),
        "diff_norm_g": 1.0 + nrm(ks[21], (L, DIFF_V_DIM), 0.05),
        "w_out": nrm(ks[22], (L, D_MIX, D_MODEL), D_MIX ** -0.5),
        "norm2_g": 1.0 + nrm(ks[23], (L, D_MODEL), 0.05),
        "w_router": nrm(ks[24], (L, D_MODEL, N_EXPERTS), D_MODEL ** -0.5),
        "w_gate": nrm(ks[25], (L, N_EXPERTS, D_MODEL, D_EXPERT), D_MODEL ** -0.5),
        "w_up": nrm(ks[26], (L, N_EXPERTS, D_MODEL, D_EXPERT), D_MODEL ** -0.5),
        "w_down": nrm(ks[27], (L, N_EXPERTS, D_EXPERT, D_MODEL), D_EXPERT ** -0.5),
        "final_g": 1.0 + nrm(ks[28], (D_MODEL,), 0.05),
    }


def reference(x, c, ctx, c_ctx, norm1_g, w_mod, b_mod, w_in, na_rpb, conv_dw_w, conv_dw_b, conv_ln_g,
              conv_ln_b, conv_pw_w, conv_pw_b, gqa_qn_g, gqa_kn_g, diff_lq1, diff_lk1, diff_lq2, diff_lk2,
              diff_norm_g, w_out, norm2_g, w_router, w_gate, w_up, w_down, final_g):
    B, S, D = x.shape
    t = jnp.arange(S)
    rows = (t // GRID_W).astype(jnp.float32)
    cols = (t % GRID_W).astype(jnp.float32)
    cond = jax.nn.silu(c)
    cond_ctx = jax.nn.silu(c_ctx)
    h, hc = x, ctx
    for l in range(DEPTH):
        need_ctx = l < DEPTH - 1
        lam_init = 0.8 - 0.6 * math.exp(-0.3 * l)
        sh1, sc1, g1, sh2, sc2, g2 = jnp.split((cond @ w_mod[l] + b_mod[l])[:, None, :], 6, axis=-1)
        sh1c, sc1c, g1c, sh2c, sc2c, g2c = jnp.split(cond_ctx @ w_mod[l] + b_mod[l], 6, axis=-1)
        u = rms_norm(h, norm1_g[l]) * (1.0 + sc1) + sh1
        uc = rms_norm(hc, norm1_g[l]) * (1.0 + sc1c) + sh1c
        y, yc = token_mixers(u, uc, w_in[l], na_rpb[l], conv_dw_w[l], conv_dw_b[l], conv_ln_g[l], conv_ln_b[l],
                             conv_pw_w[l], conv_pw_b[l], gqa_qn_g[l], gqa_kn_g[l], diff_lq1[l], diff_lk1[l],
                             diff_lq2[l], diff_lk2[l], diff_norm_g[l], lam_init, rows, cols, need_ctx)
        h = h + g1 * (y @ w_out[l])
        u = rms_norm(h, norm2_g[l]) * (1.0 + sc2) + sh2
        h = h + g2 * expert_choice_ffn(u, w_router[l], w_gate[l], w_up[l], w_down[l])
        if need_ctx:
            hc = hc + g1c * (yc @ w_out[l])
            uc = rms_norm(hc, norm2_g[l]) * (1.0 + sc2c) + sh2c
            hc = hc + g2c * expert_choice_ffn(uc, w_router[l], w_gate[l], w_up[l], w_down[l])
    return rms_norm(h, final_g)
```

```cpp
#include <hip/hip_runtime.h>
#include <cstdio>
#include <cstdint>

#ifndef MK_N_LAUNCHES
#define MK_N_LAUNCHES 1
#endif

constexpr int D = 1024, NB = 2, S = 8192, LC = 256, DEPTH = 2;
constexpr int ROWS_L = NB * S;
constexpr int ROWS_C = NB * LC;
constexpr int ROWS = ROWS_L + ROWS_C;
constexpr int KV = LC + S;
constexpr int DIN = 2560;
constexpr int NE = 16, CAP_L = 1024, CAP_C = 32;
constexpr int ESLOTS = 2 * CAP_L + 2 * CAP_C;
constexpr int EPAD = 2304;
constexpr float EPS = 1e-6f;
constexpr float LOG2E = 1.4426950408889634f;
constexpr int NWAVES = 8, NTHR = 512;

typedef unsigned short bf16_t;
typedef unsigned u32x4 __attribute__((ext_vector_type(4)));
typedef float f32x4 __attribute__((ext_vector_type(4)));

constexpr size_t MiB = 1u << 20;
constexpr size_t WS_CTL = 0;
constexpr size_t CTL_ZERO_BYTES = 64 * 1024;
constexpr size_t WS_TAB = 1 * MiB;
constexpr size_t WS_H = 2 * MiB;
constexpr size_t WS_U = 68 * MiB;
constexpr size_t WS_AFF = 101 * MiB;
constexpr size_t WS_SLOT = 103 * MiB;
constexpr size_t WS_RIDX = 105 * MiB;
constexpr size_t WS_WBF = 106 * MiB;
constexpr size_t WS_R = 314 * MiB;
constexpr size_t WS_END = 458 * MiB;
constexpr size_t WS_P = WS_WBF;
constexpr size_t WS_SEAM = WS_R;
constexpr size_t WS_Y = WS_R + 83 * MiB;
constexpr size_t WS_HE = WS_R;
constexpr size_t WS_YE = WS_R + 72 * MiB;

constexpr size_t SE_QA = 0;
constexpr size_t SE_QAC = SE_QA + (size_t)NB * 4 * S * 64;
constexpr size_t SE_KA = SE_QAC + (size_t)NB * 4 * LC * 64;
constexpr size_t SE_VA = SE_KA + (size_t)NB * 4 * KV * 64;
constexpr size_t SE_Z = SE_VA + (size_t)NB * 4 * KV * 64;
constexpr size_t SE_QG = SE_Z + (size_t)ROWS * 256;
constexpr size_t SE_QGC = SE_QG + (size_t)NB * 4 * S * 64;
constexpr size_t SE_KG = SE_QGC + (size_t)NB * 4 * LC * 64;
constexpr size_t SE_VG = SE_KG + (size_t)NB * 2 * KV * 64;
constexpr size_t SE_QD = SE_VG + (size_t)NB * 2 * KV * 64;
constexpr size_t SE_QDC = SE_QD + (size_t)NB * 4 * S * 64;
constexpr size_t SE_KD = SE_QDC + (size_t)NB * 4 * LC * 64;
constexpr size_t SE_VD = SE_KD + (size_t)NB * 4 * KV * 64;
constexpr size_t SE_END = SE_VD + (size_t)NB * 4 * KV * 64;
static_assert(SE_END == (size_t)ROWS * (DIN - 256), "seam map");
static_assert(SE_END * 2 <= 83 * MiB, "seam fits");

constexpr int TB_C64 = 0;
constexpr int TB_S64 = 2048;
constexpr int TB_C32 = 4096;
constexpr int TB_S32 = 5120;
constexpr int TB_MOD = 8192;
constexpr int TB_LAM = TB_MOD + DEPTH * 3 * 6144;

constexpr int CW_BAR = 1024;

enum { I_X = 0, I_C, I_CTX, I_CCTX, I_N1G, I_WMOD, I_BMOD, I_WIN, I_RPB, I_DWW, I_DWB, I_LNG, I_LNB, I_PWW, I_PWB,
       I_QNG, I_KNG, I_LQ1, I_LK1, I_LQ2, I_LK2, I_DNG, I_WOUT, I_N2G, I_WR, I_WG, I_WU, I_WD, I_FG, N_IN };

constexpr int LDS_BYTES = 147456;
constexpr int MISC_OFF = 131072 + 320;
constexpr int LDSCTL_OFF = 131072;

#define GAS __attribute__((address_space(1)))
#define LAS __attribute__((address_space(3)))

__device__ __forceinline__ float bf2f(bf16_t v) { return __uint_as_float((unsigned)v << 16); }
__device__ __forceinline__ unsigned f2bf(float f) { unsigned u = __float_as_uint(f); return (u + 0x7fffu + ((u >> 16) & 1u)) >> 16; }
__device__ __forceinline__ unsigned pk2(float lo, float hi) { return f2bf(lo) | (f2bf(hi) << 16); }
__device__ __forceinline__ float bflo(unsigned w) { return __uint_as_float(w << 16); }
__device__ __forceinline__ float bfhi(unsigned w) { return __uint_as_float(w & 0xffff0000u); }
__device__ __forceinline__ float wave_sum(float v) {
#pragma unroll
    for (int o = 1; o < 64; o <<= 1) v += __shfl_xor(v, o);
    return v;
}
__device__ __forceinline__ float silu_f(float x) { return x / (1.f + __expf(-x)); }
__device__ __forceinline__ int vzero() { int z; asm volatile("v_mov_b32 %0, 0" : "=v"(z)); return z; }

#define XB_TMO      128
#define XB_XCNT(j)  (256  + 64 * (j))
#define XB_XSUB(j)  (1280 + 64 * (j))
#define XB_XGEN(j)  (2304 + 64 * (j))
#define XB_TOP      3328
#define XB_TOPGEN   3392
#define XCD_BAR_WORDS 3456
#define XB_SPIN_CAP (1u << 22)
__device__ __forceinline__ unsigned xb_ld(unsigned* p)              { return __hip_atomic_load(p, __ATOMIC_RELAXED, __HIP_MEMORY_SCOPE_AGENT); }
__device__ __forceinline__ unsigned xb_add(unsigned* p, unsigned v) { return __hip_atomic_fetch_add(p, v, __ATOMIC_RELAXED, __HIP_MEMORY_SCOPE_AGENT); }
__device__ __forceinline__ unsigned xb_xcc_id() { return (unsigned)__builtin_amdgcn_s_getreg((3 << 11) | 20) & 0xFu; }
#define XB_SPIN(cond, bar) do { unsigned _sp = 0; while (cond) { __builtin_amdgcn_s_sleep(1); \
    if ((++_sp & 255u) == 0u) { if (xb_ld(&(bar)[XB_TMO])) break; if (_sp > XB_SPIN_CAP) { atomicAdd(&(bar)[XB_TMO], 1u); break; } } } } while (0)
struct XcdBarrier { unsigned* bar; unsigned x; volatile LAS unsigned* st; };
__device__ __forceinline__ XcdBarrier xcd_barrier_post(unsigned* bar, volatile LAS unsigned* st) {
    XcdBarrier b; b.bar = bar; b.x = xb_xcc_id(); b.st = st;
    if (threadIdx.x == 0) (void)xb_add(&bar[XB_XCNT(b.x)], 1u);
    return b;
}
__device__ __forceinline__ void xcd_barrier_complete(unsigned* bar, unsigned x, unsigned& nloc, unsigned& nx) {
    const unsigned G = gridDim.x * gridDim.y * gridDim.z;
    unsigned sum, cnt, mine, sp = 0u;
    for (;;) {
        sum = 0u; cnt = 0u; mine = 0u;
#pragma unroll
        for (unsigned j = 0; j < 16; ++j) { const unsigned c = xb_ld(&bar[XB_XCNT(j)]); sum += c; cnt += (c > 0u) ? 1u : 0u; mine = (j == x) ? c : mine; }
        if (sum == G) break;
        __builtin_amdgcn_s_sleep(1);
        if ((++sp & 255u) == 0u) { if (xb_ld(&bar[XB_TMO])) break; if (sp > XB_SPIN_CAP) { atomicAdd(&bar[XB_TMO], 1u); break; } }
    }
    nloc = mine > 0u ? mine : 1u; nx = cnt > 0u ? cnt : 1u;
}
__device__ __forceinline__ void xcd_barrier(const XcdBarrier& b) {
    asm volatile("s_waitcnt vmcnt(0)" ::: "memory");
    __syncthreads();
    if (threadIdx.x == 0) {
        unsigned* bar = b.bar;
        __builtin_amdgcn_s_waitcnt(0);
        unsigned nloc = b.st[0], nx = b.st[1];
        if (nloc == 0u) { xcd_barrier_complete(bar, b.x, nloc, nx); b.st[0] = nloc; b.st[1] = nx; }
        const unsigned old = xb_add(&bar[XB_XSUB(b.x)], 1u);
        const unsigned gen = old / nloc;
        if (old + 1u == (gen + 1u) * nloc) {
            __builtin_amdgcn_fence(__ATOMIC_RELEASE, "agent");
            asm volatile("s_waitcnt vmcnt(0)" ::: "memory");
            const unsigned og = xb_add(&bar[XB_TOP], 1u);
            const unsigned tg = og / nx;
            if (og + 1u == (tg + 1u) * nx) xb_add(&bar[XB_TOPGEN], 1u);
            else XB_SPIN(xb_ld(&bar[XB_TOPGEN]) == tg, bar);
            __builtin_amdgcn_fence(__ATOMIC_ACQUIRE, "agent");
            xb_add(&bar[XB_XGEN(b.x)], 1u);
            asm volatile("s_waitcnt vmcnt(0)" ::: "memory");
        } else {
            XB_SPIN(xb_ld(&bar[XB_XGEN(b.x)]) == gen, bar);
            __builtin_amdgcn_fence(__ATOMIC_ACQUIRE, "agent");
            asm volatile("s_waitcnt vmcnt(0)" ::: "memory");
        }
    }
    __syncthreads();
}

struct Args { const float* in[N_IN]; float* out; unsigned char* ws; int ph_lo, ph_hi; };
struct Frame {
    LAS unsigned char* lds;
    int tid, lane, wave, G, bid;
    const float* const* in;
    float* out; unsigned char* ws;
    float* tab; float* H; bf16_t* U; float* AFF; int* SLOT; int* RIDX; float* GATE;
    bf16_t* SEAM; bf16_t* Y; bf16_t* HE; bf16_t* YE; float* P;
};

__device__ __forceinline__ double inv_freq(int f, int nf) {
    const double r16 = 0.5623413251903491;
    const int steps = (nf == 16) ? f : 2 * f;
    double v = 1.0;
    for (int i = 0; i < steps; ++i) v *= r16;
    return v;
}
__device__ __forceinline__ void sincos_d(double x, double& s, double& c) {
    const double TWO_PI = 6.283185307179586476925286766559;
    const double k = __builtin_rint(x / TWO_PI);
    const double r = x - k * TWO_PI;
    const double r2 = r * r;
    double ts = 1.0, tc = 1.0, ss = 1.0, cs = 1.0;
#pragma unroll 1
    for (int n = 1; n <= 14; ++n) {
        tc *= -r2 / (double)((2 * n - 1) * (2 * n));
        ts *= -r2 / (double)((2 * n) * (2 * n + 1));
        cs += tc; ss += ts;
    }
    s = r * ss; c = cs;
}

__device__ __forceinline__ void phase_prologue(Frame& F) {
    const int gt = F.bid * NTHR + F.tid, NGT = F.G * NTHR;
    for (int i = gt; i < 128 * 16 + 128 * 8; i += NGT) {
        if (i < 2048) { const int pos = i >> 4, f = i & 15; double s, c; sincos_d((double)pos * inv_freq(f, 16), s, c); F.tab[TB_C64 + i] = (float)c; F.tab[TB_S64 + i] = (float)s; }
        else { const int j = i - 2048, pos = j >> 3, f = j & 7; double s, c; sincos_d((double)pos * inv_freq(f, 8), s, c); F.tab[TB_C32 + j] = (float)c; F.tab[TB_S32 + j] = (float)s; }
    }
    if (gt < DEPTH) {
        const int l = gt; float a = 0.f, b = 0.f;
        for (int i = 0; i < 32; ++i) { a += F.in[I_LQ1][l * 32 + i] * F.in[I_LK1][l * 32 + i]; b += F.in[I_LQ2][l * 32 + i] * F.in[I_LK2][l * 32 + i]; }
        const float lam_init = 0.8f - 0.6f * expf(-0.3f * (float)l);
        F.tab[TB_LAM + 2 * l] = expf(a) - expf(b) + lam_init; F.tab[TB_LAM + 2 * l + 1] = 1.f - lam_init;
    }
    LAS float* red = (LAS float*)F.lds;
    for (int u = F.bid; u < DEPTH * 96; u += F.G) {
        const int l = u / 96, n0 = (u % 96) * 64, ks = F.tid >> 6, nn = F.tid & 63;
        const float* W = F.in[I_WMOD] + (size_t)l * D * 6144 + n0 + nn;
        float a0 = 0.f, a1 = 0.f, a2 = 0.f;
        for (int k = ks * 128; k < ks * 128 + 128; ++k) {
            const float w = W[(size_t)k * 6144];
            a0 += silu_f(F.in[I_C][k]) * w; a1 += silu_f(F.in[I_C][D + k]) * w; a2 += silu_f(F.in[I_CCTX][k]) * w;
        }
        red[(ks * 3 + 0) * 64 + nn] = a0; red[(ks * 3 + 1) * 64 + nn] = a1; red[(ks * 3 + 2) * 64 + nn] = a2;
        __syncthreads();
        if (F.tid < 192) { const int v = F.tid >> 6; float s = 0.f;
            for (int q = 0; q < 8; ++q) s += red[(q * 3 + v) * 64 + nn];
            F.tab[TB_MOD + (l * 3 + v) * 6144 + n0 + nn] = s + F.in[I_BMOD][l * 6144 + n0 + nn]; }
        __syncthreads();
    }
}

template <int MODE> __device__ __forceinline__ void phase_norm(Frame& F, int l, bool src0, int comb_l, bool with_ctx) {
    const int gw = F.bid * NWAVES + F.wave, NGW = F.G * NWAVES;
    const int nrows = with_ctx ? ROWS : ROWS_L;
    for (int r = gw; r < nrows; r += NGW) {
        const bool isc = r >= ROWS_L; const int b = isc ? (r - ROWS_L) / LC : r / S; const int mv = isc ? 2 : b;
        const float* src = src0 ? (isc ? F.in[I_CTX] + (size_t)(r - ROWS_L) * D : F.in[I_X] + (size_t)r * D) : F.H + (size_t)r * D;
        f32x4 v[4];
#pragma unroll
        for (int j = 0; j < 4; ++j) v[j] = *(const f32x4*)(src + 4 * F.lane + 256 * j);
        if (comb_l >= 0) {
            const float* g2 = F.tab + TB_MOD + (comb_l * 3 + mv) * 6144 + 5 * D;
            const int* sl = F.SLOT + (size_t)r * 16;
            f32x4 acc[4];
#pragma unroll
            for (int j = 0; j < 4; ++j) acc[j] = (f32x4){0.f, 0.f, 0.f, 0.f};
            for (int e = 0; e < NE; ++e) {
                const int s_ = sl[e];
                if (s_ >= 0) {
                    const int base = isc ? 2 * CAP_L + b * CAP_C : b * CAP_L;
                    const bf16_t* y = F.YE + ((size_t)e * EPAD + base + s_) * D;
#pragma unroll
                    for (int j = 0; j < 4; ++j) { const uint2 w = *(const uint2*)(y + 4 * F.lane + 256 * j);
                        acc[j][0] += bflo(w.x); acc[j][1] += bfhi(w.x); acc[j][2] += bflo(w.y); acc[j][3] += bfhi(w.y); }
                }
            }
#pragma unroll
            for (int j = 0; j < 4; ++j) { const f32x4 g = *(const f32x4*)(g2 + 4 * F.lane + 256 * j); v[j] += g * acc[j]; *(f32x4*)(F.H + (size_t)r * D + 4 * F.lane + 256 * j) = v[j]; }
        }
        float ss = 0.f;
#pragma unroll
        for (int j = 0; j < 4; ++j) ss += (v[j][0] * v[j][0] + v[j][1] * v[j][1]) + (v[j][2] * v[j][2] + v[j][3] * v[j][3]);
        const float rs = 1.f / sqrtf(wave_sum(ss) * (1.f / D) + EPS);
        if (MODE == 2) {
#pragma unroll
            for (int j = 0; j < 4; ++j) { const f32x4 g = *(const f32x4*)(F.in[I_FG] + 4 * F.lane + 256 * j); *(f32x4*)(F.out + (size_t)r * D + 4 * F.lane + 256 * j) = v[j] * rs * g; }
        } else {
            const float* md = F.tab + TB_MOD + (l * 3 + mv) * 6144;
            const float* ng = F.in[I_N1G] + l * D;
#pragma unroll
            for (int j = 0; j < 4; ++j) { const int c0 = 4 * F.lane + 256 * j; const f32x4 g = *(const f32x4*)(ng + c0), sh = *(const f32x4*)(md + c0), sc = *(const f32x4*)(md + D + c0);
                const f32x4 u = (v[j] * rs * g) * (1.f + sc) + sh; uint2 w; w.x = pk2(u[0], u[1]); w.y = pk2(u[2], u[3]); *(uint2*)(F.U + (size_t)r * D + c0) = w; }
        }
    }
}

__device__ __forceinline__ void phase_norm2_router(Frame& F, int l, bool with_ctx) {
    LAS float* wr = (LAS float*)F.lds;
    for (int i = F.tid; i < D * NE; i += NTHR) wr[i] = F.in[I_WR][(size_t)l * D * NE + i];
    __syncthreads();
    const int gw = F.bid * NWAVES + F.wave, NGW = F.G * NWAVES;
    const int nrows = with_ctx ? ROWS : ROWS_L;
    for (int r = gw; r < nrows; r += NGW) {
        const bool isc = r >= ROWS_L; const int b = isc ? (r - ROWS_L) / LC : r / S; const int mv = isc ? 2 : b;
        const float* src = F.H + (size_t)r * D;
        const float* md = F.tab + TB_MOD + (l * 3 + mv) * 6144;
        const float* ng = F.in[I_N2G] + l * D;
        f32x4 v[4]; float ss = 0.f;
#pragma unroll
        for (int j = 0; j < 4; ++j) { v[j] = *(const f32x4*)(src + 4 * F.lane + 256 * j); ss += (v[j][0] * v[j][0] + v[j][1] * v[j][1]) + (v[j][2] * v[j][2] + v[j][3] * v[j][3]); }
        const float rs = 1.f / sqrtf(wave_sum(ss) * (1.f / D) + EPS);
        float lg[NE];
#pragma unroll
        for (int e = 0; e < NE; ++e) lg[e] = 0.f;
#pragma unroll
        for (int j = 0; j < 4; ++j) { const int c0 = 4 * F.lane + 256 * j; const f32x4 g = *(const f32x4*)(ng + c0), sh = *(const f32x4*)(md + 3 * D + c0), sc = *(const f32x4*)(md + 4 * D + c0);
            const f32x4 u = (v[j] * rs * g) * (1.f + sc) + sh; uint2 w; w.x = pk2(u[0], u[1]); w.y = pk2(u[2], u[3]); *(uint2*)(F.U + (size_t)r * D + c0) = w;
#pragma unroll
            for (int i = 0; i < 4; ++i) {
#pragma unroll
                for (int e4 = 0; e4 < 4; ++e4) { const f32x4 ww = *(const LAS f32x4*)(wr + (c0 + i) * NE + 4 * e4);
                    lg[4 * e4 + 0] += u[i] * ww[0]; lg[4 * e4 + 1] += u[i] * ww[1]; lg[4 * e4 + 2] += u[i] * ww[2]; lg[4 * e4 + 3] += u[i] * ww[3]; }
                asm volatile("" ::: "memory");
            }
        }
        float mx = -1e30f;
#pragma unroll
        for (int e = 0; e < NE; ++e) { lg[e] = wave_sum(lg[e]); mx = fmaxf(mx, lg[e]); }
        float sm = 0.f;
#pragma unroll
        for (int e = 0; e < NE; ++e) { lg[e] = expf(lg[e] - mx); sm += lg[e]; }
        const float inv = 1.f / sm;
        float mine = 0.f;
#pragma unroll
        for (int e = 0; e < NE; ++e) mine = (F.lane == e) ? lg[e] * inv : mine;
        if (F.lane < NE) F.AFF[(size_t)r * NE + F.lane] = mine;
    }
    __syncthreads();
}

__device__ __forceinline__ void phase_select_naive(Frame& F, bool with_ctx) {
    LAS float* col = (LAS float*)F.lds;
    const int NU = 32 * 16 + (with_ctx ? 32 : 0);
    for (int i = F.bid * NTHR + F.tid; i < NE * EPAD; i += F.G * NTHR) { const int sl = i % EPAD; if (sl >= (with_ctx ? ESLOTS : 2 * CAP_L)) { F.RIDX[i] = -1; F.GATE[i] = 0.f; } }
    for (int u = F.bid; u < NU; u += F.G) {
        const bool isc = u >= 512; const int li = isc ? u - 512 : u / 16, ch = isc ? 0 : u % 16, b = li / NE, e = li % NE;
        const int N = isc ? LC : S, C = isc ? CAP_C : CAP_L, row0 = isc ? ROWS_L + b * LC : b * S;
        __syncthreads();
        for (int i = F.tid; i < N; i += NTHR) col[i] = F.AFF[(size_t)(row0 + i) * NE + e];
        __syncthreads();
        const int n = ch * 512 + F.tid;
        if (n < N) {
            const float a = col[n]; int rank = 0;
            for (int m = 0; m < N; ++m) { const float x = col[m]; rank += (x > a || (x == a && m < n)) ? 1 : 0; }
            if (rank < C) { const int sl = (isc ? 2 * CAP_L + b * CAP_C : b * CAP_L) + rank; F.RIDX[e * EPAD + sl] = row0 + n; F.GATE[e * EPAD + sl] = a; F.SLOT[(size_t)(row0 + n) * NE + e] = rank; }
            else F.SLOT[(size_t)(row0 + n) * NE + e] = -1;
        }
    }
    __syncthreads();
}

struct NaiveEpi { int mode; int l; float* P; const float* hin; float* hout; const float* mod; bf16_t* HE; bf16_t* YE; const float* gate; };
template <bool DUAL> __device__ __forceinline__ void naive_gemm_tile(Frame& F, const bf16_t* A, int lda, const int* ridx, int m0, int M, const float* W, const float* W2, int ldw, int n0, int K, const NaiveEpi& E, int erow0) {
    LAS float* As = (LAS float*)F.lds;
    LAS float* Bs = As + 16 * 132;
    LAS float* Bs2 = Bs + 16 * 64;
    const int ty = F.tid >> 4, tx = F.tid & 15;
    float acc[4][4], acc2[4][4];
#pragma unroll
    for (int i = 0; i < 4; ++i)
#pragma unroll
        for (int j = 0; j < 4; ++j) { acc[i][j] = 0.f; acc2[i][j] = 0.f; }
    const int ar = F.tid >> 1, ah = F.tid & 1;
    long arow = -1;
    if (F.tid < 256) { const int m = m0 + ar; if (m < M) arow = ridx ? (long)ridx[m] : (long)m; }
    const int bk = (F.tid - 256) >> 4, bc = (F.tid - 256) & 15;
    for (int k0 = 0; k0 < K; k0 += 16) {
        __syncthreads();
        if (F.tid < 256) {
            u32x4 w = (u32x4){0u, 0u, 0u, 0u};
            if (arow >= 0) w = *(const u32x4*)(A + (size_t)arow * lda + k0 + ah * 8);
            const int kb = ah * 8;
            As[(kb + 0) * 132 + ar] = bflo(w.x); As[(kb + 1) * 132 + ar] = bfhi(w.x); As[(kb + 2) * 132 + ar] = bflo(w.y); As[(kb + 3) * 132 + ar] = bfhi(w.y);
            As[(kb + 4) * 132 + ar] = bflo(w.z); As[(kb + 5) * 132 + ar] = bfhi(w.z); As[(kb + 6) * 132 + ar] = bflo(w.w); As[(kb + 7) * 132 + ar] = bfhi(w.w);
        } else {
            *(LAS f32x4*)(Bs + bk * 64 + bc * 4) = *(const f32x4*)(W + (size_t)(k0 + bk) * ldw + n0 + bc * 4);
            if (DUAL) *(LAS f32x4*)(Bs2 + bk * 64 + bc * 4) = *(const f32x4*)(W2 + (size_t)(k0 + bk) * ldw + n0 + bc * 4);
        }
        __syncthreads();
#pragma unroll
        for (int k = 0; k < 16; ++k) {
            const f32x4 a = *(const LAS f32x4*)(As + k * 132 + ty * 4), b = *(const LAS f32x4*)(Bs + k * 64 + tx * 4);
#pragma unroll
            for (int i = 0; i < 4; ++i)
#pragma unroll
                for (int j = 0; j < 4; ++j) acc[i][j] += a[i] * b[j];
            if (DUAL) { const f32x4 b2 = *(const LAS f32x4*)(Bs2 + k * 64 + tx * 4);
#pragma unroll
                for (int i = 0; i < 4; ++i)
#pragma unroll
                    for (int j = 0; j < 4; ++j) acc2[i][j] += a[i] * b2[j]; }
        }
    }
#pragma unroll
    for (int i = 0; i < 4; ++i) {
        const int m = m0 + ty * 4 + i; if (m >= M) continue;
        const int c0 = n0 + tx * 4;
        if (E.mode == 0) { *(f32x4*)(E.P + (size_t)m * DIN + c0) = (f32x4){acc[i][0], acc[i][1], acc[i][2], acc[i][3]}; }
        else if (E.mode == 1) {
            const bool isc = m >= ROWS_L; const int b = isc ? (m - ROWS_L) / LC : m / S; const int mv = isc ? 2 : b;
            const f32x4 g = *(const f32x4*)(E.mod + (E.l * 3 + mv) * 6144 + 2 * D + c0);
            const float* hi_ = (E.hin == nullptr) ? (isc ? F.in[I_CTX] + (size_t)(m - ROWS_L) * D : F.in[I_X] + (size_t)m * D) : E.hin + (size_t)m * D;
            const f32x4 h = *(const f32x4*)(hi_ + c0);
            *(f32x4*)(E.hout + (size_t)m * D + c0) = h + g * (f32x4){acc[i][0], acc[i][1], acc[i][2], acc[i][3]};
        } else if (E.mode == 2) {
            uint2 w; w.x = pk2(silu_f(acc[i][0]) * acc2[i][0], silu_f(acc[i][1]) * acc2[i][1]); w.y = pk2(silu_f(acc[i][2]) * acc2[i][2], silu_f(acc[i][3]) * acc2[i][3]);
            *(uint2*)(E.HE + (size_t)(erow0 + m) * D + c0) = w;
        } else {
            const float g = E.gate[erow0 + m];
            uint2 w; w.x = pk2(g * acc[i][0], g * acc[i][1]); w.y = pk2(g * acc[i][2], g * acc[i][3]);
            *(uint2*)(E.YE + (size_t)(erow0 + m) * D + c0) = w;
        }
    }
}

__device__ __forceinline__ void phase_inproj_naive(Frame& F, int l) {
    NaiveEpi E{}; E.mode = 0; E.P = F.P;
    const int nM = ROWS / 128, nN = DIN / 64;
    for (int u = F.bid; u < nM * nN; u += F.G) { const int pm = u / nN, pn = u % nN;
        naive_gemm_tile<false>(F, F.U, D, nullptr, pm * 128, ROWS, F.in[I_WIN] + (size_t)l * D * DIN, nullptr, DIN, pn * 64, D, E, 0); }
    __syncthreads();
}
__device__ __forceinline__ void phase_outproj_naive(Frame& F, int l, bool with_ctx) {
    NaiveEpi E{}; E.mode = 1; E.l = l; E.hin = (l == 0) ? nullptr : F.H; E.hout = F.H; E.mod = F.tab + TB_MOD;
    const int M = with_ctx ? ROWS : ROWS_L; const int nM = M / 128, nN = D / 64;
    for (int u = F.bid; u < nM * nN; u += F.G) { const int pm = u / nN, pn = u % nN;
        naive_gemm_tile<false>(F, F.Y, D, nullptr, pm * 128, M, F.in[I_WOUT] + (size_t)l * D * D, nullptr, D, pn * 64, D, E, 0); }
    __syncthreads();
}
__device__ __forceinline__ void phase_moe1_naive(Frame& F, int l, bool with_ctx) {
    NaiveEpi E{}; E.mode = 2; E.HE = F.HE;
    const int M = with_ctx ? ESLOTS : 2 * CAP_L; const int nM = (M + 127) / 128, nN = D / 64;
    for (int u = F.bid; u < NE * nM * nN; u += F.G) { const int e = u / (nM * nN), r = u % (nM * nN), pm = r / nN, pn = r % nN;
        naive_gemm_tile<true>(F, F.U, D, F.RIDX + e * EPAD, pm * 128, M, F.in[I_WG] + ((size_t)l * NE + e) * D * D, F.in[I_WU] + ((size_t)l * NE + e) * D * D, D, pn * 64, D, E, e * EPAD); }
    __syncthreads();
}
__device__ __forceinline__ void phase_moe2_naive(Frame& F, int l, bool with_ctx) {
    NaiveEpi E{}; E.mode = 3; E.YE = F.YE; E.gate = F.GATE;
    const int M = with_ctx ? ESLOTS : 2 * CAP_L; const int nM = (M + 127) / 128, nN = D / 64;
    for (int u = F.bid; u < NE * nM * nN; u += F.G) { const int e = u / (nM * nN), r = u % (nM * nN), pm = r / nN, pn = r % nN;
        naive_gemm_tile<false>(F, F.HE + (size_t)e * EPAD * D, D, nullptr, pm * 128, M, F.in[I_WD] + ((size_t)l * NE + e) * D * D, nullptr, D, pn * 64, D, E, e * EPAD); }
    __syncthreads();
}

__device__ __forceinline__ void store64(bf16_t* dst, const float (&v)[64]) {
#pragma unroll
    for (int i = 0; i < 8; ++i) { u32x4 w; w.x = pk2(v[8 * i], v[8 * i + 1]); w.y = pk2(v[8 * i + 2], v[8 * i + 3]); w.z = pk2(v[8 * i + 4], v[8 * i + 5]); w.w = pk2(v[8 * i + 6], v[8 * i + 7]); *(u32x4*)(dst + 8 * i) = w; }
}
template <int DIM, int OFF> __device__ __forceinline__ void rope_vec(float (&v)[64], const float* tab, int t) {
    constexpr int half = DIM / 2, nf = half / 2;
    const int pr = t >> 6, pc = t & 63;
    const float* C = tab + (DIM == 64 ? TB_C64 : TB_C32); const float* Sn = tab + (DIM == 64 ? TB_S64 : TB_S32);
#pragma unroll
    for (int i = 0; i < half; ++i) {
        const int pos = (i < nf) ? pr : pc, f = (i < nf) ? i : i - nf;
        const float c = C[pos * nf + f], s = Sn[pos * nf + f];
        const float x1 = v[OFF + i], x2 = v[OFF + half + i];
        v[OFF + i] = x1 * c - x2 * s; v[OFF + half + i] = x2 * c + x1 * s;
    }
}
__device__ __forceinline__ void phase_post_naive(Frame& F, int l) {
    const long NT = (long)ROWS * 40;
    for (long it = (long)F.bid * NTHR + F.tid; it < NT; it += (long)F.G * NTHR) {
        const int r = (int)(it / 40), u = (int)(it % 40);
        if (u >= 16 && u < 20) continue;
        const bool isc = r >= ROWS_L; const int b = isc ? (r - ROWS_L) / LC : r / S; const int t = isc ? (r - ROWS_L) % LC : r % S;
        const int key = isc ? t : LC + t;
        const float* p = F.P + (size_t)r * DIN + 64 * u;
        float v[64];
#pragma unroll
        for (int i = 0; i < 16; ++i) { const f32x4 x = *(const f32x4*)(p + 4 * i); v[4 * i] = x[0]; v[4 * i + 1] = x[1]; v[4 * i + 2] = x[2]; v[4 * i + 3] = x[3]; }
        bf16_t* dst;
        if (u < 4) {
            const float sc = 0.125f * LOG2E;
#pragma unroll
            for (int i = 0; i < 64; ++i) v[i] *= sc;
            dst = isc ? F.SEAM + SE_QAC + (((size_t)b * 4 + u) * LC + t) * 64 : F.SEAM + SE_QA + (((size_t)b * 4 + u) * S + t) * 64;
        } else if (u < 8) { dst = F.SEAM + SE_KA + (((size_t)b * 4 + (u - 4)) * KV + key) * 64; }
        else if (u < 12) { dst = F.SEAM + SE_VA + (((size_t)b * 4 + (u - 8)) * KV + key) * 64; }
        else if (u < 16) {
            const float* pg = p + 256;
#pragma unroll
            for (int i = 0; i < 16; ++i) { const f32x4 g = *(const f32x4*)(pg + 4 * i);
                v[4 * i] *= 1.f / (1.f + __expf(-g[0])); v[4 * i + 1] *= 1.f / (1.f + __expf(-g[1])); v[4 * i + 2] *= 1.f / (1.f + __expf(-g[2])); v[4 * i + 3] *= 1.f / (1.f + __expf(-g[3])); }
            dst = F.SEAM + SE_Z + (size_t)r * 256 + 64 * (u - 12);
        } else if (u < 24) {
            const int hq = u - 20; const float* g = F.in[I_QNG] + l * 64; float ss = 0.f;
#pragma unroll
            for (int i = 0; i < 64; ++i) ss += v[i] * v[i];
            const float rs = 1.f / sqrtf(ss * (1.f / 64.f) + EPS);
#pragma unroll
            for (int i = 0; i < 64; ++i) v[i] = v[i] * rs * g[i];
            if (!isc) rope_vec<64, 0>(v, F.tab, t);
            const float sc = 0.125f * LOG2E;
#pragma unroll
            for (int i = 0; i < 64; ++i) v[i] *= sc;
            dst = isc ? F.SEAM + SE_QGC + (((size_t)b * 4 + hq) * LC + t) * 64 : F.SEAM + SE_QG + (((size_t)b * 4 + hq) * S + t) * 64;
        } else if (u < 26) {
            const int hk = u - 24; const float* g = F.in[I_KNG] + l * 64; float ss = 0.f;
#pragma unroll
            for (int i = 0; i < 64; ++i) ss += v[i] * v[i];
            const float rs = 1.f / sqrtf(ss * (1.f / 64.f) + EPS);
#pragma unroll
            for (int i = 0; i < 64; ++i) v[i] = v[i] * rs * g[i];
            if (!isc) rope_vec<64, 0>(v, F.tab, t);
            dst = F.SEAM + SE_KG + (((size_t)b * 2 + hk) * KV + key) * 64;
        } else if (u < 28) { dst = F.SEAM + SE_VG + (((size_t)b * 2 + (u - 26)) * KV + key) * 64; }
        else if (u < 32) {
            const int h = u - 28;
            if (!isc) { rope_vec<32, 0>(v, F.tab, t); rope_vec<32, 32>(v, F.tab, t); }
            const float sc = 0.17677669529663687f * LOG2E;
#pragma unroll
            for (int i = 0; i < 64; ++i) v[i] *= sc;
            dst = isc ? F.SEAM + SE_QDC + (((size_t)b * 4 + h) * LC + t) * 64 : F.SEAM + SE_QD + (((size_t)b * 4 + h) * S + t) * 64;
        } else if (u < 36) {
            const int h = u - 32;
            if (!isc) { rope_vec<32, 0>(v, F.tab, t); rope_vec<32, 32>(v, F.tab, t); }
            dst = F.SEAM + SE_KD + (((size_t)b * 4 + h) * KV + key) * 64;
        } else { dst = F.SEAM + SE_VD + (((size_t)b * 4 + (u - 36)) * KV + key) * 64; }
        store64(dst, v);
    }
}

__device__ __forceinline__ void load64(float (&v)[64], const bf16_t* p) {
#pragma unroll
    for (int i = 0; i < 8; ++i) { const u32x4 w = *(const u32x4*)(p + 8 * i);
        v[8 * i] = bflo(w.x); v[8 * i + 1] = bfhi(w.x); v[8 * i + 2] = bflo(w.y); v[8 * i + 3] = bfhi(w.y); v[8 * i + 4] = bflo(w.z); v[8 * i + 5] = bfhi(w.z); v[8 * i + 6] = bflo(w.w); v[8 * i + 7] = bfhi(w.w); }
}
struct Q64 { u32x4 w[8]; };
__device__ __forceinline__ void loadq(Q64& q, const bf16_t* p) {
#pragma unroll
    for (int i = 0; i < 8; ++i) q.w[i] = *(const u32x4*)(p + 8 * i);
}
__device__ __forceinline__ float dot8(u32x4 a, const u32x4 w, float s) {
    asm volatile("" : "+v"(a));
    s += bflo(a.x) * bflo(w.x); s += bfhi(a.x) * bfhi(w.x); s += bflo(a.y) * bflo(w.y); s += bfhi(a.y) * bfhi(w.y);
    s += bflo(a.z) * bflo(w.z); s += bfhi(a.z) * bfhi(w.z); s += bflo(a.w) * bflo(w.w); s += bfhi(a.w) * bfhi(w.w); return s;
}
__device__ __forceinline__ float dot64(const Q64& q, const bf16_t* k) {
    float s0 = 0.f, s1 = 0.f;
#pragma unroll
    for (int i = 0; i < 8; i += 2) { s0 = dot8(q.w[i], *(const u32x4*)(k + 8 * i), s0); s1 = dot8(q.w[i + 1], *(const u32x4*)(k + 8 * i + 8), s1); }
    return s0 + s1;
}
template <int OFF> __device__ __forceinline__ float dot32(const Q64& q, const bf16_t* k) {
    float s0 = 0.f, s1 = 0.f;
#pragma unroll
    for (int i = 0; i < 4; i += 2) { s0 = dot8(q.w[OFF / 8 + i], *(const u32x4*)(k + OFF + 8 * i), s0); s1 = dot8(q.w[OFF / 8 + i + 1], *(const u32x4*)(k + OFF + 8 * i + 8), s1); }
    return s0 + s1;
}
__device__ __forceinline__ void axpy64(float (&o)[64], float p, const bf16_t* vrow) {
#pragma unroll
    for (int i = 0; i < 8; ++i) { const u32x4 w = *(const u32x4*)(vrow + 8 * i);
        o[8 * i] += p * bflo(w.x); o[8 * i + 1] += p * bfhi(w.x); o[8 * i + 2] += p * bflo(w.y); o[8 * i + 3] += p * bfhi(w.y);
        o[8 * i + 4] += p * bflo(w.z); o[8 * i + 5] += p * bfhi(w.z); o[8 * i + 6] += p * bflo(w.w); o[8 * i + 7] += p * bfhi(w.w); }
}
#define OSM_STEP(m, lsum, o, s, vrow) do { if ((s) > (m)) { const float f_ = exp2f((m) - (s)); (lsum) *= f_; _Pragma("unroll") for (int i_ = 0; i_ < 64; ++i_) (o)[i_] *= f_; (m) = (s); } \
    const float p_ = exp2f((s) - (m)); (lsum) += p_; axpy64((o), p_, (vrow)); } while (0)

__device__ __forceinline__ void axpy32(float (&o)[32], float p, const bf16_t* vrow) {
#pragma unroll
    for (int i = 0; i < 4; ++i) { const u32x4 w = *(const u32x4*)(vrow + 8 * i);
        o[8 * i] += p * bflo(w.x); o[8 * i + 1] += p * bfhi(w.x); o[8 * i + 2] += p * bflo(w.y); o[8 * i + 3] += p * bfhi(w.y);
        o[8 * i + 4] += p * bflo(w.z); o[8 * i + 5] += p * bfhi(w.z); o[8 * i + 6] += p * bflo(w.w); o[8 * i + 7] += p * bfhi(w.w); }
}
#define OSM_STEP32(m, lsum, o, s, vrow) do { if ((s) > (m)) { const float f_ = exp2f((m) - (s)); (lsum) *= f_; _Pragma("unroll") for (int i_ = 0; i_ < 32; ++i_) (o)[i_] *= f_; (m) = (s); } \
    const float p_ = exp2f((s) - (m)); (lsum) += p_; axpy32((o), p_, (vrow)); } while (0)
__device__ __forceinline__ void naive_diff(Frame& F, int l, const bf16_t* qp, const bf16_t* K, const bf16_t* V, int nk, int dh, bf16_t* dst) {
    Q64 q; loadq(q, qp);
    float o1[32], o2[32]; float m1 = -1e30f, l1 = 0.f, m2 = -1e30f, l2 = 0.f;
#pragma unroll
    for (int i = 0; i < 32; ++i) { o1[i] = 0.f; o2[i] = 0.f; }
    const int z = vzero();
#pragma unroll 1
    for (int j = 0; j < nk; ++j) {
        const bf16_t* kr = K + (size_t)(j + z) * 64; const bf16_t* vr = V + (size_t)(j + z) * 64 + 32 * dh;
        const float s1 = dot32<0>(q, kr), s2 = dot32<32>(q, kr);
        OSM_STEP32(m1, l1, o1, s1, vr); OSM_STEP32(m2, l2, o2, s2, vr);
    }
    const float lam = F.tab[TB_LAM + 2 * l], oml = F.tab[TB_LAM + 2 * l + 1];
    const float i1 = 1.f / l1, i2 = lam / l2; float ss = 0.f;
#pragma unroll
    for (int i = 0; i < 32; ++i) { o1[i] = o1[i] * i1 - o2[i] * i2; ss += o1[i] * o1[i]; }
    ss += __shfl_xor(ss, 1);
    const float rs = oml / sqrtf(ss * (1.f / 64.f) + EPS);
    const float* g = F.in[I_DNG] + l * 64 + 32 * dh;
#pragma unroll
    for (int i = 0; i < 4; ++i) { u32x4 w; w.x = pk2(o1[8 * i] * rs * g[8 * i], o1[8 * i + 1] * rs * g[8 * i + 1]); w.y = pk2(o1[8 * i + 2] * rs * g[8 * i + 2], o1[8 * i + 3] * rs * g[8 * i + 3]);
        w.z = pk2(o1[8 * i + 4] * rs * g[8 * i + 4], o1[8 * i + 5] * rs * g[8 * i + 5]); w.w = pk2(o1[8 * i + 6] * rs * g[8 * i + 6], o1[8 * i + 7] * rs * g[8 * i + 7]); *(u32x4*)(dst + 8 * i) = w; }
}
__device__ __forceinline__ void store32n(bf16_t* dst, const float (&o)[32], float inv) {
#pragma unroll
    for (int i = 0; i < 4; ++i) { u32x4 w; w.x = pk2(o[8 * i] * inv, o[8 * i + 1] * inv); w.y = pk2(o[8 * i + 2] * inv, o[8 * i + 3] * inv);
        w.z = pk2(o[8 * i + 4] * inv, o[8 * i + 5] * inv); w.w = pk2(o[8 * i + 6] * inv, o[8 * i + 7] * inv); *(u32x4*)(dst + 8 * i) = w; }
}
__device__ __forceinline__ void naive_attn(const bf16_t* qp, const bf16_t* K, const bf16_t* V, int nk, int dh, bf16_t* dst) {
    Q64 q; loadq(q, qp);
    float o[32]; float m = -1e30f, ls = 0.f;
#pragma unroll
    for (int i = 0; i < 32; ++i) o[i] = 0.f;
    const int z = vzero();
#pragma unroll 1
    for (int j = 0; j < nk; ++j) { const float s = dot64(q, K + (size_t)(j + z) * 64); OSM_STEP32(m, ls, o, s, V + (size_t)(j + z) * 64 + 32 * dh); }
    store32n(dst, o, 1.f / ls);
}
__device__ __forceinline__ void naive_na(Frame& F, int l, int b, int h, int t, int dh, bf16_t* dst) {
    Q64 q; loadq(q, F.SEAM + SE_QA + (((size_t)b * 4 + h) * S + t) * 64);
    const bf16_t* K = F.SEAM + SE_KA + ((size_t)b * 4 + h) * KV * 64; const bf16_t* V = F.SEAM + SE_VA + ((size_t)b * 4 + h) * KV * 64 + 32 * dh;
    const float* rpb = F.in[I_RPB] + ((size_t)l * 4 + h) * 15 * 31;
    const int r = t >> 6, jq = t & 63;
    int rs = r - 4; rs = rs < 0 ? 0 : (rs > 120 ? 120 : rs);
    int cs = jq - 8; cs = cs < 0 ? 0 : (cs > 48 ? 48 : cs);
    float o[32]; float m = -1e30f, ls = 0.f;
#pragma unroll
    for (int i = 0; i < 32; ++i) o[i] = 0.f;
#pragma unroll 1
    for (int kk = 0; kk < 128 + LC; ++kk) {
        int key; float bias = 0.f;
        if (kk < 128) { const int rr = rs + (kk >> 4), cc = cs + (kk & 15); key = LC + rr * 64 + cc;
            const int dr = rr - r + 7; int dc = cc - jq; dc = dc < -15 ? -15 : (dc > 15 ? 15 : dc); dc += 15; bias = rpb[dr * 31 + dc] * LOG2E; }
        else key = kk - 128;
        const float s = dot64(q, K + (size_t)key * 64) + bias;
        OSM_STEP32(m, ls, o, s, V + (size_t)key * 64);
    }
    store32n(dst, o, 1.f / ls);
}
__device__ __forceinline__ void phase_conv_naive(Frame& F, int l, int unit, bool ctxu) {
    LAS float* zc = (LAS float*)F.lds;
    const int row0 = ctxu ? ROWS_L + unit * 16 : unit * 16;
    const int seqlen = ctxu ? LC : S; const int t0 = (ctxu ? unit * 16 : unit * 16) % seqlen; const int seqrow0 = row0 - t0;
    const bf16_t* Z = F.SEAM + SE_Z;
    const float* dww = F.in[I_DWW] + (size_t)l * 31 * 256; const float* dwb = F.in[I_DWB] + l * 256;
    __syncthreads();
#pragma unroll 1
    for (int i = F.tid; i < 16 * 256; i += NTHR) {
        const int tt = i >> 8, c = i & 255; float a = dwb[c];
#pragma unroll 4
        for (int k = 0; k < 31; ++k) { const int ts = t0 + tt + k - 15; if (ts >= 0 && ts < seqlen) a += bf2f(Z[(size_t)(seqrow0 + ts) * 256 + c]) * dww[k * 256 + c]; }
        zc[i] = a;
    }
    __syncthreads();
    for (int tt = F.wave * 2; tt < F.wave * 2 + 2; ++tt) {
        float x[4]; float s = 0.f;
#pragma unroll
        for (int j = 0; j < 4; ++j) { x[j] = zc[tt * 256 + F.lane + 64 * j]; s += x[j]; }
        const float mu = wave_sum(s) * (1.f / 256.f); float q = 0.f;
#pragma unroll
        for (int j = 0; j < 4; ++j) { x[j] -= mu; q += x[j] * x[j]; }
        const float rs = 1.f / sqrtf(wave_sum(q) * (1.f / 256.f) + EPS);
#pragma unroll
        for (int j = 0; j < 4; ++j) { const int c = F.lane + 64 * j; const float y = x[j] * rs * F.in[I_LNG][l * 256 + c] + F.in[I_LNB][l * 256 + c]; zc[tt * 256 + c] = silu_f(y); }
    }
    __syncthreads();
    const float* pw = F.in[I_PWW] + (size_t)l * 256 * 256; const float* pb = F.in[I_PWB] + l * 256;
#pragma unroll 1
    for (int i = F.tid; i < 16 * 256; i += NTHR) {
        const int tt = i >> 8, c = i & 255; float a = pb[c];
#pragma unroll 8
        for (int k = 0; k < 256; ++k) a += zc[tt * 256 + k] * pw[k * 256 + c];
        F.Y[(size_t)(row0 + tt) * D + 256 + c] = (bf16_t)f2bf(a);
    }
}
__device__ __forceinline__ void phase_mixers_naive(Frame& F, int l, bool with_ctx) {
    const int NA_U = with_ctx ? 264 : 256;
#define UNIT_DECODE const bool cu = u >= 256; const int nq = cu ? LC : S; const int idx = cu ? u - 256 : u; const int q0 = idx * 256 + (F.tid >> 1), dh = F.tid & 1; \
        const int b = q0 / (4 * nq), h = (q0 / nq) % 4, t = q0 % nq; const int row = cu ? ROWS_L + b * LC + t : b * S + t;
#pragma unroll 1
    for (int u = F.bid; u < NA_U; u += F.G) { UNIT_DECODE
        const bf16_t* qp = F.SEAM + (cu ? SE_QGC : SE_QG) + (((size_t)b * 4 + h) * nq + t) * 64;
        const size_t kvo = ((size_t)b * 2 + (h >> 1)) * KV * 64;
        naive_attn(qp, F.SEAM + SE_KG + kvo, F.SEAM + SE_VG + kvo, cu ? LC : KV, dh, F.Y + (size_t)row * D + 512 + h * 64 + 32 * dh);
    }
    asm volatile("" ::: "memory");
#pragma unroll 1
    for (int u = F.G - 1 - F.bid; u < NA_U; u += F.G) { UNIT_DECODE
        const bf16_t* qp = F.SEAM + (cu ? SE_QDC : SE_QD) + (((size_t)b * 4 + h) * nq + t) * 64;
        const size_t kvo = ((size_t)b * 4 + h) * KV * 64;
        naive_diff(F, l, qp, F.SEAM + SE_KD + kvo, F.SEAM + SE_VD + kvo, cu ? LC : KV, dh, F.Y + (size_t)row * D + 768 + h * 64 + 32 * dh);
    }
    asm volatile("" ::: "memory");
#pragma unroll 1
    for (int u = F.bid; u < NA_U; u += F.G) { UNIT_DECODE
        if (cu) { const bf16_t* qp = F.SEAM + SE_QAC + (((size_t)b * 4 + h) * LC + t) * 64; const size_t kvo = ((size_t)b * 4 + h) * KV * 64;
            naive_attn(qp, F.SEAM + SE_KA + kvo, F.SEAM + SE_VA + kvo, LC, dh, F.Y + (size_t)row * D + h * 64 + 32 * dh); }
        else naive_na(F, l, b, h, t, dh, F.Y + (size_t)row * D + h * 64 + 32 * dh);
    }
#undef UNIT_DECODE
    asm volatile("" ::: "memory");
#pragma unroll 1
    for (int u = F.bid; u < (with_ctx ? 1056 : 1024); u += F.G) { if (u < 1024) phase_conv_naive(F, l, u, false); else phase_conv_naive(F, l, u - 1024, true); }
    __syncthreads();
}

#ifndef PHMASK
#define PHMASK 0xffffffffu
#endif
#define REFRESH() do { asm volatile("" : "+v"(F.tid)); F.lane = F.tid & 63; F.wave = __builtin_amdgcn_readfirstlane(F.tid >> 6); } while (0)
#define PHX(i, call) do { if ((PHMASK >> (i)) & 1u) { REFRESH(); call; } } while (0)
constexpr int PH_PER_LAYER = 9;
constexpr int NPH = 1 + DEPTH * PH_PER_LAYER + 1;

__global__ void __launch_bounds__(NTHR, 2) mk_fwd(Args args) {
    extern __shared__ __attribute__((aligned(16))) unsigned char lds[];
    Frame F;
    F.lds = (LAS unsigned char*)lds;
    F.tid = threadIdx.x; F.lane = F.tid & 63; F.wave = __builtin_amdgcn_readfirstlane(F.tid >> 6);
    F.G = gridDim.x; F.bid = blockIdx.x;
    F.in = args.in; F.out = args.out; F.ws = args.ws;
    unsigned char* ws = args.ws;
    F.tab = (float*)(ws + WS_TAB); F.H = (float*)(ws + WS_H); F.U = (bf16_t*)(ws + WS_U); F.AFF = (float*)(ws + WS_AFF); F.SLOT = (int*)(ws + WS_SLOT);
    F.RIDX = (int*)(ws + WS_RIDX); F.GATE = (float*)(ws + WS_RIDX + 256 * 1024);
    F.SEAM = (bf16_t*)(ws + WS_SEAM); F.Y = (bf16_t*)(ws + WS_Y); F.HE = (bf16_t*)(ws + WS_HE); F.YE = (bf16_t*)(ws + WS_YE); F.P = (float*)(ws + WS_P);
    for (int u = F.tid; u < (LDS_BYTES - LDSCTL_OFF) / 4; u += NTHR) ((LAS unsigned*)(F.lds + LDSCTL_OFF))[u] = 0u;
    __syncthreads();
    XcdBarrier bar; bar.bar = (unsigned*)(ws + WS_CTL) + CW_BAR; bar.x = 0; bar.st = nullptr;
    const bool one = (MK_N_LAUNCHES == 1);
    if (one) bar = xcd_barrier_post((unsigned*)(ws + WS_CTL) + CW_BAR, (volatile LAS unsigned*)(F.lds + MISC_OFF) + 8);
    const int lo = args.ph_lo, hi = args.ph_hi;
#define IN(k) (lo <= (k) && (k) < hi)
#define SEAM_BAR(k) do { if (one && (k) + 1 < hi) xcd_barrier(bar); } while (0)
    if (IN(0)) { PHX(0, phase_prologue(F)); SEAM_BAR(0); }
#pragma unroll 1
    for (int l = 0; l < DEPTH; ++l) {
        const int pb = 1 + l * PH_PER_LAYER; const bool wc = (l < DEPTH - 1);
        if (IN(pb + 0)) { REFRESH(); if (l == 0) phase_norm<0>(F, 0, true, -1, true); else phase_norm<0>(F, l, false, l - 1, true); SEAM_BAR(pb + 0); }
        if (IN(pb + 1)) { PHX(1, phase_inproj_naive(F, l)); SEAM_BAR(pb + 1); }
        if (IN(pb + 2)) { PHX(2, phase_post_naive(F, l)); SEAM_BAR(pb + 2); }
        if (IN(pb + 3)) { PHX(3, phase_mixers_naive(F, l, wc)); SEAM_BAR(pb + 3); }
        if (IN(pb + 4)) { PHX(4, phase_outproj_naive(F, l, wc)); SEAM_BAR(pb + 4); }
        if (IN(pb + 5)) { PHX(5, phase_norm2_router(F, l, wc)); SEAM_BAR(pb + 5); }
        if (IN(pb + 6)) { PHX(6, phase_select_naive(F, wc)); SEAM_BAR(pb + 6); }
        if (IN(pb + 7)) { PHX(7, phase_moe1_naive(F, l, wc)); SEAM_BAR(pb + 7); }
        if (IN(pb + 8)) { PHX(8, phase_moe2_naive(F, l, wc)); SEAM_BAR(pb + 8); }
    }
    if (IN(NPH - 1)) { REFRESH(); phase_norm<2>(F, 0, false, DEPTH - 1, false); }
#undef IN
#undef SEAM_BAR
}

extern "C" void kernel_launch(void* const* d_in, const int* in_sizes, int n_in, void* d_out, int out_size, void* d_ws, size_t ws_size, hipStream_t stream) {
    static int grid = 0;
    if (grid == 0) {
        if (n_in != N_IN || out_size != ROWS_L * D || ws_size < WS_END) { fprintf(stderr, "kernel_launch: unexpected shapes (n_in %d out %d ws %zu)\n", n_in, out_size, ws_size); grid = -1; return; }
        int dev = 0, cus = 0, per_cu = 0;
        if (hipGetDevice(&dev) != hipSuccess || hipDeviceGetAttribute(&cus, hipDeviceAttributeMultiprocessorCount, dev) != hipSuccess) { grid = -1; return; }
        if (hipFuncSetAttribute((const void*)mk_fwd, hipFuncAttributeMaxDynamicSharedMemorySize, LDS_BYTES) != hipSuccess) { fprintf(stderr, "kernel_launch: hipFuncSetAttribute failed\n"); grid = -1; return; }
        if (hipOccupancyMaxActiveBlocksPerMultiprocessor(&per_cu, (const void*)mk_fwd, NTHR, LDS_BYTES) != hipSuccess || per_cu < 1) { fprintf(stderr, "kernel_launch: occupancy query says %d\n", per_cu); per_cu = 1; }
        (void)hipGetLastError();
        grid = cus;
    }
    if (grid < 0) return;
    (void)hipMemsetAsync((char*)d_ws + WS_CTL, 0, CTL_ZERO_BYTES, stream);
    Args a{};
    for (int i = 0; i < N_IN; ++i) a.in[i] = (const float*)d_in[i];
    a.out = (float*)d_out; a.ws = (unsigned char*)d_ws;
    if (MK_N_LAUNCHES == 1) { a.ph_lo = 0; a.ph_hi = NPH; hipLaunchKernelGGL(mk_fwd, dim3(grid), dim3(NTHR), LDS_BYTES, stream, a); }
    else for (int p = 0; p < NPH; ++p) { a.ph_lo = p; a.ph_hi = p + 1; hipLaunchKernelGGL(mk_fwd, dim3(grid), dim3(NTHR), LDS_BYTES, stream, a); }
}
```

```cpp
#include <hip/hip_runtime.h>
#include <cstdio>
#include <cstdint>

#ifndef MK_N_LAUNCHES
#define MK_N_LAUNCHES 1
#endif

constexpr int D = 1024, NB = 2, S = 8192, LC = 256, DEPTH = 2;
constexpr int ROWS_L = NB * S;
constexpr int ROWS_C = NB * LC;
constexpr int ROWS = ROWS_L + ROWS_C;
constexpr int KV = LC + S;
constexpr int DIN = 2560;
constexpr int NE = 16, CAP_L = 1024, CAP_C = 32;
constexpr int ESLOTS = 2 * CAP_L + 2 * CAP_C;
constexpr int EPAD = 2304;
constexpr float EPS = 1e-6f;
constexpr float LOG2E = 1.4426950408889634f;
constexpr int NWAVES = 8, NTHR = 512;

typedef unsigned short bf16_t;
typedef unsigned u32x4 __attribute__((ext_vector_type(4)));
typedef float f32x4 __attribute__((ext_vector_type(4)));

constexpr size_t MiB = 1u << 20;
constexpr size_t WS_CTL = 0;
constexpr size_t CTL_ZERO_BYTES = 64 * 1024;
constexpr size_t WS_TAB = 1 * MiB;
constexpr size_t WS_H = 2 * MiB;
constexpr size_t WS_U = 68 * MiB;
constexpr size_t WS_AFF = 101 * MiB;
constexpr size_t WS_SLOT = 103 * MiB;
constexpr size_t WS_RIDX = 105 * MiB;
constexpr size_t WS_WBF = 106 * MiB;
constexpr size_t WS_R = 314 * MiB;
constexpr size_t WS_END = 458 * MiB;
constexpr size_t WS_P = WS_WBF;
constexpr size_t WS_SEAM = WS_R;
constexpr size_t WS_Y = WS_R + 83 * MiB;
constexpr size_t WS_HE = WS_R;
constexpr size_t WS_YE = WS_R + 72 * MiB;

constexpr size_t SE_QA = 0;
constexpr size_t SE_QAC = SE_QA + (size_t)NB * 4 * S * 64;
constexpr size_t SE_KA = SE_QAC + (size_t)NB * 4 * LC * 64;
constexpr size_t SE_VA = SE_KA + (size_t)NB * 4 * KV * 64;
constexpr size_t SE_Z = SE_VA + (size_t)NB * 4 * KV * 64;
constexpr size_t SE_QG = SE_Z + (size_t)ROWS * 256;
constexpr size_t SE_QGC = SE_QG + (size_t)NB * 4 * S * 64;
constexpr size_t SE_KG = SE_QGC + (size_t)NB * 4 * LC * 64;
constexpr size_t SE_VG = SE_KG + (size_t)NB * 2 * KV * 64;
constexpr size_t SE_QD = SE_VG + (size_t)NB * 2 * KV * 64;
constexpr size_t SE_QDC = SE_QD + (size_t)NB * 4 * S * 64;
constexpr size_t SE_KD = SE_QDC + (size_t)NB * 4 * LC * 64;
constexpr size_t SE_VD = SE_KD + (size_t)NB * 4 * KV * 64;
constexpr size_t SE_END = SE_VD + (size_t)NB * 4 * KV * 64;
static_assert(SE_END == (size_t)ROWS * (DIN - 256), "seam map");
static_assert(SE_END * 2 <= 83 * MiB, "seam fits");

constexpr int TB_C64 = 0;
constexpr int TB_S64 = 2048;
constexpr int TB_C32 = 4096;
constexpr int TB_S32 = 5120;
constexpr int TB_MOD = 8192;
constexpr int TB_LAM = TB_MOD + DEPTH * 3 * 6144;

constexpr int CW_BAR = 1024;

enum { I_X = 0, I_C, I_CTX, I_CCTX, I_N1G, I_WMOD, I_BMOD, I_WIN, I_RPB, I_DWW, I_DWB, I_LNG, I_LNB, I_PWW, I_PWB,
       I_QNG, I_KNG, I_LQ1, I_LK1, I_LQ2, I_LK2, I_DNG, I_WOUT, I_N2G, I_WR, I_WG, I_WU, I_WD, I_FG, N_IN };

constexpr int LDS_BYTES = 147456;
constexpr int MISC_OFF = 131072 + 320;
constexpr int LDSCTL_OFF = 131072;

#define GAS __attribute__((address_space(1)))
#define LAS __attribute__((address_space(3)))

__device__ __forceinline__ float bf2f(bf16_t v) { return __uint_as_float((unsigned)v << 16); }
__device__ __forceinline__ unsigned f2bf(float f) { unsigned u = __float_as_uint(f); return (u + 0x7fffu + ((u >> 16) & 1u)) >> 16; }
__device__ __forceinline__ unsigned pk2(float lo, float hi) { return f2bf(lo) | (f2bf(hi) << 16); }
__device__ __forceinline__ float bflo(unsigned w) { return __uint_as_float(w << 16); }
__device__ __forceinline__ float bfhi(unsigned w) { return __uint_as_float(w & 0xffff0000u); }
__device__ __forceinline__ float wave_sum(float v) {
#pragma unroll
    for (int o = 1; o < 64; o <<= 1) v += __shfl_xor(v, o);
    return v;
}
__device__ __forceinline__ float silu_f(float x) { return x / (1.f + __expf(-x)); }
__device__ __forceinline__ int vzero() { int z; asm volatile("v_mov_b32 %0, 0" : "=v"(z)); return z; }

#define XB_TMO      128
#define XB_XCNT(j)  (256  + 64 * (j))
#define XB_XSUB(j)  (1280 + 64 * (j))
#define XB_XGEN(j)  (2304 + 64 * (j))
#define XB_TOP      3328
#define XB_TOPGEN   3392
#define XCD_BAR_WORDS 3456
#define XB_SPIN_CAP (1u << 22)
__device__ __forceinline__ unsigned xb_ld(unsigned* p)              { return __hip_atomic_load(p, __ATOMIC_RELAXED, __HIP_MEMORY_SCOPE_AGENT); }
__device__ __forceinline__ unsigned xb_add(unsigned* p, unsigned v) { return __hip_atomic_fetch_add(p, v, __ATOMIC_RELAXED, __HIP_MEMORY_SCOPE_AGENT); }
__device__ __forceinline__ unsigned xb_xcc_id() { return (unsigned)__builtin_amdgcn_s_getreg((3 << 11) | 20) & 0xFu; }
#define XB_SPIN(cond, bar) do { unsigned _sp = 0; while (cond) { __builtin_amdgcn_s_sleep(1); \
    if ((++_sp & 255u) == 0u) { if (xb_ld(&(bar)[XB_TMO])) break; if (_sp > XB_SPIN_CAP) { atomicAdd(&(bar)[XB_TMO], 1u); break; } } } } while (0)
struct XcdBarrier { unsigned* bar; unsigned x; volatile LAS unsigned* st; };
__device__ __forceinline__ XcdBarrier xcd_barrier_post(unsigned* bar, volatile LAS unsigned* st) {
    XcdBarrier b; b.bar = bar; b.x = xb_xcc_id(); b.st = st;
    if (threadIdx.x == 0) (void)xb_add(&bar[XB_XCNT(b.x)], 1u);
    return b;
}
__device__ __forceinline__ void xcd_barrier_complete(unsigned* bar, unsigned x, unsigned& nloc, unsigned& nx) {
    const unsigned G = gridDim.x * gridDim.y * gridDim.z;
    unsigned sum, cnt, mine, sp = 0u;
    for (;;) {
        sum = 0u; cnt = 0u; mine = 0u;
#pragma unroll
        for (unsigned j = 0; j < 16; ++j) { const unsigned c = xb_ld(&bar[XB_XCNT(j)]); sum += c; cnt += (c > 0u) ? 1u : 0u; mine = (j == x) ? c : mine; }
        if (sum == G) break;
        __builtin_amdgcn_s_sleep(1);
        if ((++sp & 255u) == 0u) { if (xb_ld(&bar[XB_TMO])) break; if (sp > XB_SPIN_CAP) { atomicAdd(&bar[XB_TMO], 1u); break; } }
    }
    nloc = mine > 0u ? mine : 1u; nx = cnt > 0u ? cnt : 1u;
}
__device__ __forceinline__ void xcd_barrier(const XcdBarrier& b) {
    asm volatile("s_waitcnt vmcnt(0)" ::: "memory");
    __syncthreads();
    if (threadIdx.x == 0) {
        unsigned* bar = b.bar;
        __builtin_amdgcn_s_waitcnt(0);
        unsigned nloc = b.st[0], nx = b.st[1];
        if (nloc == 0u) { xcd_barrier_complete(bar, b.x, nloc, nx); b.st[0] = nloc; b.st[1] = nx; }
        const unsigned old = xb_add(&bar[XB_XSUB(b.x)], 1u);
        const unsigned gen = old / nloc;
        if (old + 1u == (gen + 1u) * nloc) {
            __builtin_amdgcn_fence(__ATOMIC_RELEASE, "agent");
            asm volatile("s_waitcnt vmcnt(0)" ::: "memory");
            const unsigned og = xb_add(&bar[XB_TOP], 1u);
            const unsigned tg = og / nx;
            if (og + 1u == (tg + 1u) * nx) xb_add(&bar[XB_TOPGEN], 1u);
            else XB_SPIN(xb_ld(&bar[XB_TOPGEN]) == tg, bar);
            __builtin_amdgcn_fence(__ATOMIC_ACQUIRE, "agent");
            xb_add(&bar[XB_XGEN(b.x)], 1u);
            asm volatile("s_waitcnt vmcnt(0)" ::: "memory");
        } else {
            XB_SPIN(xb_ld(&bar[XB_XGEN(b.x)]) == gen, bar);
            __builtin_amdgcn_fence(__ATOMIC_ACQUIRE, "agent");
            asm volatile("s_waitcnt vmcnt(0)" ::: "memory");
        }
    }
    __syncthreads();
}

struct Args { const float* in[N_IN]; float* out; unsigned char* ws; int ph_lo, ph_hi; };
struct Frame {
    LAS unsigned char* lds;
    int tid, lane, wave, G, bid;
    const float* const* in;
    float* out; unsigned char* ws;
    float* tab; float* H; bf16_t* U; float* AFF; int* SLOT; int* RIDX; float* GATE;
    bf16_t* SEAM; bf16_t* Y; bf16_t* HE; bf16_t* YE; float* P;
};

__device__ __forceinline__ double inv_freq(int f, int nf) {
    const double r16 = 0.5623413251903491;
    const int steps = (nf == 16) ? f : 2 * f;
    double v = 1.0;
    for (int i = 0; i < steps; ++i) v *= r16;
    return v;
}
__device__ __forceinline__ void sincos_d(double x, double& s, double& c) {
    const double TWO_PI = 6.283185307179586476925286766559;
    const double k = __builtin_rint(x / TWO_PI);
    const double r = x - k * TWO_PI;
    const double r2 = r * r;
    double ts = 1.0, tc = 1.0, ss = 1.0, cs = 1.0;
#pragma unroll 1
    for (int n = 1; n <= 14; ++n) {
        tc *= -r2 / (double)((2 * n - 1) * (2 * n));
        ts *= -r2 / (double)((2 * n) * (2 * n + 1));
        cs += tc; ss += ts;
    }
    s = r * ss; c = cs;
}

__device__ __forceinline__ void phase_prologue(Frame& F) {
    const int gt = F.bid * NTHR + F.tid, NGT = F.G * NTHR;
    for (int i = gt; i < 128 * 16 + 128 * 8; i += NGT) {
        if (i < 2048) { const int pos = i >> 4, f = i & 15; double s, c; sincos_d((double)pos * inv_freq(f, 16), s, c); F.tab[TB_C64 + i] = (float)c; F.tab[TB_S64 + i] = (float)s; }
        else { const int j = i - 2048, pos = j >> 3, f = j & 7; double s, c; sincos_d((double)pos * inv_freq(f, 8), s, c); F.tab[TB_C32 + j] = (float)c; F.tab[TB_S32 + j] = (float)s; }
    }
    if (gt < DEPTH) {
        const int l = gt; float a = 0.f, b = 0.f;
        for (int i = 0; i < 32; ++i) { a += F.in[I_LQ1][l * 32 + i] * F.in[I_LK1][l * 32 + i]; b += F.in[I_LQ2][l * 32 + i] * F.in[I_LK2][l * 32 + i]; }
        const float lam_init = 0.8f - 0.6f * expf(-0.3f * (float)l);
        F.tab[TB_LAM + 2 * l] = expf(a) - expf(b) + lam_init; F.tab[TB_LAM + 2 * l + 1] = 1.f - lam_init;
    }
    LAS float* red = (LAS float*)F.lds;
    for (int u = F.bid; u < DEPTH * 96; u += F.G) {
        const int l = u / 96, n0 = (u % 96) * 64, ks = F.tid >> 6, nn = F.tid & 63;
        const float* W = F.in[I_WMOD] + (size_t)l * D * 6144 + n0 + nn;
        float a0 = 0.f, a1 = 0.f, a2 = 0.f;
        for (int k = ks * 128; k < ks * 128 + 128; ++k) {
            const float w = W[(size_t)k * 6144];
            a0 += silu_f(F.in[I_C][k]) * w; a1 += silu_f(F.in[I_C][D + k]) * w; a2 += silu_f(F.in[I_CCTX][k]) * w;
        }
        red[(ks * 3 + 0) * 64 + nn] = a0; red[(ks * 3 + 1) * 64 + nn] = a1; red[(ks * 3 + 2) * 64 + nn] = a2;
        __syncthreads();
        if (F.tid < 192) { const int v = F.tid >> 6; float s = 0.f;
            for (int q = 0; q < 8; ++q) s += red[(q * 3 + v) * 64 + nn];
            F.tab[TB_MOD + (l * 3 + v) * 6144 + n0 + nn] = s + F.in[I_BMOD][l * 6144 + n0 + nn]; }
        __syncthreads();
    }
}

template <int MODE> __device__ __forceinline__ void phase_norm(Frame& F, int l, bool src0, int comb_l, bool with_ctx) {
    const int gw = F.bid * NWAVES + F.wave, NGW = F.G * NWAVES;
    const int nrows = with_ctx ? ROWS : ROWS_L;
    for (int r = gw; r < nrows; r += NGW) {
        const bool isc = r >= ROWS_L; const int b = isc ? (r - ROWS_L) / LC : r / S; const int mv = isc ? 2 : b;
        const float* src = src0 ? (isc ? F.in[I_CTX] + (size_t)(r - ROWS_L) * D : F.in[I_X] + (size_t)r * D) : F.H + (size_t)r * D;
        f32x4 v[4];
#pragma unroll
        for (int j = 0; j < 4; ++j) v[j] = *(const f32x4*)(src + 4 * F.lane + 256 * j);
        if (comb_l >= 0) {
            const float* g2 = F.tab + TB_MOD + (comb_l * 3 + mv) * 6144 + 5 * D;
            const int* sl = F.SLOT + (size_t)r * 16;
            f32x4 acc[4];
#pragma unroll
            for (int j = 0; j < 4; ++j) acc[j] = (f32x4){0.f, 0.f, 0.f, 0.f};
            for (int e = 0; e < NE; ++e) {
                const int s_ = sl[e];
                if (s_ >= 0) {
                    const int base = isc ? 2 * CAP_L + b * CAP_C : b * CAP_L;
                    const bf16_t* y = F.YE + ((size_t)e * EPAD + base + s_) * D;
#pragma unroll
                    for (int j = 0; j < 4; ++j) { const uint2 w = *(const uint2*)(y + 4 * F.lane + 256 * j);
                        acc[j][0] += bflo(w.x); acc[j][1] += bfhi(w.x); acc[j][2] += bflo(w.y); acc[j][3] += bfhi(w.y); }
                }
            }
#pragma unroll
            for (int j = 0; j < 4; ++j) { const f32x4 g = *(const f32x4*)(g2 + 4 * F.lane + 256 * j); v[j] += g * acc[j]; *(f32x4*)(F.H + (size_t)r * D + 4 * F.lane + 256 * j) = v[j]; }
        }
        float ss = 0.f;
#pragma unroll
        for (int j = 0; j < 4; ++j) ss += (v[j][0] * v[j][0] + v[j][1] * v[j][1]) + (v[j][2] * v[j][2] + v[j][3] * v[j][3]);
        const float rs = 1.f / sqrtf(wave_sum(ss) * (1.f / D) + EPS);
        if (MODE == 2) {
#pragma unroll
            for (int j = 0; j < 4; ++j) { const f32x4 g = *(const f32x4*)(F.in[I_FG] + 4 * F.lane + 256 * j); *(f32x4*)(F.out + (size_t)r * D + 4 * F.lane + 256 * j) = v[j] * rs * g; }
        } else {
            const float* md = F.tab + TB_MOD + (l * 3 + mv) * 6144;
            const float* ng = F.in[I_N1G] + l * D;
#pragma unroll
            for (int j = 0; j < 4; ++j) { const int c0 = 4 * F.lane + 256 * j; const f32x4 g = *(const f32x4*)(ng + c0), sh = *(const f32x4*)(md + c0), sc = *(const f32x4*)(md + D + c0);
                const f32x4 u = (v[j] * rs * g) * (1.f + sc) + sh; uint2 w; w.x = pk2(u[0], u[1]); w.y = pk2(u[2], u[3]); *(uint2*)(F.U + (size_t)r * D + c0) = w; }
        }
    }
}

__device__ __forceinline__ void phase_norm2_router(Frame& F, int l, bool with_ctx) {
    LAS float* wr = (LAS float*)F.lds;
    for (int i = F.tid; i < D * NE; i += NTHR) wr[i] = F.in[I_WR][(size_t)l * D * NE + i];
    __syncthreads();
    const int gw = F.bid * NWAVES + F.wave, NGW = F.G * NWAVES;
    const int nrows = with_ctx ? ROWS : ROWS_L;
    for (int r = gw; r < nrows; r += NGW) {
        const bool isc = r >= ROWS_L; const int b = isc ? (r - ROWS_L) / LC : r / S; const int mv = isc ? 2 : b;
        const float* src = F.H + (size_t)r * D;
        const float* md = F.tab + TB_MOD + (l * 3 + mv) * 6144;
        const float* ng = F.in[I_N2G] + l * D;
        f32x4 v[4]; float ss = 0.f;
#pragma unroll
        for (int j = 0; j < 4; ++j) { v[j] = *(const f32x4*)(src + 4 * F.lane + 256 * j); ss += (v[j][0] * v[j][0] + v[j][1] * v[j][1]) + (v[j][2] * v[j][2] + v[j][3] * v[j][3]); }
        const float rs = 1.f / sqrtf(wave_sum(ss) * (1.f / D) + EPS);
        float lg[NE];
#pragma unroll
        for (int e = 0; e < NE; ++e) lg[e] = 0.f;
#pragma unroll
        for (int j = 0; j < 4; ++j) { const int c0 = 4 * F.lane + 256 * j; const f32x4 g = *(const f32x4*)(ng + c0), sh = *(const f32x4*)(md + 3 * D + c0), sc = *(const f32x4*)(md + 4 * D + c0);
            const f32x4 u = (v[j] * rs * g) * (1.f + sc) + sh; uint2 w; w.x = pk2(u[0], u[1]); w.y = pk2(u[2], u[3]); *(uint2*)(F.U + (size_t)r * D + c0) = w;
#pragma unroll
            for (int i = 0; i < 4; ++i) {
#pragma unroll
                for (int e4 = 0; e4 < 4; ++e4) { const f32x4 ww = *(const LAS f32x4*)(wr + (c0 + i) * NE + 4 * e4);
                    lg[4 * e4 + 0] += u[i] * ww[0]; lg[4 * e4 + 1] += u[i] * ww[1]; lg[4 * e4 + 2] += u[i] * ww[2]; lg[4 * e4 + 3] += u[i] * ww[3]; }
                asm volatile("" ::: "memory");
            }
        }
        float mx = -1e30f;
#pragma unroll
        for (int e = 0; e < NE; ++e) { lg[e] = wave_sum(lg[e]); mx = fmaxf(mx, lg[e]); }
        float sm = 0.f;
#pragma unroll
        for (int e = 0; e < NE; ++e) { lg[e] = expf(lg[e] - mx); sm += lg[e]; }
        const float inv = 1.f / sm;
        float mine = 0.f;
#pragma unroll
        for (int e = 0; e < NE; ++e) mine = (F.lane == e) ? lg[e] * inv : mine;
        if (F.lane < NE) F.AFF[(size_t)r * NE + F.lane] = mine;
    }
    __syncthreads();
}

__device__ __forceinline__ void phase_select_naive(Frame& F, bool with_ctx) {
    LAS float* col = (LAS float*)F.lds;
    const int NU = 32 * 16 + (with_ctx ? 32 : 0);
    for (int i = F.bid * NTHR + F.tid; i < NE * EPAD; i += F.G * NTHR) { const int sl = i % EPAD; if (sl >= (with_ctx ? ESLOTS : 2 * CAP_L)) { F.RIDX[i] = -1; F.GATE[i] = 0.f; } }
    for (int u = F.bid; u < NU; u += F.G) {
        const bool isc = u >= 512; const int li = isc ? u - 512 : u / 16, ch = isc ? 0 : u % 16, b = li / NE, e = li % NE;
        const int N = isc ? LC : S, C = isc ? CAP_C : CAP_L, row0 = isc ? ROWS_L + b * LC : b * S;
        __syncthreads();
        for (int i = F.tid; i < N; i += NTHR) col[i] = F.AFF[(size_t)(row0 + i) * NE + e];
        __syncthreads();
        const int n = ch * 512 + F.tid;
        if (n < N) {
            const float a = col[n]; int rank = 0;
            for (int m = 0; m < N; ++m) { const float x = col[m]; rank += (x > a || (x == a && m < n)) ? 1 : 0; }
            if (rank < C) { const int sl = (isc ? 2 * CAP_L + b * CAP_C : b * CAP_L) + rank; F.RIDX[e * EPAD + sl] = row0 + n; F.GATE[e * EPAD + sl] = a; F.SLOT[(size_t)(row0 + n) * NE + e] = rank; }
            else F.SLOT[(size_t)(row0 + n) * NE + e] = -1;
        }
    }
    __syncthreads();
}

struct NaiveEpi { int mode; int l; float* P; const float* hin; float* hout; const float* mod; bf16_t* HE; bf16_t* YE; const float* gate; };
template <bool DUAL> __device__ __forceinline__ void naive_gemm_tile(Frame& F, const bf16_t* A, int lda, const int* ridx, int m0, int M, const float* W, const float* W2, int ldw, int n0, int K, const NaiveEpi& E, int erow0) {
    LAS float* As = (LAS float*)F.lds;
    LAS float* Bs = As + 16 * 132;
    LAS float* Bs2 = Bs + 16 * 64;
    const int ty = F.tid >> 4, tx = F.tid & 15;
    float acc[4][4], acc2[4][4];
#pragma unroll
    for (int i = 0; i < 4; ++i)
#pragma unroll
        for (int j = 0; j < 4; ++j) { acc[i][j] = 0.f; acc2[i][j] = 0.f; }
    const int ar = F.tid >> 1, ah = F.tid & 1;
    long arow = -1;
    if (F.tid < 256) { const int m = m0 + ar; if (m < M) arow = ridx ? (long)ridx[m] : (long)m; }
    const int bk = (F.tid - 256) >> 4, bc = (F.tid - 256) & 15;
    for (int k0 = 0; k0 < K; k0 += 16) {
        __syncthreads();
        if (F.tid < 256) {
            u32x4 w = (u32x4){0u, 0u, 0u, 0u};
            if (arow >= 0) w = *(const u32x4*)(A + (size_t)arow * lda + k0 + ah * 8);
            const int kb = ah * 8;
            As[(kb + 0) * 132 + ar] = bflo(w.x); As[(kb + 1) * 132 + ar] = bfhi(w.x); As[(kb + 2) * 132 + ar] = bflo(w.y); As[(kb + 3) * 132 + ar] = bfhi(w.y);
            As[(kb + 4) * 132 + ar] = bflo(w.z); As[(kb + 5) * 132 + ar] = bfhi(w.z); As[(kb + 6) * 132 + ar] = bflo(w.w); As[(kb + 7) * 132 + ar] = bfhi(w.w);
        } else {
            *(LAS f32x4*)(Bs + bk * 64 + bc * 4) = *(const f32x4*)(W + (size_t)(k0 + bk) * ldw + n0 + bc * 4);
            if (DUAL) *(LAS f32x4*)(Bs2 + bk * 64 + bc * 4) = *(const f32x4*)(W2 + (size_t)(k0 + bk) * ldw + n0 + bc * 4);
        }
        __syncthreads();
#pragma unroll
        for (int k = 0; k < 16; ++k) {
            const f32x4 a = *(const LAS f32x4*)(As + k * 132 + ty * 4), b = *(const LAS f32x4*)(Bs + k * 64 + tx * 4);
#pragma unroll
            for (int i = 0; i < 4; ++i)
#pragma unroll
                for (int j = 0; j < 4; ++j) acc[i][j] += a[i] * b[j];
            if (DUAL) { const f32x4 b2 = *(const LAS f32x4*)(Bs2 + k * 64 + tx * 4);
#pragma unroll
                for (int i = 0; i < 4; ++i)
#pragma unroll
                    for (int j = 0; j < 4; ++j) acc2[i][j] += a[i] * b2[j]; }
        }
    }
#pragma unroll
    for (int i = 0; i < 4; ++i) {
        const int m = m0 + ty * 4 + i; if (m >= M) continue;
        const int c0 = n0 + tx * 4;
        if (E.mode == 0) { *(f32x4*)(E.P + (size_t)m * DIN + c0) = (f32x4){acc[i][0], acc[i][1], acc[i][2], acc[i][3]}; }
        else if (E.mode == 1) {
            const bool isc = m >= ROWS_L; const int b = isc ? (m - ROWS_L) / LC : m / S; const int mv = isc ? 2 : b;
            const f32x4 g = *(const f32x4*)(E.mod + (E.l * 3 + mv) * 6144 + 2 * D + c0);
            const float* hi_ = (E.hin == nullptr) ? (isc ? F.in[I_CTX] + (size_t)(m - ROWS_L) * D : F.in[I_X] + (size_t)m * D) : E.hin + (size_t)m * D;
            const f32x4 h = *(const f32x4*)(hi_ + c0);
            *(f32x4*)(E.hout + (size_t)m * D + c0) = h + g * (f32x4){acc[i][0], acc[i][1], acc[i][2], acc[i][3]};
        } else if (E.mode == 2) {
            uint2 w; w.x = pk2(silu_f(acc[i][0]) * acc2[i][0], silu_f(acc[i][1]) * acc2[i][1]); w.y = pk2(silu_f(acc[i][2]) * acc2[i][2], silu_f(acc[i][3]) * acc2[i][3]);
            *(uint2*)(E.HE + (size_t)(erow0 + m) * D + c0) = w;
        } else {
            const float g = E.gate[erow0 + m];
            uint2 w; w.x = pk2(g * acc[i][0], g * acc[i][1]); w.y = pk2(g * acc[i][2], g * acc[i][3]);
            *(uint2*)(E.YE + (size_t)(erow0 + m) * D + c0) = w;
        }
    }
}

__device__ __forceinline__ void phase_inproj_naive(Frame& F, int l) {
    NaiveEpi E{}; E.mode = 0; E.P = F.P;
    const int nM = ROWS / 128, nN = DIN / 64;
    for (int u = F.bid; u < nM * nN; u += F.G) { const int pm = u / nN, pn = u % nN;
        naive_gemm_tile<false>(F, F.U, D, nullptr, pm * 128, ROWS, F.in[I_WIN] + (size_t)l * D * DIN, nullptr, DIN, pn * 64, D, E, 0); }
    __syncthreads();
}
__device__ __forceinline__ void phase_outproj_naive(Frame& F, int l, bool with_ctx) {
    NaiveEpi E{}; E.mode = 1; E.l = l; E.hin = (l == 0) ? nullptr : F.H; E.hout = F.H; E.mod = F.tab + TB_MOD;
    const int M = with_ctx ? ROWS : ROWS_L; const int nM = M / 128, nN = D / 64;
    for (int u = F.bid; u < nM * nN; u += F.G) { const int pm = u / nN, pn = u % nN;
        naive_gemm_tile<false>(F, F.Y, D, nullptr, pm * 128, M, F.in[I_WOUT] + (size_t)l * D * D, nullptr, D, pn * 64, D, E, 0); }
    __syncthreads();
}
__device__ __forceinline__ void phase_moe1_naive(Frame& F, int l, bool with_ctx) {
    NaiveEpi E{}; E.mode = 2; E.HE = F.HE;
    const int M = with_ctx ? ESLOTS : 2 * CAP_L; const int nM = (M + 127) / 128, nN = D / 64;
    for (int u = F.bid; u < NE * nM * nN; u += F.G) { const int e = u / (nM * nN), r = u % (nM * nN), pm = r / nN, pn = r % nN;
        naive_gemm_tile<true>(F, F.U, D, F.RIDX + e * EPAD, pm * 128, M, F.in[I_WG] + ((size_t)l * NE + e) * D * D, F.in[I_WU] + ((size_t)l * NE + e) * D * D, D, pn * 64, D, E, e * EPAD); }
    __syncthreads();
}
__device__ __forceinline__ void phase_moe2_naive(Frame& F, int l, bool with_ctx) {
    NaiveEpi E{}; E.mode = 3; E.YE = F.YE; E.gate = F.GATE;
    const int M = with_ctx ? ESLOTS : 2 * CAP_L; const int nM = (M + 127) / 128, nN = D / 64;
    for (int u = F.bid; u < NE * nM * nN; u += F.G) { const int e = u / (nM * nN), r = u % (nM * nN), pm = r / nN, pn = r % nN;
        naive_gemm_tile<false>(F, F.HE + (size_t)e * EPAD * D, D, nullptr, pm * 128, M, F.in[I_WD] + ((size_t)l * NE + e) * D * D, nullptr, D, pn * 64, D, E, e * EPAD); }
    __syncthreads();
}

__device__ __forceinline__ void store64(bf16_t* dst, const float (&v)[64]) {
#pragma unroll
    for (int i = 0; i < 8; ++i) { u32x4 w; w.x = pk2(v[8 * i], v[8 * i + 1]); w.y = pk2(v[8 * i + 2], v[8 * i + 3]); w.z = pk2(v[8 * i + 4], v[8 * i + 5]); w.w = pk2(v[8 * i + 6], v[8 * i + 7]); *(u32x4*)(dst + 8 * i) = w; }
}
template <int DIM, int OFF> __device__ __forceinline__ void rope_vec(float (&v)[64], const float* tab, int t) {
    constexpr int half = DIM / 2, nf = half / 2;
    const int pr = t >> 6, pc = t & 63;
    const float* C = tab + (DIM == 64 ? TB_C64 : TB_C32); const float* Sn = tab + (DIM == 64 ? TB_S64 : TB_S32);
#pragma unroll
    for (int i = 0; i < half; ++i) {
        const int pos = (i < nf) ? pr : pc, f = (i < nf) ? i : i - nf;
        const float c = C[pos * nf + f], s = Sn[pos * nf + f];
        const float x1 = v[OFF + i], x2 = v[OFF + half + i];
        v[OFF + i] = x1 * c - x2 * s; v[OFF + half + i] = x2 * c + x1 * s;
    }
}
__device__ __forceinline__ void phase_post_naive(Frame& F, int l) {
    const long NT = (long)ROWS * 40;
    for (long it = (long)F.bid * NTHR + F.tid; it < NT; it += (long)F.G * NTHR) {
        const int r = (int)(it / 40), u = (int)(it % 40);
        if (u >= 16 && u < 20) continue;
        const bool isc = r >= ROWS_L; const int b = isc ? (r - ROWS_L) / LC : r / S; const int t = isc ? (r - ROWS_L) % LC : r % S;
        const int key = isc ? t : LC + t;
        const float* p = F.P + (size_t)r * DIN + 64 * u;
        float v[64];
#pragma unroll
        for (int i = 0; i < 16; ++i) { const f32x4 x = *(const f32x4*)(p + 4 * i); v[4 * i] = x[0]; v[4 * i + 1] = x[1]; v[4 * i + 2] = x[2]; v[4 * i + 3] = x[3]; }
        bf16_t* dst;
        if (u < 4) {
            const float sc = 0.125f * LOG2E;
#pragma unroll
            for (int i = 0; i < 64; ++i) v[i] *= sc;
            dst = isc ? F.SEAM + SE_QAC + (((size_t)b * 4 + u) * LC + t) * 64 : F.SEAM + SE_QA + (((size_t)b * 4 + u) * S + t) * 64;
        } else if (u < 8) { dst = F.SEAM + SE_KA + (((size_t)b * 4 + (u - 4)) * KV + key) * 64; }
        else if (u < 12) { dst = F.SEAM + SE_VA + (((size_t)b * 4 + (u - 8)) * KV + key) * 64; }
        else if (u < 16) {
            const float* pg = p + 256;
#pragma unroll
            for (int i = 0; i < 16; ++i) { const f32x4 g = *(const f32x4*)(pg + 4 * i);
                v[4 * i] *= 1.f / (1.f + __expf(-g[0])); v[4 * i + 1] *= 1.f / (1.f + __expf(-g[1])); v[4 * i + 2] *= 1.f / (1.f + __expf(-g[2])); v[4 * i + 3] *= 1.f / (1.f + __expf(-g[3])); }
            dst = F.SEAM + SE_Z + (size_t)r * 256 + 64 * (u - 12);
        } else if (u < 24) {
            const int hq = u - 20; const float* g = F.in[I_QNG] + l * 64; float ss = 0.f;
#pragma unroll
            for (int i = 0; i < 64; ++i) ss += v[i] * v[i];
            const float rs = 1.f / sqrtf(ss * (1.f / 64.f) + EPS);
#pragma unroll
            for (int i = 0; i < 64; ++i) v[i] = v[i] * rs * g[i];
            if (!isc) rope_vec<64, 0>(v, F.tab, t);
            const float sc = 0.125f * LOG2E;
#pragma unroll
            for (int i = 0; i < 64; ++i) v[i] *= sc;
            dst = isc ? F.SEAM + SE_QGC + (((size_t)b * 4 + hq) * LC + t) * 64 : F.SEAM + SE_QG + (((size_t)b * 4 + hq) * S + t) * 64;
        } else if (u < 26) {
            const int hk = u - 24; const float* g = F.in[I_KNG] + l * 64; float ss = 0.f;
#pragma unroll
            for (int i = 0; i < 64; ++i) ss += v[i] * v[i];
            const float rs = 1.f / sqrtf(ss * (1.f / 64.f) + EPS);
#pragma unroll
            for (int i = 0; i < 64; ++i) v[i] = v[i] * rs * g[i];
            if (!isc) rope_vec<64, 0>(v, F.tab, t);
            dst = F.SEAM + SE_KG + (((size_t)b * 2 + hk) * KV + key) * 64;
        } else if (u < 28) { dst = F.SEAM + SE_VG + (((size_t)b * 2 + (u - 26)) * KV + key) * 64; }
        else if (u < 32) {
            const int h = u - 28;
            if (!isc) { rope_vec<32, 0>(v, F.tab, t); rope_vec<32, 32>(v, F.tab, t); }
            const float sc = 0.17677669529663687f * LOG2E;
#pragma unroll
            for (int i = 0; i < 64; ++i) v[i] *= sc;
            dst = isc ? F.SEAM + SE_QDC + (((size_t)b * 4 + h) * LC + t) * 64 : F.SEAM + SE_QD + (((size_t)b * 4 + h) * S + t) * 64;
        } else if (u < 36) {
            const int h = u - 32;
            if (!isc) { rope_vec<32, 0>(v, F.tab, t); rope_vec<32, 32>(v, F.tab, t); }
            dst = F.SEAM + SE_KD + (((size_t)b * 4 + h) * KV + key) * 64;
        } else { dst = F.SEAM + SE_VD + (((size_t)b * 4 + (u - 36)) * KV + key) * 64; }
        store64(dst, v);
    }
}

__device__ __forceinline__ void load64(float (&v)[64], const bf16_t* p) {
#pragma unroll
    for (int i = 0; i < 8; ++i) { const u32x4 w = *(const u32x4*)(p + 8 * i);
        v[8 * i] = bflo(w.x); v[8 * i + 1] = bfhi(w.x); v[8 * i + 2] = bflo(w.y); v[8 * i + 3] = bfhi(w.y); v[8 * i + 4] = bflo(w.z); v[8 * i + 5] = bfhi(w.z); v[8 * i + 6] = bflo(w.w); v[8 * i + 7] = bfhi(w.w); }
}
struct Q64 { u32x4 w[8]; };
__device__ __forceinline__ void loadq(Q64& q, const bf16_t* p) {
#pragma unroll
    for (int i = 0; i < 8; ++i) q.w[i] = *(const u32x4*)(p + 8 * i);
}
__device__ __forceinline__ float dot8(u32x4 a, const u32x4 w, float s) {
    asm volatile("" : "+v"(a));
    s += bflo(a.x) * bflo(w.x); s += bfhi(a.x) * bfhi(w.x); s += bflo(a.y) * bflo(w.y); s += bfhi(a.y) * bfhi(w.y);
    s += bflo(a.z) * bflo(w.z); s += bfhi(a.z) * bfhi(w.z); s += bflo(a.w) * bflo(w.w); s += bfhi(a.w) * bfhi(w.w); return s;
}
__device__ __forceinline__ float dot64(const Q64& q, const bf16_t* k) {
    float s0 = 0.f, s1 = 0.f;
#pragma unroll
    for (int i = 0; i < 8; i += 2) { s0 = dot8(q.w[i], *(const u32x4*)(k + 8 * i), s0); s1 = dot8(q.w[i + 1], *(const u32x4*)(k + 8 * i + 8), s1); }
    return s0 + s1;
}
template <int OFF> __device__ __forceinline__ float dot32(const Q64& q, const bf16_t* k) {
    float s0 = 0.f, s1 = 0.f;
#pragma unroll
    for (int i = 0; i < 4; i += 2) { s0 = dot8(q.w[OFF / 8 + i], *(const u32x4*)(k + OFF + 8 * i), s0); s1 = dot8(q.w[OFF / 8 + i + 1], *(const u32x4*)(k + OFF + 8 * i + 8), s1); }
    return s0 + s1;
}
__device__ __forceinline__ void axpy64(float (&o)[64], float p, const bf16_t* vrow) {
#pragma unroll
    for (int i = 0; i < 8; ++i) { const u32x4 w = *(const u32x4*)(vrow + 8 * i);
        o[8 * i] += p * bflo(w.x); o[8 * i + 1] += p * bfhi(w.x); o[8 * i + 2] += p * bflo(w.y); o[8 * i + 3] += p * bfhi(w.y);
        o[8 * i + 4] += p * bflo(w.z); o[8 * i + 5] += p * bfhi(w.z); o[8 * i + 6] += p * bflo(w.w); o[8 * i + 7] += p * bfhi(w.w); }
}
#define OSM_STEP(m, lsum, o, s, vrow) do { if ((s) > (m)) { const float f_ = exp2f((m) - (s)); (lsum) *= f_; _Pragma("unroll") for (int i_ = 0; i_ < 64; ++i_) (o)[i_] *= f_; (m) = (s); } \
    const float p_ = exp2f((s) - (m)); (lsum) += p_; axpy64((o), p_, (vrow)); } while (0)

__device__ __forceinline__ void axpy32(float (&o)[32], float p, const bf16_t* vrow) {
#pragma unroll
    for (int i = 0; i < 4; ++i) { const u32x4 w = *(const u32x4*)(vrow + 8 * i);
        o[8 * i] += p * bflo(w.x); o[8 * i + 1] += p * bfhi(w.x); o[8 * i + 2] += p * bflo(w.y); o[8 * i + 3] += p * bfhi(w.y);
        o[8 * i + 4] += p * bflo(w.z); o[8 * i + 5] += p * bfhi(w.z); o[8 * i + 6] += p * bflo(w.w); o[8 * i + 7] += p * bfhi(w.w); }
}
#define OSM_STEP32(m, lsum, o, s, vrow) do { if ((s) > (m)) { const float f_ = exp2f((m) - (s)); (lsum) *= f_; _Pragma("unroll") for (int i_ = 0; i_ < 32; ++i_) (o)[i_] *= f_; (m) = (s); } \
    const float p_ = exp2f((s) - (m)); (lsum) += p_; axpy32((o), p_, (vrow)); } while (0)
__device__ __forceinline__ void naive_diff(Frame& F, int l, const bf16_t* qp, const bf16_t* K, const bf16_t* V, int nk, int dh, bf16_t* dst) {
    Q64 q; loadq(q, qp);
    float o1[32], o2[32]; float m1 = -1e30f, l1 = 0.f, m2 = -1e30f, l2 = 0.f;
#pragma unroll
    for (int i = 0; i < 32; ++i) { o1[i] = 0.f; o2[i] = 0.f; }
    const int z = vzero();
#pragma unroll 1
    for (int j = 0; j < nk; ++j) {
        const bf16_t* kr = K + (size_t)(j + z) * 64; const bf16_t* vr = V + (size_t)(j + z) * 64 + 32 * dh;
        const float s1 = dot32<0>(q, kr), s2 = dot32<32>(q, kr);
        OSM_STEP32(m1, l1, o1, s1, vr); OSM_STEP32(m2, l2, o2, s2, vr);
    }
    const float lam = F.tab[TB_LAM + 2 * l], oml = F.tab[TB_LAM + 2 * l + 1];
    const float i1 = 1.f / l1, i2 = lam / l2; float ss = 0.f;
#pragma unroll
    for (int i = 0; i < 32; ++i) { o1[i] = o1[i] * i1 - o2[i] * i2; ss += o1[i] * o1[i]; }
    ss += __shfl_xor(ss, 1);
    const float rs = oml / sqrtf(ss * (1.f / 64.f) + EPS);
    const float* g = F.in[I_DNG] + l * 64 + 32 * dh;
#pragma unroll
    for (int i = 0; i < 4; ++i) { u32x4 w; w.x = pk2(o1[8 * i] * rs * g[8 * i], o1[8 * i + 1] * rs * g[8 * i + 1]); w.y = pk2(o1[8 * i + 2] * rs * g[8 * i + 2], o1[8 * i + 3] * rs * g[8 * i + 3]);
        w.z = pk2(o1[8 * i + 4] * rs * g[8 * i + 4], o1[8 * i + 5] * rs * g[8 * i + 5]); w.w = pk2(o1[8 * i + 6] * rs * g[8 * i + 6], o1[8 * i + 7] * rs * g[8 * i + 7]); *(u32x4*)(dst + 8 * i) = w; }
}
__device__ __forceinline__ void store32n(bf16_t* dst, const float (&o)[32], float inv) {
#pragma unroll
    for (int i = 0; i < 4; ++i) { u32x4 w; w.x = pk2(o[8 * i] * inv, o[8 * i + 1] * inv); w.y = pk2(o[8 * i + 2] * inv, o[8 * i + 3] * inv);
        w.z = pk2(o[8 * i + 4] * inv, o[8 * i + 5] * inv); w.w = pk2(o[8 * i + 6] * inv, o[8 * i + 7] * inv); *(u32x4*)(dst + 8 * i) = w; }
}
__device__ __forceinline__ void naive_attn(const bf16_t* qp, const bf16_t* K, const bf16_t* V, int nk, int dh, bf16_t* dst) {
    Q64 q; loadq(q, qp);
    float o[32]; float m = -1e30f, ls = 0.f;
#pragma unroll
    for (int i = 0; i < 32; ++i) o[i] = 0.f;
    const int z = vzero();
#pragma unroll 1
    for (int j = 0; j < nk; ++j) { const float s = dot64(q, K + (size_t)(j + z) * 64); OSM_STEP32(m, ls, o, s, V + (size_t)(j + z) * 64 + 32 * dh); }
    store32n(dst, o, 1.f / ls);
}
__device__ __forceinline__ void naive_na(Frame& F, int l, int b, int h, int t, int dh, bf16_t* dst) {
    Q64 q; loadq(q, F.SEAM + SE_QA + (((size_t)b * 4 + h) * S + t) * 64);
    const bf16_t* K = F.SEAM + SE_KA + ((size_t)b * 4 + h) * KV * 64; const bf16_t* V = F.SEAM + SE_VA + ((size_t)b * 4 + h) * KV * 64 + 32 * dh;
    const float* rpb = F.in[I_RPB] + ((size_t)l * 4 + h) * 15 * 31;
    const int r = t >> 6, jq = t & 63;
    int rs = r - 4; rs = rs < 0 ? 0 : (rs > 120 ? 120 : rs);
    int cs = jq - 8; cs = cs < 0 ? 0 : (cs > 48 ? 48 : cs);
    float o[32]; float m = -1e30f, ls = 0.f;
#pragma unroll
    for (int i = 0; i < 32; ++i) o[i] = 0.f;
#pragma unroll 1
    for (int kk = 0; kk < 128 + LC; ++kk) {
        int key; float bias = 0.f;
        if (kk < 128) { const int rr = rs + (kk >> 4), cc = cs + (kk & 15); key = LC + rr * 64 + cc;
            const int dr = rr - r + 7; int dc = cc - jq; dc = dc < -15 ? -15 : (dc > 15 ? 15 : dc); dc += 15; bias = rpb[dr * 31 + dc] * LOG2E; }
        else key = kk - 128;
        const float s = dot64(q, K + (size_t)key * 64) + bias;
        OSM_STEP32(m, ls, o, s, V + (size_t)key * 64);
    }
    store32n(dst, o, 1.f / ls);
}
__device__ __forceinline__ void phase_conv_naive(Frame& F, int l, int unit, bool ctxu) {
    LAS float* zc = (LAS float*)F.lds;
    const int row0 = ctxu ? ROWS_L + unit * 16 : unit * 16;
    const int seqlen = ctxu ? LC : S; const int t0 = (ctxu ? unit * 16 : unit * 16) % seqlen; const int seqrow0 = row0 - t0;
    const bf16_t* Z = F.SEAM + SE_Z;
    const float* dww = F.in[I_DWW] + (size_t)l * 31 * 256; const float* dwb = F.in[I_DWB] + l * 256;
    __syncthreads();
#pragma unroll 1
    for (int i = F.tid; i < 16 * 256; i += NTHR) {
        const int tt = i >> 8, c = i & 255; float a = dwb[c];
#pragma unroll 4
        for (int k = 0; k < 31; ++k) { const int ts = t0 + tt + k - 15; if (ts >= 0 && ts < seqlen) a += bf2f(Z[(size_t)(seqrow0 + ts) * 256 + c]) * dww[k * 256 + c]; }
        zc[i] = a;
    }
    __syncthreads();
    for (int tt = F.wave * 2; tt < F.wave * 2 + 2; ++tt) {
        float x[4]; float s = 0.f;
#pragma unroll
        for (int j = 0; j < 4; ++j) { x[j] = zc[tt * 256 + F.lane + 64 * j]; s += x[j]; }
        const float mu = wave_sum(s) * (1.f / 256.f); float q = 0.f;
#pragma unroll
        for (int j = 0; j < 4; ++j) { x[j] -= mu; q += x[j] * x[j]; }
        const float rs = 1.f / sqrtf(wave_sum(q) * (1.f / 256.f) + EPS);
#pragma unroll
        for (int j = 0; j < 4; ++j) { const int c = F.lane + 64 * j; const float y = x[j] * rs * F.in[I_LNG][l * 256 + c] + F.in[I_LNB][l * 256 + c]; zc[tt * 256 + c] = silu_f(y); }
    }
    __syncthreads();
    const float* pw = F.in[I_PWW] + (size_t)l * 256 * 256; const float* pb = F.in[I_PWB] + l * 256;
#pragma unroll 1
    for (int i = F.tid; i < 16 * 256; i += NTHR) {
        const int tt = i >> 8, c = i & 255; float a = pb[c];
#pragma unroll 8
        for (int k = 0; k < 256; ++k) a += zc[tt * 256 + k] * pw[k * 256 + c];
        F.Y[(size_t)(row0 + tt) * D + 256 + c] = (bf16_t)f2bf(a);
    }
}
__device__ __forceinline__ void phase_mixers_naive(Frame& F, int l, bool with_ctx) {
    const int NA_U = with_ctx ? 264 : 256;
#define UNIT_DECODE const bool cu = u >= 256; const int nq = cu ? LC : S; const int idx = cu ? u - 256 : u; const int q0 = idx * 256 + (F.tid >> 1), dh = F.tid & 1; \
        const int b = q0 / (4 * nq), h = (q0 / nq) % 4, t = q0 % nq; const int row = cu ? ROWS_L + b * LC + t : b * S + t;
#pragma unroll 1
    for (int u = F.bid; u < NA_U; u += F.G) { UNIT_DECODE
        const bf16_t* qp = F.SEAM + (cu ? SE_QGC : SE_QG) + (((size_t)b * 4 + h) * nq + t) * 64;
        const size_t kvo = ((size_t)b * 2 + (h >> 1)) * KV * 64;
        naive_attn(qp, F.SEAM + SE_KG + kvo, F.SEAM + SE_VG + kvo, cu ? LC : KV, dh, F.Y + (size_t)row * D + 512 + h * 64 + 32 * dh);
    }
    asm volatile("" ::: "memory");
#pragma unroll 1
    for (int u = F.G - 1 - F.bid; u < NA_U; u += F.G) { UNIT_DECODE
        const bf16_t* qp = F.SEAM + (cu ? SE_QDC : SE_QD) + (((size_t)b * 4 + h) * nq + t) * 64;
        const size_t kvo = ((size_t)b * 4 + h) * KV * 64;
        naive_diff(F, l, qp, F.SEAM + SE_KD + kvo, F.SEAM + SE_VD + kvo, cu ? LC : KV, dh, F.Y + (size_t)row * D + 768 + h * 64 + 32 * dh);
    }
    asm volatile("" ::: "memory");
#pragma unroll 1
    for (int u = F.bid; u < NA_U; u += F.G) { UNIT_DECODE
        if (cu) { const bf16_t* qp = F.SEAM + SE_QAC + (((size_t)b * 4 + h) * LC + t) * 64; const size_t kvo = ((size_t)b * 4 + h) * KV * 64;
            naive_attn(qp, F.SEAM + SE_KA + kvo, F.SEAM + SE_VA + kvo, LC, dh, F.Y + (size_t)row * D + h * 64 + 32 * dh); }
        else naive_na(F, l, b, h, t, dh, F.Y + (size_t)row * D + h * 64 + 32 * dh);
    }
#undef UNIT_DECODE
    asm volatile("" ::: "memory");
#pragma unroll 1
    for (int u = F.bid; u < (with_ctx ? 1056 : 1024); u += F.G) { if (u < 1024) phase_conv_naive(F, l, u, false); else phase_conv_naive(F, l, u - 1024, true); }
    __syncthreads();
}


#ifndef FAST_INPROJ
#define FAST_INPROJ 1
#endif
#ifndef FAST_OUTPROJ
#define FAST_OUTPROJ 1
#endif
#ifndef FAST_MOE
#define FAST_MOE 1
#endif
constexpr size_t WB_GU = 0;
constexpr size_t WB_DN = 128 * MiB;
constexpr size_t WB_IN = 192 * MiB;
constexpr size_t WB_OUT = 202 * MiB;
static_assert(!(FAST_MOE && !FAST_INPROJ), "naive P overlays the MoE weight copies");
constexpr int GOFS_OFF = 131072 + 1024;

namespace pg8 {
typedef short bf16x8 __attribute__((ext_vector_type(8)));
constexpr int BM = 256, BK = 64, HALF = 128, HTB = HALF * BK * 2, STAGE_BYTES = 8 * HTB;
__device__ __forceinline__ int lds_byte(int r, int c) { const int st = (r >> 4) * 2 + (c >> 5), rr = r & 15, cc = c & 31, ob = rr * 64 + cc * 2; return st * 1024 + (ob ^ (((ob >> 9) & 1) << 5)); }
__device__ __forceinline__ void stage_rc(int b, int& R, int& C) { const int st = b / 1024, sb = b % 1024, swz = sb ^ (((sb >> 9) & 1) << 5); R = (st >> 1) * 16 + swz / 64; C = (st & 1) * 32 + (swz % 64) / 2; }
__device__ __forceinline__ int perm32(int rho) { const int n = rho >> 4, i = rho & 15; return 8 * (i >> 2) + 4 * n + (i & 3); }
struct Unit { int pm, pn; };
struct Gemm { const bf16_t* A; const bf16_t* Bt; int K; };

template <class Epi, class Sched, bool GATHER>
__device__ __forceinline__ void gemm_phase(LAS unsigned char* lds, const Gemm g, const Sched& S, const Epi& E, const LAS unsigned* gofs) {
    const int tid = threadIdx.x, wid = __builtin_amdgcn_readfirstlane(tid >> 6), lane = tid & 63, wr = wid >> 2, wc = wid & 3, fr = lane & 15, fq = lane >> 4;
    const int K = g.K, nt = K / BK;
    unsigned voffB[2];
#pragma unroll
    for (int i = 0; i < 2; ++i) { int R, C; stage_rc(tid * 16 + i * 8192, R, C); const int Rb = (R & ~31) + perm32(R & 31);
        voffB[i] = (unsigned)(Rb * K + C) * 2u; }
    const size_t kstep = (size_t)(BK * 2);
    const size_t hstep = (size_t)HALF * K * 2;
    const size_t tstep = 2 * hstep;
    const unsigned ldsw = (unsigned)wid * 1024u;
    const int aoff = lds_byte(wr * 64 + fr, fq * 8), boff = lds_byte(wc * 32 + fr, fq * 8);
#define PG8_SA(b, h) (((b) * 2 + (h)) * HTB)
#define PG8_SB(b, h) ((4 + (b) * 2 + (h)) * HTB)
#define PG8_STAGE(bufoff, gbase, voff) do { _Pragma("unroll") for (int _i = 0; _i < 2; ++_i) \
        __builtin_amdgcn_global_load_lds((const unsigned*)((const char*)(gbase) + (voff)[_i]), (LAS unsigned*)(lds + (bufoff) + ldsw + _i * 8192), 16, 0, 0); } while (0)
#define PG8_LDA(dst, b, h) do { _Pragma("unroll") for (int m = 0; m < 4; ++m) _Pragma("unroll") for (int k = 0; k < 2; ++k) dst[m][k] = *(const LAS bf16x8*)(lds + PG8_SA(b, h) + aoff + m * 2048 + k * 1024); } while (0)
#define PG8_LDB(dst, b, h) do { _Pragma("unroll") for (int n = 0; n < 2; ++n) _Pragma("unroll") for (int k = 0; k < 2; ++k) dst[n][k] = *(const LAS bf16x8*)(lds + PG8_SB(b, h) + boff + n * 2048 + k * 1024); } while (0)
#define PG8_MMA(ai, bj, At, Bt) do { __builtin_amdgcn_s_setprio(1); _Pragma("unroll") for (int m = 0; m < 4; ++m) _Pragma("unroll") for (int n = 0; n < 2; ++n) _Pragma("unroll") for (int k = 0; k < 2; ++k) \
        acc[ai][bj][m][n] = __builtin_amdgcn_mfma_f32_16x16x32_bf16(Bt[n][k], At[m][k], acc[ai][bj][m][n], 0, 0, 0); __builtin_amdgcn_s_setprio(0); } while (0)
#define PG8_WAIT_V(n) asm volatile("s_waitcnt vmcnt(" #n ")" ::: "memory")
#define PG8_WAIT_L(n) asm volatile("s_waitcnt lgkmcnt(" #n ")" ::: "memory")
#define PG8_BAR __builtin_amdgcn_s_barrier()
#define PG8_SCHED __builtin_amdgcn_sched_barrier(0)
#define PG8_AOFF(dst, u, slot) do { int _t = tid; asm volatile("" : "+v"(_t)); _Pragma("unroll") for (int _i = 0; _i < 2; ++_i) { int _R, _C; stage_rc(_t * 16 + _i * 8192, _R, _C); \
        _Pragma("unroll") for (int _h = 0; _h < 2; ++_h) \
        dst[_h][_i] = (GATHER ? gofs[(slot) * 256 + _h * HALF + _R] : (unsigned)((u).pm * BM + _h * HALF + _R) * (unsigned)(K * 2)) + (unsigned)_C * 2u; } } while (0)
    Unit cur, nxt; int ui = 0;
    if (!S.next(0, cur)) return;
    f32x4 acc[2][2][4][2];
#pragma unroll
    for (int a = 0; a < 2; ++a)
#pragma unroll
        for (int b = 0; b < 2; ++b)
#pragma unroll
            for (int m = 0; m < 4; ++m)
#pragma unroll
                for (int n = 0; n < 2; ++n) acc[a][b][m][n] = (f32x4){0.f, 0.f, 0.f, 0.f};
    bf16x8 At[4][2], B0[2][2], B1[2][2];
    unsigned ca[2][2];
    PG8_AOFF(ca, cur, 0);
    const char* Ab = (const char*)g.A; const char* cB = (const char*)g.Bt + (size_t)cur.pn * tstep;
    PG8_STAGE(PG8_SB(0, 0), cB, voffB); PG8_STAGE(PG8_SB(0, 1), cB + hstep, voffB); PG8_STAGE(PG8_SA(0, 0), Ab, ca[0]); PG8_STAGE(PG8_SA(0, 1), Ab, ca[1]);
    if (wr == 1) PG8_BAR;
    PG8_WAIT_V(2); PG8_BAR;
    PG8_STAGE(PG8_SB(1, 0), cB + kstep, voffB); PG8_STAGE(PG8_SA(1, 0), Ab + kstep, ca[0]); PG8_STAGE(PG8_SB(1, 1), cB + hstep + kstep, voffB);
    PG8_WAIT_V(6); PG8_BAR;
    for (;;) {
        const bool has_next = S.next(ui + 1, nxt);
        const char* nB = has_next ? (const char*)g.Bt + (size_t)nxt.pn * tstep : cB;
        for (int t = 0; t < nt; t += 2) {
            const bool last = (t == nt - 2);
            const char* a1 = Ab + (size_t)(t + 1) * kstep;
            const char* a2 = last ? Ab : Ab + (size_t)(t + 2) * kstep; const char* b2 = last ? nB : cB + (size_t)(t + 2) * kstep;
            const char* a3 = a2 + kstep; const char* b3 = b2 + kstep;
            PG8_LDB(B0, 0, 0); PG8_LDB(B1, 0, 1); PG8_SCHED; PG8_LDA(At, 0, 0); PG8_STAGE(PG8_SA(1, 1), a1, ca[1]);
            if (last && has_next) { PG8_AOFF(ca, nxt, ui + 1); }
            PG8_WAIT_V(8); PG8_WAIT_L(0); PG8_BAR; PG8_MMA(0, 0, At, B0); PG8_MMA(0, 1, At, B1); PG8_BAR; PG8_SCHED;
            PG8_LDA(At, 0, 1); PG8_STAGE(PG8_SB(0, 0), b2, voffB); PG8_STAGE(PG8_SB(0, 1), b2 + hstep, voffB); PG8_STAGE(PG8_SA(0, 0), a2, ca[0]);
            PG8_WAIT_V(8); PG8_WAIT_L(0); PG8_BAR; PG8_MMA(1, 0, At, B0); PG8_MMA(1, 1, At, B1); PG8_BAR; PG8_SCHED;
            PG8_LDB(B0, 1, 0); PG8_LDB(B1, 1, 1); PG8_SCHED; PG8_LDA(At, 1, 0); PG8_STAGE(PG8_SA(0, 1), a2, ca[1]);
            PG8_WAIT_V(8); PG8_WAIT_L(0); PG8_BAR; PG8_MMA(0, 0, At, B0); PG8_MMA(0, 1, At, B1); PG8_BAR; PG8_SCHED;
            PG8_LDA(At, 1, 1); PG8_STAGE(PG8_SB(1, 0), b3, voffB); PG8_STAGE(PG8_SB(1, 1), b3 + hstep, voffB); PG8_STAGE(PG8_SA(1, 0), a3, ca[0]);
            PG8_WAIT_V(8); PG8_WAIT_L(0); PG8_BAR; PG8_MMA(1, 0, At, B0); PG8_MMA(1, 1, At, B1); PG8_BAR; PG8_SCHED;
        }
        if (wr == 0) PG8_BAR;
        { int fr_ = fr, fq_ = fq, wr_ = wr, wc_ = wc; asm volatile("" : "+v"(fr_), "+v"(fq_), "+s"(wr_), "+s"(wc_));
          E(acc, cur, wr_, wc_, fr_, fq_); }
        if (!has_next) break;
#pragma unroll
        for (int a = 0; a < 2; ++a)
#pragma unroll
            for (int b = 0; b < 2; ++b)
#pragma unroll
                for (int m = 0; m < 4; ++m)
#pragma unroll
                    for (int n = 0; n < 2; ++n) acc[a][b][m][n] = (f32x4){0.f, 0.f, 0.f, 0.f};
        cur = nxt; cB = nB; ++ui;
        if (wr == 1) PG8_BAR;
    }
    PG8_WAIT_V(0);
    PG8_BAR;
#undef PG8_SA
#undef PG8_SB
#undef PG8_STAGE
#undef PG8_LDA
#undef PG8_LDB
#undef PG8_MMA
#undef PG8_WAIT_V
#undef PG8_WAIT_L
#undef PG8_BAR
#undef PG8_SCHED
#undef PG8_AOFF
}

struct OrderDense {
    int nM, nN, G, v;
    __device__ __forceinline__ bool next(int i, Unit& u) const {
        const int id = i * G + v; if (id >= nM * nN) return false;
        const int nig = 8 * nN, gid = id / nig, fm = gid * 8, gsz = (nM - fm) < 8 ? (nM - fm) : 8;
        u.pm = fm + ((id % nig) % gsz); u.pn = (id % nig) / gsz; return true;
    }
};
struct OrderMoe {
    int nM, nN, G, v;
    __device__ __forceinline__ bool next(int i, Unit& u) const {
        const int id = i * G + v; if (id >= NE * nM * nN) return false;
        const int e = id / (nM * nN), r = id % (nM * nN);
        u.pm = e * 9 + (r % nM); u.pn = e * nN + (r / nM); return true;
    }
};
}

__device__ __forceinline__ unsigned cvt_pk_bf16(float lo, float hi) { unsigned r; asm volatile("v_cvt_pk_bf16_f32 %0, %1, %2" : "=v"(r) : "v"(lo), "v"(hi)); return r; }
__device__ __forceinline__ u32x4 pack8(const f32x4 a, const f32x4 b) { u32x4 w; w.x = cvt_pk_bf16(a[0], a[1]); w.y = cvt_pk_bf16(a[2], a[3]); w.z = cvt_pk_bf16(b[0], b[1]); w.w = cvt_pk_bf16(b[2], b[3]); return w; }
__device__ __forceinline__ float fast_sigmoid(float x) { return __builtin_amdgcn_rcpf(1.f + __expf(-x)); }

struct EpiIn {
    bf16_t* SEAM; const float* tab; const float* qng; const float* kng;
    __device__ __forceinline__ void operator()(const f32x4 (&acc)[2][2][4][2], const pg8::Unit& u, int wr, int wc, int fr, int fq) const {
        const bool isc = u.pm >= 64; const int b = isc ? u.pm - 64 : u.pm >> 5; const int pn = u.pn; const int nq = isc ? LC : S;
        f32x4 gn[2][2];
        if (pn == 5 || pn == 6) { const float* g = (pn == 5) ? qng : kng;
#pragma unroll
            for (int bj = 0; bj < 2; ++bj)
#pragma unroll
                for (int n = 0; n < 2; ++n) gn[bj][n] = *(const f32x4*)(g + 32 * bj + 8 * fq + 4 * n); }
#pragma unroll
        for (int ai = 0; ai < 2; ++ai)
#pragma unroll
            for (int m = 0; m < 4; ++m) {
                const int rl = 128 * ai + 64 * wr + 16 * m + fr; const int r = u.pm * 256 + rl; const int t = isc ? rl : (r & (S - 1)); const int key = isc ? t : LC + t;
                const int e0 = 8 * fq;
                if (pn <= 2 || pn == 9 || (pn == 6 && wc >= 2)) {
                    bf16_t* base;
                    if (pn == 0) base = isc ? SEAM + SE_QAC + (((size_t)b * 4 + wc) * LC + t) * 64 : SEAM + SE_QA + (((size_t)b * 4 + wc) * S + t) * 64;
                    else if (pn == 1) base = SEAM + SE_KA + (((size_t)b * 4 + wc) * KV + key) * 64;
                    else if (pn == 2) base = SEAM + SE_VA + (((size_t)b * 4 + wc) * KV + key) * 64;
                    else if (pn == 9) base = SEAM + SE_VD + (((size_t)b * 4 + wc) * KV + key) * 64;
                    else base = SEAM + SE_VG + (((size_t)b * 2 + (wc - 2)) * KV + key) * 64;
                    const float sc = (pn == 0) ? 0.125f * LOG2E : 1.f;
#pragma unroll
                    for (int bj = 0; bj < 2; ++bj) *(u32x4*)(base + 32 * bj + e0) = pack8(acc[ai][bj][m][0] * sc, acc[ai][bj][m][1] * sc);
                } else if (pn == 3 || pn == 4) {
                    f32x4 z0, z1;
#pragma unroll
                    for (int j = 0; j < 4; ++j) { z0[j] = acc[ai][0][m][0][j] * fast_sigmoid(acc[ai][1][m][0][j]); z1[j] = acc[ai][0][m][1][j] * fast_sigmoid(acc[ai][1][m][1][j]); }
                    *(u32x4*)(SEAM + SE_Z + (size_t)r * 256 + 128 * (pn - 3) + 32 * wc + e0) = pack8(z0, z1);
                } else if (pn == 5 || pn == 6) {
                    float ss = 0.f;
#pragma unroll
                    for (int bj = 0; bj < 2; ++bj)
#pragma unroll
                        for (int n = 0; n < 2; ++n) { const f32x4 x = acc[ai][bj][m][n]; ss += (x[0] * x[0] + x[1] * x[1]) + (x[2] * x[2] + x[3] * x[3]); }
                    ss += __shfl_xor(ss, 16); ss += __shfl_xor(ss, 32);
                    const float rs = 1.f / sqrtf(ss * (1.f / 64.f) + EPS);
                    f32x4 x1[2], x2[2];
#pragma unroll
                    for (int n = 0; n < 2; ++n) { x1[n] = acc[ai][0][m][n] * rs * gn[0][n]; x2[n] = acc[ai][1][m][n] * rs * gn[1][n]; }
                    if (!isc) { const int pos = (fq < 2) ? (t >> 6) : (t & 63);
#pragma unroll
                        for (int n = 0; n < 2; ++n) { const f32x4 c = *(const f32x4*)(tab + TB_C64 + pos * 16 + 8 * (fq & 1) + 4 * n), sn = *(const f32x4*)(tab + TB_S64 + pos * 16 + 8 * (fq & 1) + 4 * n);
                            const f32x4 a = x1[n] * c - x2[n] * sn, bb = x2[n] * c + x1[n] * sn; x1[n] = a; x2[n] = bb; } }
                    bf16_t* base;
                    if (pn == 5) { base = isc ? SEAM + SE_QGC + (((size_t)b * 4 + wc) * LC + t) * 64 : SEAM + SE_QG + (((size_t)b * 4 + wc) * S + t) * 64;
                        const float sc = 0.125f * LOG2E;
#pragma unroll
                        for (int n = 0; n < 2; ++n) { x1[n] = x1[n] * sc; x2[n] = x2[n] * sc; } }
                    else base = SEAM + SE_KG + (((size_t)b * 2 + wc) * KV + key) * 64;
                    *(u32x4*)(base + e0) = pack8(x1[0], x1[1]); *(u32x4*)(base + 32 + e0) = pack8(x2[0], x2[1]);
                } else {
                    bf16_t* base;
                    if (pn == 7) base = isc ? SEAM + SE_QDC + (((size_t)b * 4 + wc) * LC + t) * 64 : SEAM + SE_QD + (((size_t)b * 4 + wc) * S + t) * 64;
                    else base = SEAM + SE_KD + (((size_t)b * 4 + wc) * KV + key) * 64;
                    const float sc = (pn == 7) ? 0.17677669529663687f * LOG2E : 1.f;
                    f32x4 c = (f32x4){1.f, 1.f, 1.f, 1.f}, sn = (f32x4){0.f, 0.f, 0.f, 0.f};
                    if (!isc) { const int pos = (fq < 2) ? (t >> 6) : (t & 63); c = *(const f32x4*)(tab + TB_C32 + pos * 8 + 4 * (fq & 1)); sn = *(const f32x4*)(tab + TB_S32 + pos * 8 + 4 * (fq & 1)); }
#pragma unroll
                    for (int bj = 0; bj < 2; ++bj) { const f32x4 x1 = acc[ai][bj][m][0], x2 = acc[ai][bj][m][1];
                        const f32x4 a = (x1 * c - x2 * sn) * sc, bb = (x2 * c + x1 * sn) * sc;
                        uint2 w1, w2; w1.x = cvt_pk_bf16(a[0], a[1]); w1.y = cvt_pk_bf16(a[2], a[3]); w2.x = cvt_pk_bf16(bb[0], bb[1]); w2.y = cvt_pk_bf16(bb[2], bb[3]);
                        *(uint2*)(base + 32 * bj + 4 * fq) = w1; *(uint2*)(base + 32 * bj + 16 + 4 * fq) = w2; }
                }
            }
    }
};
__device__ __forceinline__ int inproj_srccol(int nrow) {
    const int pn = nrow >> 8, p = nrow & 255, bj = p >> 7, wc = (p >> 5) & 3, j32 = p & 31;
    if (pn == 3 || pn == 4) return (bj ? 1024 : 768) + 128 * (pn - 3) + (p & 127);
    if (pn == 7 || pn == 8) { const int fq = j32 >> 3, n = (j32 >> 2) & 1, j = j32 & 3; return 256 * pn + 64 * wc + 32 * bj + 16 * n + 4 * fq + j; }
    return 256 * pn + 64 * wc + 32 * bj + j32;
}
struct EpiOut {
    const float* xl; const float* xc; const float* hin; float* hout; const float* modl;
    __device__ __forceinline__ void operator()(const f32x4 (&acc)[2][2][4][2], const pg8::Unit& u, int wr, int wc, int fr, int fq) const {
        const bool isc = u.pm >= 64; const int b = isc ? u.pm - 64 : u.pm >> 5; const float* g1 = modl + (isc ? 2 : b) * 6144 + 2 * D;
        const int col0 = u.pn * 256 + 32 * wc + 8 * fq;
        f32x4 g[2][2];
#pragma unroll
        for (int bj = 0; bj < 2; ++bj)
#pragma unroll
            for (int n = 0; n < 2; ++n) g[bj][n] = *(const f32x4*)(g1 + col0 + 128 * bj + 4 * n);
#pragma unroll
        for (int ai = 0; ai < 2; ++ai)
#pragma unroll
            for (int m = 0; m < 4; ++m) { const int r = u.pm * 256 + 128 * ai + 64 * wr + 16 * m + fr;
                const float* src = hin ? hin + (size_t)r * D : (isc ? xc + (size_t)(r - ROWS_L) * D : xl + (size_t)r * D);
#pragma unroll
                for (int bj = 0; bj < 2; ++bj)
#pragma unroll
                    for (int n = 0; n < 2; ++n) { const int c = col0 + 128 * bj + 4 * n; const f32x4 h = *(const f32x4*)(src + c); *(f32x4*)(hout + (size_t)r * D + c) = h + g[bj][n] * acc[ai][bj][m][n]; }
            }
    }
};
struct EpiMoe1 {
    bf16_t* HE;
    __device__ __forceinline__ void operator()(const f32x4 (&acc)[2][2][4][2], const pg8::Unit& u, int wr, int wc, int fr, int fq) const {
        const int f0 = (u.pn & 7) * 128 + 32 * wc + 8 * fq;
#pragma unroll
        for (int ai = 0; ai < 2; ++ai)
#pragma unroll
            for (int m = 0; m < 4; ++m) { const size_t r = (size_t)u.pm * 256 + 128 * ai + 64 * wr + 16 * m + fr;
                f32x4 h0, h1;
#pragma unroll
                for (int j = 0; j < 4; ++j) { const float a0 = acc[ai][0][m][0][j], a1 = acc[ai][0][m][1][j]; h0[j] = a0 * fast_sigmoid(a0) * acc[ai][1][m][0][j]; h1[j] = a1 * fast_sigmoid(a1) * acc[ai][1][m][1][j]; }
                *(u32x4*)(HE + r * D + f0) = pack8(h0, h1); }
    }
};
struct EpiMoe2 {
    bf16_t* YE; const float* gate;
    __device__ __forceinline__ void operator()(const f32x4 (&acc)[2][2][4][2], const pg8::Unit& u, int wr, int wc, int fr, int fq) const {
        const int c0 = (u.pn & 3) * 256 + 32 * wc + 8 * fq;
#pragma unroll
        for (int ai = 0; ai < 2; ++ai)
#pragma unroll
            for (int m = 0; m < 4; ++m) { const size_t r = (size_t)u.pm * 256 + 128 * ai + 64 * wr + 16 * m + fr; const float gt = gate[r];
#pragma unroll
                for (int bj = 0; bj < 2; ++bj) *(u32x4*)(YE + r * D + c0 + 128 * bj) = pack8(acc[ai][bj][m][0] * gt, acc[ai][bj][m][1] * gt); }
    }
};

__device__ __forceinline__ int vcu_of(const Frame& F) { return (F.G % 8 == 0) ? (F.bid % 8) * (F.G / 8) + F.bid / 8 : F.bid; }

__device__ __forceinline__ void phase_inproj_fast(Frame& F, int l) {
    pg8::Gemm g{F.U, (const bf16_t*)(F.ws + WS_WBF + WB_IN + (size_t)l * 5 * MiB), D};
    pg8::OrderDense S{ROWS / 256, DIN / 256, F.G, vcu_of(F)};
    EpiIn E{F.SEAM, F.tab, F.in[I_QNG] + l * 64, F.in[I_KNG] + l * 64};
    pg8::gemm_phase<EpiIn, pg8::OrderDense, false>(F.lds, g, S, E, nullptr);
}
__device__ __forceinline__ void phase_outproj_fast(Frame& F, int l, bool with_ctx) {
    pg8::Gemm g{F.Y, (const bf16_t*)(F.ws + WS_WBF + WB_OUT + (size_t)l * 2 * MiB), D};
    pg8::OrderDense S{(with_ctx ? ROWS : ROWS_L) / 256, D / 256, F.G, vcu_of(F)};
    EpiOut E{F.in[I_X], F.in[I_CTX], (l == 0) ? nullptr : F.H, F.H, F.tab + TB_MOD + l * 3 * 6144};
    pg8::gemm_phase<EpiOut, pg8::OrderDense, false>(F.lds, g, S, E, nullptr);
}
__device__ __forceinline__ void phase_moe1_fast(Frame& F, int l, bool with_ctx) {
    pg8::Gemm g{F.U, (const bf16_t*)(F.ws + WS_WBF + WB_GU + (size_t)l * 64 * MiB), D};
    pg8::OrderMoe S{with_ctx ? 9 : 8, 8, F.G, vcu_of(F)};
    LAS unsigned* gofs = (LAS unsigned*)(F.lds + GOFS_OFF);
    { pg8::Unit u;
      for (int i = 0; i < 8 && S.next(i, u); ++i)
          for (int j = F.tid; j < 256; j += NTHR) { const int ri = F.RIDX[u.pm * 256 + j]; gofs[i * 256 + j] = (unsigned)(ri < 0 ? 0 : ri) * (unsigned)(D * 2); }
      __syncthreads(); }
    EpiMoe1 E{F.HE};
    pg8::gemm_phase<EpiMoe1, pg8::OrderMoe, true>(F.lds, g, S, E, gofs);
}
__device__ __forceinline__ void phase_moe2_fast(Frame& F, int l, bool with_ctx) {
    pg8::Gemm g{F.HE, (const bf16_t*)(F.ws + WS_WBF + WB_DN + (size_t)l * 32 * MiB), D};
    pg8::OrderMoe S{with_ctx ? 9 : 8, 4, F.G, vcu_of(F)};
    EpiMoe2 E{F.YE, F.GATE};
    pg8::gemm_phase<EpiMoe2, pg8::OrderMoe, false>(F.lds, g, S, E, nullptr);
}

__device__ __forceinline__ void transpose_item(const float* W, int ldw, int srccol, int k0, bf16_t* WTrow0, int K, LAS float* scr, int lane) {
#pragma unroll 8
    for (int i = 0; i < 32; ++i) { const int kk = 2 * i + (lane >> 5); scr[kk * 33 + (lane & 31)] = W[(size_t)(k0 + kk) * ldw + srccol]; }
    asm volatile("s_waitcnt lgkmcnt(0)" ::: "memory");
    const int c = lane & 7;
#pragma unroll
    for (int j = 0; j < 4; ++j) { const int n = (lane >> 3) + 8 * j; const LAS float* s_ = scr + (8 * c) * 33 + n;
        u32x4 o; o.x = pk2(s_[0 * 33], s_[1 * 33]); o.y = pk2(s_[2 * 33], s_[3 * 33]); o.z = pk2(s_[4 * 33], s_[5 * 33]); o.w = pk2(s_[6 * 33], s_[7 * 33]);
        *(u32x4*)(WTrow0 + (size_t)n * K + k0 + 8 * c) = o; }
    asm volatile("s_waitcnt lgkmcnt(0)" ::: "memory");
}
__device__ __forceinline__ void phase_convert(Frame& F) {
    LAS float* scr = (LAS float*)(F.lds + F.wave * 16384);
    const int gw = F.bid * NWAVES + F.wave, NGW = F.G * NWAVES;
    constexpr int IT_IN = 16 * 80, IT_OUT = 16 * 32, IT_E = 16 * 32;
    constexpr int PER_L = IT_IN + IT_OUT + NE * 3 * IT_E;
    const int nn = F.lane & 31;
    for (int it = gw; it < DEPTH * PER_L; it += NGW) {
        const int l = it / PER_L; int r = it % PER_L;
        if (r < IT_IN) { if (!FAST_INPROJ) continue; const int kb = r / 80, nb = r % 80;
            transpose_item(F.in[I_WIN] + (size_t)l * D * DIN, DIN, inproj_srccol(nb * 32 + nn), kb * 64, (bf16_t*)(F.ws + WS_WBF + WB_IN + (size_t)l * 5 * MiB) + (size_t)(nb * 32) * D, D, scr, F.lane); continue; }
        r -= IT_IN;
        if (r < IT_OUT) { if (!FAST_OUTPROJ) continue; const int kb = r / 32, nb = r % 32;
            transpose_item(F.in[I_WOUT] + (size_t)l * D * D, D, nb * 32 + nn, kb * 64, (bf16_t*)(F.ws + WS_WBF + WB_OUT + (size_t)l * 2 * MiB) + (size_t)(nb * 32) * D, D, scr, F.lane); continue; }
        r -= IT_OUT;
        if (!FAST_MOE) continue;
        const int e = r / (3 * IT_E), q = (r % (3 * IT_E)) / IT_E, r2 = r % IT_E, kb = r2 / 32, nb = r2 % 32;
        const size_t wo = ((size_t)l * NE + e) * D * D;
        if (q < 2) {
            const int f0 = nb * 32; const int row0 = (f0 >> 7) * 256 + q * 128 + (f0 & 127);
            transpose_item(F.in[q == 0 ? I_WG : I_WU] + wo, D, f0 + nn, kb * 64, (bf16_t*)(F.ws + WS_WBF + WB_GU + (size_t)l * 64 * MiB) + ((size_t)e * 2048 + row0) * D, D, scr, F.lane);
        } else transpose_item(F.in[I_WD] + wo, D, nb * 32 + nn, kb * 64, (bf16_t*)(F.ws + WS_WBF + WB_DN + (size_t)l * 32 * MiB) + ((size_t)e * 1024 + nb * 32) * D, D, scr, F.lane);
    }
}

#ifndef PHMASK
#define PHMASK 0xffffffffu
#endif
#define REFRESH() do { asm volatile("" : "+v"(F.tid)); F.lane = F.tid & 63; F.wave = __builtin_amdgcn_readfirstlane(F.tid >> 6); } while (0)
#define PHX(i, call) do { if ((PHMASK >> (i)) & 1u) { REFRESH(); call; } } while (0)
constexpr int PH_PER_LAYER = 9;
constexpr int NPH = 1 + DEPTH * PH_PER_LAYER + 1;

__global__ void __launch_bounds__(NTHR, 2) mk_fwd(Args args) {
    extern __shared__ __attribute__((aligned(16))) unsigned char lds[];
    Frame F;
    F.lds = (LAS unsigned char*)lds;
    F.tid = threadIdx.x; F.lane = F.tid & 63; F.wave = __builtin_amdgcn_readfirstlane(F.tid >> 6);
    F.G = gridDim.x; F.bid = blockIdx.x;
    F.in = args.in; F.out = args.out; F.ws = args.ws;
    unsigned char* ws = args.ws;
    F.tab = (float*)(ws + WS_TAB); F.H = (float*)(ws + WS_H); F.U = (bf16_t*)(ws + WS_U); F.AFF = (float*)(ws + WS_AFF); F.SLOT = (int*)(ws + WS_SLOT);
    F.RIDX = (int*)(ws + WS_RIDX); F.GATE = (float*)(ws + WS_RIDX + 256 * 1024);
    F.SEAM = (bf16_t*)(ws + WS_SEAM); F.Y = (bf16_t*)(ws + WS_Y); F.HE = (bf16_t*)(ws + WS_HE); F.YE = (bf16_t*)(ws + WS_YE); F.P = (float*)(ws + WS_P);
    for (int u = F.tid; u < (LDS_BYTES - LDSCTL_OFF) / 4; u += NTHR) ((LAS unsigned*)(F.lds + LDSCTL_OFF))[u] = 0u;
    __syncthreads();
    XcdBarrier bar; bar.bar = (unsigned*)(ws + WS_CTL) + CW_BAR; bar.x = 0; bar.st = nullptr;
    const bool one = (MK_N_LAUNCHES == 1);
    if (one) bar = xcd_barrier_post((unsigned*)(ws + WS_CTL) + CW_BAR, (volatile LAS unsigned*)(F.lds + MISC_OFF) + 8);
    const int lo = args.ph_lo, hi = args.ph_hi;
#define IN(k) (lo <= (k) && (k) < hi)
#define SEAM_BAR(k) do { if (one && (k) + 1 < hi) xcd_barrier(bar); } while (0)
    if (IN(0)) { PHX(0, phase_prologue(F)); REFRESH(); phase_convert(F); SEAM_BAR(0); }
#pragma unroll 1
    for (int l = 0; l < DEPTH; ++l) {
        const int pb = 1 + l * PH_PER_LAYER; const bool wc = (l < DEPTH - 1);
        if (IN(pb + 0)) { REFRESH(); if (l == 0) phase_norm<0>(F, 0, true, -1, true); else phase_norm<0>(F, l, false, l - 1, true); SEAM_BAR(pb + 0); }
        if (IN(pb + 1)) { if (FAST_INPROJ) { REFRESH(); phase_inproj_fast(F, l); } else { PHX(1, phase_inproj_naive(F, l)); } SEAM_BAR(pb + 1); }
        if (IN(pb + 2)) { if (!FAST_INPROJ) { PHX(2, phase_post_naive(F, l)); SEAM_BAR(pb + 2); } }
        if (IN(pb + 3)) { PHX(3, phase_mixers_naive(F, l, wc)); SEAM_BAR(pb + 3); }
        if (IN(pb + 4)) { if (FAST_OUTPROJ) { REFRESH(); phase_outproj_fast(F, l, wc); } else { PHX(4, phase_outproj_naive(F, l, wc)); } SEAM_BAR(pb + 4); }
        if (IN(pb + 5)) { PHX(5, phase_norm2_router(F, l, wc)); SEAM_BAR(pb + 5); }
        if (IN(pb + 6)) { PHX(6, phase_select_naive(F, wc)); SEAM_BAR(pb + 6); }
        if (IN(pb + 7)) { if (FAST_MOE) { REFRESH(); phase_moe1_fast(F, l, wc); } else { PHX(7, phase_moe1_naive(F, l, wc)); } SEAM_BAR(pb + 7); }
        if (IN(pb + 8)) { if (FAST_MOE) { REFRESH(); phase_moe2_fast(F, l, wc); } else { PHX(8, phase_moe2_naive(F, l, wc)); } SEAM_BAR(pb + 8); }
    }
    if (IN(NPH - 1)) { REFRESH(); phase_norm<2>(F, 0, false, DEPTH - 1, false); }
#undef IN
#undef SEAM_BAR
}

extern "C" void kernel_launch(void* const* d_in, const int* in_sizes, int n_in, void* d_out, int out_size, void* d_ws, size_t ws_size, hipStream_t stream) {
    static int grid = 0;
    if (grid == 0) {
        if (n_in != N_IN || out_size != ROWS_L * D || ws_size < WS_END) { fprintf(stderr, "kernel_launch: unexpected shapes (n_in %d out %d ws %zu)\n", n_in, out_size, ws_size); grid = -1; return; }
        int dev = 0, cus = 0, per_cu = 0;
        if (hipGetDevice(&dev) != hipSuccess || hipDeviceGetAttribute(&cus, hipDeviceAttributeMultiprocessorCount, dev) != hipSuccess) { grid = -1; return; }
        if (hipFuncSetAttribute((const void*)mk_fwd, hipFuncAttributeMaxDynamicSharedMemorySize, LDS_BYTES) != hipSuccess) { fprintf(stderr, "kernel_launch: hipFuncSetAttribute failed\n"); grid = -1; return; }
        if (hipOccupancyMaxActiveBlocksPerMultiprocessor(&per_cu, (const void*)mk_fwd, NTHR, LDS_BYTES) != hipSuccess || per_cu < 1) { fprintf(stderr, "kernel_launch: occupancy query says %d\n", per_cu); per_cu = 1; }
        (void)hipGetLastError();
        grid = cus;
    }
    if (grid < 0) return;
    (void)hipMemsetAsync((char*)d_ws + WS_CTL, 0, CTL_ZERO_BYTES, stream);
    Args a{};
    for (int i = 0; i < N_IN; ++i) a.in[i] = (const float*)d_in[i];
    a.out = (float*)d_out; a.ws = (unsigned char*)d_ws;
    if (MK_N_LAUNCHES == 1) { a.ph_lo = 0; a.ph_hi = NPH; hipLaunchKernelGGL(mk_fwd, dim3(grid), dim3(NTHR), LDS_BYTES, stream, a); }
    else for (int p = 0; p < NPH; ++p) { a.ph_lo = p; a.ph_hi = p + 1; hipLaunchKernelGGL(mk_fwd, dim3(grid), dim3(NTHR), LDS_BYTES, stream, a); }
}
```

```cpp
#include <hip/hip_runtime.h>
#include <cstdio>
#include <cstdint>

#ifndef MK_N_LAUNCHES
#define MK_N_LAUNCHES 1
#endif

constexpr int D = 1024, NB = 2, S = 8192, LC = 256, DEPTH = 2;
constexpr int ROWS_L = NB * S;
constexpr int ROWS_C = NB * LC;
constexpr int ROWS = ROWS_L + ROWS_C;
constexpr int KV = LC + S;
constexpr int DIN = 2560;
constexpr int NE = 16, CAP_L = 1024, CAP_C = 32;
constexpr int ESLOTS = 2 * CAP_L + 2 * CAP_C;
constexpr int EPAD = 2304;
constexpr float EPS = 1e-6f;
constexpr float LOG2E = 1.4426950408889634f;
constexpr int NWAVES = 8, NTHR = 512;

typedef unsigned short bf16_t;
typedef unsigned u32x4 __attribute__((ext_vector_type(4)));
typedef float f32x4 __attribute__((ext_vector_type(4)));

constexpr size_t MiB = 1u << 20;
constexpr size_t WS_CTL = 0;
constexpr size_t CTL_ZERO_BYTES = 64 * 1024;
constexpr size_t WS_TAB = 1 * MiB;
constexpr size_t WS_H = 2 * MiB;
constexpr size_t WS_U = 68 * MiB;
constexpr size_t WS_AFF = 101 * MiB;
constexpr size_t WS_SLOT = 103 * MiB;
constexpr size_t WS_RIDX = 105 * MiB;
constexpr size_t WS_WBF = 106 * MiB;
constexpr size_t WS_R = 314 * MiB;
constexpr size_t WS_END = 458 * MiB;
constexpr size_t WS_P = WS_WBF;
constexpr size_t WS_SEAM = WS_R;
constexpr size_t WS_Y = WS_R + 83 * MiB;
constexpr size_t WS_HE = WS_R;
constexpr size_t WS_YE = WS_R + 72 * MiB;

constexpr size_t SE_QA = 0;
constexpr size_t SE_QAC = SE_QA + (size_t)NB * 4 * S * 64;
constexpr size_t SE_KA = SE_QAC + (size_t)NB * 4 * LC * 64;
constexpr size_t SE_VA = SE_KA + (size_t)NB * 4 * KV * 64;
constexpr size_t SE_Z = SE_VA + (size_t)NB * 4 * KV * 64;
constexpr size_t SE_QG = SE_Z + (size_t)ROWS * 256;
constexpr size_t SE_QGC = SE_QG + (size_t)NB * 4 * S * 64;
constexpr size_t SE_KG = SE_QGC + (size_t)NB * 4 * LC * 64;
constexpr size_t SE_VG = SE_KG + (size_t)NB * 2 * KV * 64;
constexpr size_t SE_QD = SE_VG + (size_t)NB * 2 * KV * 64;
constexpr size_t SE_QDC = SE_QD + (size_t)NB * 4 * S * 64;
constexpr size_t SE_KD = SE_QDC + (size_t)NB * 4 * LC * 64;
constexpr size_t SE_VD = SE_KD + (size_t)NB * 4 * KV * 64;
constexpr size_t SE_END = SE_VD + (size_t)NB * 4 * KV * 64;
static_assert(SE_END == (size_t)ROWS * (DIN - 256), "seam map");
static_assert(SE_END * 2 <= 83 * MiB, "seam fits");

constexpr int TB_C64 = 0;
constexpr int TB_S64 = 2048;
constexpr int TB_C32 = 4096;
constexpr int TB_S32 = 5120;
constexpr int TB_MOD = 8192;
constexpr int TB_LAM = TB_MOD + DEPTH * 3 * 6144;

constexpr int CW_BAR = 1024;

enum { I_X = 0, I_C, I_CTX, I_CCTX, I_N1G, I_WMOD, I_BMOD, I_WIN, I_RPB, I_DWW, I_DWB, I_LNG, I_LNB, I_PWW, I_PWB,
       I_QNG, I_KNG, I_LQ1, I_LK1, I_LQ2, I_LK2, I_DNG, I_WOUT, I_N2G, I_WR, I_WG, I_WU, I_WD, I_FG, N_IN };

constexpr int LDS_BYTES = 147456;
constexpr int MISC_OFF = 131072 + 320;
constexpr int LDSCTL_OFF = 131072;

#define GAS __attribute__((address_space(1)))
#define LAS __attribute__((address_space(3)))

__device__ __forceinline__ float bf2f(bf16_t v) { return __uint_as_float((unsigned)v << 16); }
__device__ __forceinline__ unsigned f2bf(float f) { unsigned u = __float_as_uint(f); return (u + 0x7fffu + ((u >> 16) & 1u)) >> 16; }
__device__ __forceinline__ unsigned pk2(float lo, float hi) { return f2bf(lo) | (f2bf(hi) << 16); }
__device__ __forceinline__ float bflo(unsigned w) { return __uint_as_float(w << 16); }
__device__ __forceinline__ float bfhi(unsigned w) { return __uint_as_float(w & 0xffff0000u); }
__device__ __forceinline__ float wave_sum(float v) {
#pragma unroll
    for (int o = 1; o < 64; o <<= 1) v += __shfl_xor(v, o);
    return v;
}
__device__ __forceinline__ float silu_f(float x) { return x / (1.f + __expf(-x)); }
__device__ __forceinline__ int vzero() { int z; asm volatile("v_mov_b32 %0, 0" : "=v"(z)); return z; }

#define XB_TMO      128
#define XB_XCNT(j)  (256  + 64 * (j))
#define XB_XSUB(j)  (1280 + 64 * (j))
#define XB_XGEN(j)  (2304 + 64 * (j))
#define XB_TOP      3328
#define XB_TOPGEN   3392
#define XCD_BAR_WORDS 3456
#define XB_SPIN_CAP (1u << 22)
__device__ __forceinline__ unsigned xb_ld(unsigned* p)              { return __hip_atomic_load(p, __ATOMIC_RELAXED, __HIP_MEMORY_SCOPE_AGENT); }
__device__ __forceinline__ unsigned xb_add(unsigned* p, unsigned v) { return __hip_atomic_fetch_add(p, v, __ATOMIC_RELAXED, __HIP_MEMORY_SCOPE_AGENT); }
__device__ __forceinline__ unsigned xb_xcc_id() { return (unsigned)__builtin_amdgcn_s_getreg((3 << 11) | 20) & 0xFu; }
#define XB_SPIN(cond, bar) do { unsigned _sp = 0; while (cond) { __builtin_amdgcn_s_sleep(1); \
    if ((++_sp & 255u) == 0u) { if (xb_ld(&(bar)[XB_TMO])) break; if (_sp > XB_SPIN_CAP) { atomicAdd(&(bar)[XB_TMO], 1u); break; } } } } while (0)
struct XcdBarrier { unsigned* bar; unsigned x; volatile LAS unsigned* st; };
__device__ __forceinline__ XcdBarrier xcd_barrier_post(unsigned* bar, volatile LAS unsigned* st) {
    XcdBarrier b; b.bar = bar; b.x = xb_xcc_id(); b.st = st;
    if (threadIdx.x == 0) (void)xb_add(&bar[XB_XCNT(b.x)], 1u);
    return b;
}
__device__ __forceinline__ void xcd_barrier_complete(unsigned* bar, unsigned x, unsigned& nloc, unsigned& nx) {
    const unsigned G = gridDim.x * gridDim.y * gridDim.z;
    unsigned sum, cnt, mine, sp = 0u;
    for (;;) {
        sum = 0u; cnt = 0u; mine = 0u;
#pragma unroll
        for (unsigned j = 0; j < 16; ++j) { const unsigned c = xb_ld(&bar[XB_XCNT(j)]); sum += c; cnt += (c > 0u) ? 1u : 0u; mine = (j == x) ? c : mine; }
        if (sum == G) break;
        __builtin_amdgcn_s_sleep(1);
        if ((++sp & 255u) == 0u) { if (xb_ld(&bar[XB_TMO])) break; if (sp > XB_SPIN_CAP) { atomicAdd(&bar[XB_TMO], 1u); break; } }
    }
    nloc = mine > 0u ? mine : 1u; nx = cnt > 0u ? cnt : 1u;
}
__device__ __forceinline__ void xcd_barrier(const XcdBarrier& b) {
    asm volatile("s_waitcnt vmcnt(0)" ::: "memory");
    __syncthreads();
    if (threadIdx.x == 0) {
        unsigned* bar = b.bar;
        __builtin_amdgcn_s_waitcnt(0);
        unsigned nloc = b.st[0], nx = b.st[1];
        if (nloc == 0u) { xcd_barrier_complete(bar, b.x, nloc, nx); b.st[0] = nloc; b.st[1] = nx; }
        const unsigned old = xb_add(&bar[XB_XSUB(b.x)], 1u);
        const unsigned gen = old / nloc;
        if (old + 1u == (gen + 1u) * nloc) {
            __builtin_amdgcn_fence(__ATOMIC_RELEASE, "agent");
            asm volatile("s_waitcnt vmcnt(0)" ::: "memory");
            const unsigned og = xb_add(&bar[XB_TOP], 1u);
            const unsigned tg = og / nx;
            if (og + 1u == (tg + 1u) * nx) xb_add(&bar[XB_TOPGEN], 1u);
            else XB_SPIN(xb_ld(&bar[XB_TOPGEN]) == tg, bar);
            __builtin_amdgcn_fence(__ATOMIC_ACQUIRE, "agent");
            xb_add(&bar[XB_XGEN(b.x)], 1u);
            asm volatile("s_waitcnt vmcnt(0)" ::: "memory");
        } else {
            XB_SPIN(xb_ld(&bar[XB_XGEN(b.x)]) == gen, bar);
            __builtin_amdgcn_fence(__ATOMIC_ACQUIRE, "agent");
            asm volatile("s_waitcnt vmcnt(0)" ::: "memory");
        }
    }
    __syncthreads();
}

struct Args { const float* in[N_IN]; float* out; unsigned char* ws; int ph_lo, ph_hi; };
struct Frame {
    LAS unsigned char* lds;
    int tid, lane, wave, G, bid;
    const float* const* in;
    float* out; unsigned char* ws;
    float* tab; float* H; bf16_t* U; float* AFF; int* SLOT; int* RIDX; float* GATE;
    bf16_t* SEAM; bf16_t* Y; bf16_t* HE; bf16_t* YE; float* P;
};

__device__ __forceinline__ double inv_freq(int f, int nf) {
    const double r16 = 0.5623413251903491;
    const int steps = (nf == 16) ? f : 2 * f;
    double v = 1.0;
    for (int i = 0; i < steps; ++i) v *= r16;
    return v;
}
__device__ __forceinline__ void sincos_d(double x, double& s, double& c) {
    const double TWO_PI = 6.283185307179586476925286766559;
    const double k = __builtin_rint(x / TWO_PI);
    const double r = x - k * TWO_PI;
    const double r2 = r * r;
    double ts = 1.0, tc = 1.0, ss = 1.0, cs = 1.0;
#pragma unroll 1
    for (int n = 1; n <= 14; ++n) {
        tc *= -r2 / (double)((2 * n - 1) * (2 * n));
        ts *= -r2 / (double)((2 * n) * (2 * n + 1));
        cs += tc; ss += ts;
    }
    s = r * ss; c = cs;
}

__device__ __forceinline__ void phase_prologue(Frame& F) {
    const int gt = F.bid * NTHR + F.tid, NGT = F.G * NTHR;
    for (int i = gt; i < 128 * 16 + 128 * 8; i += NGT) {
        if (i < 2048) { const int pos = i >> 4, f = i & 15; double s, c; sincos_d((double)pos * inv_freq(f, 16), s, c); F.tab[TB_C64 + i] = (float)c; F.tab[TB_S64 + i] = (float)s; }
        else { const int j = i - 2048, pos = j >> 3, f = j & 7; double s, c; sincos_d((double)pos * inv_freq(f, 8), s, c); F.tab[TB_C32 + j] = (float)c; F.tab[TB_S32 + j] = (float)s; }
    }
    if (gt < DEPTH) {
        const int l = gt; float a = 0.f, b = 0.f;
        for (int i = 0; i < 32; ++i) { a += F.in[I_LQ1][l * 32 + i] * F.in[I_LK1][l * 32 + i]; b += F.in[I_LQ2][l * 32 + i] * F.in[I_LK2][l * 32 + i]; }
        const float lam_init = 0.8f - 0.6f * expf(-0.3f * (float)l);
        F.tab[TB_LAM + 2 * l] = expf(a) - expf(b) + lam_init; F.tab[TB_LAM + 2 * l + 1] = 1.f - lam_init;
    }
    LAS float* red = (LAS float*)F.lds;
    for (int u = F.bid; u < DEPTH * 96; u += F.G) {
        const int l = u / 96, n0 = (u % 96) * 64, ks = F.tid >> 6, nn = F.tid & 63;
        const float* W = F.in[I_WMOD] + (size_t)l * D * 6144 + n0 + nn;
        float a0 = 0.f, a1 = 0.f, a2 = 0.f;
        for (int k = ks * 128; k < ks * 128 + 128; ++k) {
            const float w = W[(size_t)k * 6144];
            a0 += silu_f(F.in[I_C][k]) * w; a1 += silu_f(F.in[I_C][D + k]) * w; a2 += silu_f(F.in[I_CCTX][k]) * w;
        }
        red[(ks * 3 + 0) * 64 + nn] = a0; red[(ks * 3 + 1) * 64 + nn] = a1; red[(ks * 3 + 2) * 64 + nn] = a2;
        __syncthreads();
        if (F.tid < 192) { const int v = F.tid >> 6; float s = 0.f;
            for (int q = 0; q < 8; ++q) s += red[(q * 3 + v) * 64 + nn];
            F.tab[TB_MOD + (l * 3 + v) * 6144 + n0 + nn] = s + F.in[I_BMOD][l * 6144 + n0 + nn]; }
        __syncthreads();
    }
}

template <int MODE> __device__ __forceinline__ void phase_norm(Frame& F, int l, bool src0, int comb_l, bool with_ctx) {
    const int gw = F.bid * NWAVES + F.wave, NGW = F.G * NWAVES;
    const int nrows = with_ctx ? ROWS : ROWS_L;
    for (int r = gw; r < nrows; r += NGW) {
        const bool isc = r >= ROWS_L; const int b = isc ? (r - ROWS_L) / LC : r / S; const int mv = isc ? 2 : b;
        const float* src = src0 ? (isc ? F.in[I_CTX] + (size_t)(r - ROWS_L) * D : F.in[I_X] + (size_t)r * D) : F.H + (size_t)r * D;
        f32x4 v[4];
#pragma unroll
        for (int j = 0; j < 4; ++j) v[j] = *(const f32x4*)(src + 4 * F.lane + 256 * j);
        if (comb_l >= 0) {
            const float* g2 = F.tab + TB_MOD + (comb_l * 3 + mv) * 6144 + 5 * D;
            const int* sl = F.SLOT + (size_t)r * 16;
            f32x4 acc[4];
#pragma unroll
            for (int j = 0; j < 4; ++j) acc[j] = (f32x4){0.f, 0.f, 0.f, 0.f};
            for (int e = 0; e < NE; ++e) {
                const int s_ = sl[e];
                if (s_ >= 0) {
                    const int base = isc ? 2 * CAP_L + b * CAP_C : b * CAP_L;
                    const bf16_t* y = F.YE + ((size_t)e * EPAD + base + s_) * D;
#pragma unroll
                    for (int j = 0; j < 4; ++j) { const uint2 w = *(const uint2*)(y + 4 * F.lane + 256 * j);
                        acc[j][0] += bflo(w.x); acc[j][1] += bfhi(w.x); acc[j][2] += bflo(w.y); acc[j][3] += bfhi(w.y); }
                }
            }
#pragma unroll
            for (int j = 0; j < 4; ++j) { const f32x4 g = *(const f32x4*)(g2 + 4 * F.lane + 256 * j); v[j] += g * acc[j]; *(f32x4*)(F.H + (size_t)r * D + 4 * F.lane + 256 * j) = v[j]; }
        }
        float ss = 0.f;
#pragma unroll
        for (int j = 0; j < 4; ++j) ss += (v[j][0] * v[j][0] + v[j][1] * v[j][1]) + (v[j][2] * v[j][2] + v[j][3] * v[j][3]);
        const float rs = 1.f / sqrtf(wave_sum(ss) * (1.f / D) + EPS);
        if (MODE == 2) {
#pragma unroll
            for (int j = 0; j < 4; ++j) { const f32x4 g = *(const f32x4*)(F.in[I_FG] + 4 * F.lane + 256 * j); *(f32x4*)(F.out + (size_t)r * D + 4 * F.lane + 256 * j) = v[j] * rs * g; }
        } else {
            const float* md = F.tab + TB_MOD + (l * 3 + mv) * 6144;
            const float* ng = F.in[I_N1G] + l * D;
#pragma unroll
            for (int j = 0; j < 4; ++j) { const int c0 = 4 * F.lane + 256 * j; const f32x4 g = *(const f32x4*)(ng + c0), sh = *(const f32x4*)(md + c0), sc = *(const f32x4*)(md + D + c0);
                const f32x4 u = (v[j] * rs * g) * (1.f + sc) + sh; uint2 w; w.x = pk2(u[0], u[1]); w.y = pk2(u[2], u[3]); *(uint2*)(F.U + (size_t)r * D + c0) = w; }
        }
    }
}

__device__ __forceinline__ void phase_norm2_router(Frame& F, int l, bool with_ctx) {
    LAS float* wr = (LAS float*)F.lds;
    for (int i = F.tid; i < D * NE; i += NTHR) wr[i] = F.in[I_WR][(size_t)l * D * NE + i];
    __syncthreads();
    const int gw = F.bid * NWAVES + F.wave, NGW = F.G * NWAVES;
    const int nrows = with_ctx ? ROWS : ROWS_L;
    for (int r = gw; r < nrows; r += NGW) {
        const bool isc = r >= ROWS_L; const int b = isc ? (r - ROWS_L) / LC : r / S; const int mv = isc ? 2 : b;
        const float* src = F.H + (size_t)r * D;
        const float* md = F.tab + TB_MOD + (l * 3 + mv) * 6144;
        const float* ng = F.in[I_N2G] + l * D;
        f32x4 v[4]; float ss = 0.f;
#pragma unroll
        for (int j = 0; j < 4; ++j) { v[j] = *(const f32x4*)(src + 4 * F.lane + 256 * j); ss += (v[j][0] * v[j][0] + v[j][1] * v[j][1]) + (v[j][2] * v[j][2] + v[j][3] * v[j][3]); }
        const float rs = 1.f / sqrtf(wave_sum(ss) * (1.f / D) + EPS);
        float lg[NE];
#pragma unroll
        for (int e = 0; e < NE; ++e) lg[e] = 0.f;
#pragma unroll
        for (int j = 0; j < 4; ++j) { const int c0 = 4 * F.lane + 256 * j; const f32x4 g = *(const f32x4*)(ng + c0), sh = *(const f32x4*)(md + 3 * D + c0), sc = *(const f32x4*)(md + 4 * D + c0);
            const f32x4 u = (v[j] * rs * g) * (1.f + sc) + sh; uint2 w; w.x = pk2(u[0], u[1]); w.y = pk2(u[2], u[3]); *(uint2*)(F.U + (size_t)r * D + c0) = w;
#pragma unroll
            for (int i = 0; i < 4; ++i) {
#pragma unroll
                for (int e4 = 0; e4 < 4; ++e4) { const f32x4 ww = *(const LAS f32x4*)(wr + (c0 + i) * NE + 4 * e4);
                    lg[4 * e4 + 0] += u[i] * ww[0]; lg[4 * e4 + 1] += u[i] * ww[1]; lg[4 * e4 + 2] += u[i] * ww[2]; lg[4 * e4 + 3] += u[i] * ww[3]; }
                asm volatile("" ::: "memory");
            }
        }
        float mx = -1e30f;
#pragma unroll
        for (int e = 0; e < NE; ++e) { lg[e] = wave_sum(lg[e]); mx = fmaxf(mx, lg[e]); }
        float sm = 0.f;
#pragma unroll
        for (int e = 0; e < NE; ++e) { lg[e] = expf(lg[e] - mx); sm += lg[e]; }
        const float inv = 1.f / sm;
        float mine = 0.f;
#pragma unroll
        for (int e = 0; e < NE; ++e) mine = (F.lane == e) ? lg[e] * inv : mine;
        if (F.lane < NE) F.AFF[(size_t)r * NE + F.lane] = mine;
    }
    __syncthreads();
}

__device__ __forceinline__ void phase_select_naive(Frame& F, bool with_ctx) {
    LAS float* col = (LAS float*)F.lds;
    const int NU = 32 * 16 + (with_ctx ? 32 : 0);
    for (int i = F.bid * NTHR + F.tid; i < NE * EPAD; i += F.G * NTHR) { const int sl = i % EPAD; if (sl >= (with_ctx ? ESLOTS : 2 * CAP_L)) { F.RIDX[i] = -1; F.GATE[i] = 0.f; } }
    for (int u = F.bid; u < NU; u += F.G) {
        const bool isc = u >= 512; const int li = isc ? u - 512 : u / 16, ch = isc ? 0 : u % 16, b = li / NE, e = li % NE;
        const int N = isc ? LC : S, C = isc ? CAP_C : CAP_L, row0 = isc ? ROWS_L + b * LC : b * S;
        __syncthreads();
        for (int i = F.tid; i < N; i += NTHR) col[i] = F.AFF[(size_t)(row0 + i) * NE + e];
        __syncthreads();
        const int n = ch * 512 + F.tid;
        if (n < N) {
            const float a = col[n]; int rank = 0;
            for (int m = 0; m < N; ++m) { const float x = col[m]; rank += (x > a || (x == a && m < n)) ? 1 : 0; }
            if (rank < C) { const int sl = (isc ? 2 * CAP_L + b * CAP_C : b * CAP_L) + rank; F.RIDX[e * EPAD + sl] = row0 + n; F.GATE[e * EPAD + sl] = a; F.SLOT[(size_t)(row0 + n) * NE + e] = rank; }
            else F.SLOT[(size_t)(row0 + n) * NE + e] = -1;
        }
    }
    __syncthreads();
}

struct NaiveEpi { int mode; int l; float* P; const float* hin; float* hout; const float* mod; bf16_t* HE; bf16_t* YE; const float* gate; };
template <bool DUAL> __device__ __forceinline__ void naive_gemm_tile(Frame& F, const bf16_t* A, int lda, const int* ridx, int m0, int M, const float* W, const float* W2, int ldw, int n0, int K, const NaiveEpi& E, int erow0) {
    LAS float* As = (LAS float*)F.lds;
    LAS float* Bs = As + 16 * 132;
    LAS float* Bs2 = Bs + 16 * 64;
    const int ty = F.tid >> 4, tx = F.tid & 15;
    float acc[4][4], acc2[4][4];
#pragma unroll
    for (int i = 0; i < 4; ++i)
#pragma unroll
        for (int j = 0; j < 4; ++j) { acc[i][j] = 0.f; acc2[i][j] = 0.f; }
    const int ar = F.tid >> 1, ah = F.tid & 1;
    long arow = -1;
    if (F.tid < 256) { const int m = m0 + ar; if (m < M) arow = ridx ? (long)ridx[m] : (long)m; }
    const int bk = (F.tid - 256) >> 4, bc = (F.tid - 256) & 15;
    for (int k0 = 0; k0 < K; k0 += 16) {
        __syncthreads();
        if (F.tid < 256) {
            u32x4 w = (u32x4){0u, 0u, 0u, 0u};
            if (arow >= 0) w = *(const u32x4*)(A + (size_t)arow * lda + k0 + ah * 8);
            const int kb = ah * 8;
            As[(kb + 0) * 132 + ar] = bflo(w.x); As[(kb + 1) * 132 + ar] = bfhi(w.x); As[(kb + 2) * 132 + ar] = bflo(w.y); As[(kb + 3) * 132 + ar] = bfhi(w.y);
            As[(kb + 4) * 132 + ar] = bflo(w.z); As[(kb + 5) * 132 + ar] = bfhi(w.z); As[(kb + 6) * 132 + ar] = bflo(w.w); As[(kb + 7) * 132 + ar] = bfhi(w.w);
        } else {
            *(LAS f32x4*)(Bs + bk * 64 + bc * 4) = *(const f32x4*)(W + (size_t)(k0 + bk) * ldw + n0 + bc * 4);
            if (DUAL) *(LAS f32x4*)(Bs2 + bk * 64 + bc * 4) = *(const f32x4*)(W2 + (size_t)(k0 + bk) * ldw + n0 + bc * 4);
        }
        __syncthreads();
#pragma unroll
        for (int k = 0; k < 16; ++k) {
            const f32x4 a = *(const LAS f32x4*)(As + k * 132 + ty * 4), b = *(const LAS f32x4*)(Bs + k * 64 + tx * 4);
#pragma unroll
            for (int i = 0; i < 4; ++i)
#pragma unroll
                for (int j = 0; j < 4; ++j) acc[i][j] += a[i] * b[j];
            if (DUAL) { const f32x4 b2 = *(const LAS f32x4*)(Bs2 + k * 64 + tx * 4);
#pragma unroll
                for (int i = 0; i < 4; ++i)
#pragma unroll
                    for (int j = 0; j < 4; ++j) acc2[i][j] += a[i] * b2[j]; }
        }
    }
#pragma unroll
    for (int i = 0; i < 4; ++i) {
        const int m = m0 + ty * 4 + i; if (m >= M) continue;
        const int c0 = n0 + tx * 4;
        if (E.mode == 0) { *(f32x4*)(E.P + (size_t)m * DIN + c0) = (f32x4){acc[i][0], acc[i][1], acc[i][2], acc[i][3]}; }
        else if (E.mode == 1) {
            const bool isc = m >= ROWS_L; const int b = isc ? (m - ROWS_L) / LC : m / S; const int mv = isc ? 2 : b;
            const f32x4 g = *(const f32x4*)(E.mod + (E.l * 3 + mv) * 6144 + 2 * D + c0);
            const float* hi_ = (E.hin == nullptr) ? (isc ? F.in[I_CTX] + (size_t)(m - ROWS_L) * D : F.in[I_X] + (size_t)m * D) : E.hin + (size_t)m * D;
            const f32x4 h = *(const f32x4*)(hi_ + c0);
            *(f32x4*)(E.hout + (size_t)m * D + c0) = h + g * (f32x4){acc[i][0], acc[i][1], acc[i][2], acc[i][3]};
        } else if (E.mode == 2) {
            uint2 w; w.x = pk2(silu_f(acc[i][0]) * acc2[i][0], silu_f(acc[i][1]) * acc2[i][1]); w.y = pk2(silu_f(acc[i][2]) * acc2[i][2], silu_f(acc[i][3]) * acc2[i][3]);
            *(uint2*)(E.HE + (size_t)(erow0 + m) * D + c0) = w;
        } else {
            const float g = E.gate[erow0 + m];
            uint2 w; w.x = pk2(g * acc[i][0], g * acc[i][1]); w.y = pk2(g * acc[i][2], g * acc[i][3]);
            *(uint2*)(E.YE + (size_t)(erow0 + m) * D + c0) = w;
        }
    }
}

__device__ __forceinline__ void phase_inproj_naive(Frame& F, int l) {
    NaiveEpi E{}; E.mode = 0; E.P = F.P;
    const int nM = ROWS / 128, nN = DIN / 64;
    for (int u = F.bid; u < nM * nN; u += F.G) { const int pm = u / nN, pn = u % nN;
        naive_gemm_tile<false>(F, F.U, D, nullptr, pm * 128, ROWS, F.in[I_WIN] + (size_t)l * D * DIN, nullptr, DIN, pn * 64, D, E, 0); }
    __syncthreads();
}
__device__ __forceinline__ void phase_outproj_naive(Frame& F, int l, bool with_ctx) {
    NaiveEpi E{}; E.mode = 1; E.l = l; E.hin = (l == 0) ? nullptr : F.H; E.hout = F.H; E.mod = F.tab + TB_MOD;
    const int M = with_ctx ? ROWS : ROWS_L; const int nM = M / 128, nN = D / 64;
    for (int u = F.bid; u < nM * nN; u += F.G) { const int pm = u / nN, pn = u % nN;
        naive_gemm_tile<false>(F, F.Y, D, nullptr, pm * 128, M, F.in[I_WOUT] + (size_t)l * D * D, nullptr, D, pn * 64, D, E, 0); }
    __syncthreads();
}
__device__ __forceinline__ void phase_moe1_naive(Frame& F, int l, bool with_ctx) {
    NaiveEpi E{}; E.mode = 2; E.HE = F.HE;
    const int M = with_ctx ? ESLOTS : 2 * CAP_L; const int nM = (M + 127) / 128, nN = D / 64;
    for (int u = F.bid; u < NE * nM * nN; u += F.G) { const int e = u / (nM * nN), r = u % (nM * nN), pm = r / nN, pn = r % nN;
        naive_gemm_tile<true>(F, F.U, D, F.RIDX + e * EPAD, pm * 128, M, F.in[I_WG] + ((size_t)l * NE + e) * D * D, F.in[I_WU] + ((size_t)l * NE + e) * D * D, D, pn * 64, D, E, e * EPAD); }
    __syncthreads();
}
__device__ __forceinline__ void phase_moe2_naive(Frame& F, int l, bool with_ctx) {
    NaiveEpi E{}; E.mode = 3; E.YE = F.YE; E.gate = F.GATE;
    const int M = with_ctx ? ESLOTS : 2 * CAP_L; const int nM = (M + 127) / 128, nN = D / 64;
    for (int u = F.bid; u < NE * nM * nN; u += F.G) { const int e = u / (nM * nN), r = u % (nM * nN), pm = r / nN, pn = r % nN;
        naive_gemm_tile<false>(F, F.HE + (size_t)e * EPAD * D, D, nullptr, pm * 128, M, F.in[I_WD] + ((size_t)l * NE + e) * D * D, nullptr, D, pn * 64, D, E, e * EPAD); }
    __syncthreads();
}

__device__ __forceinline__ void store64(bf16_t* dst, const float (&v)[64]) {
#pragma unroll
    for (int i = 0; i < 8; ++i) { u32x4 w; w.x = pk2(v[8 * i], v[8 * i + 1]); w.y = pk2(v[8 * i + 2], v[8 * i + 3]); w.z = pk2(v[8 * i + 4], v[8 * i + 5]); w.w = pk2(v[8 * i + 6], v[8 * i + 7]); *(u32x4*)(dst + 8 * i) = w; }
}
template <int DIM, int OFF> __device__ __forceinline__ void rope_vec(float (&v)[64], const float* tab, int t) {
    constexpr int half = DIM / 2, nf = half / 2;
    const int pr = t >> 6, pc = t & 63;
    const float* C = tab + (DIM == 64 ? TB_C64 : TB_C32); const float* Sn = tab + (DIM == 64 ? TB_S64 : TB_S32);
#pragma unroll
    for (int i = 0; i < half; ++i) {
        const int pos = (i < nf) ? pr : pc, f = (i < nf) ? i : i - nf;
        const float c = C[pos * nf + f], s = Sn[pos * nf + f];
        const float x1 = v[OFF + i], x2 = v[OFF + half + i];
        v[OFF + i] = x1 * c - x2 * s; v[OFF + half + i] = x2 * c + x1 * s;
    }
}
__device__ __forceinline__ void phase_post_naive(Frame& F, int l) {
    const long NT = (long)ROWS * 40;
    for (long it = (long)F.bid * NTHR + F.tid; it < NT; it += (long)F.G * NTHR) {
        const int r = (int)(it / 40), u = (int)(it % 40);
        if (u >= 16 && u < 20) continue;
        const bool isc = r >= ROWS_L; const int b = isc ? (r - ROWS_L) / LC : r / S; const int t = isc ? (r - ROWS_L) % LC : r % S;
        const int key = isc ? t : LC + t;
        const float* p = F.P + (size_t)r * DIN + 64 * u;
        float v[64];
#pragma unroll
        for (int i = 0; i < 16; ++i) { const f32x4 x = *(const f32x4*)(p + 4 * i); v[4 * i] = x[0]; v[4 * i + 1] = x[1]; v[4 * i + 2] = x[2]; v[4 * i + 3] = x[3]; }
        bf16_t* dst;
        if (u < 4) {
            const float sc = 0.125f * LOG2E;
#pragma unroll
            for (int i = 0; i < 64; ++i) v[i] *= sc;
            dst = isc ? F.SEAM + SE_QAC + (((size_t)b * 4 + u) * LC + t) * 64 : F.SEAM + SE_QA + (((size_t)b * 4 + u) * S + t) * 64;
        } else if (u < 8) { dst = F.SEAM + SE_KA + (((size_t)b * 4 + (u - 4)) * KV + key) * 64; }
        else if (u < 12) { dst = F.SEAM + SE_VA + (((size_t)b * 4 + (u - 8)) * KV + key) * 64; }
        else if (u < 16) {
            const float* pg = p + 256;
#pragma unroll
            for (int i = 0; i < 16; ++i) { const f32x4 g = *(const f32x4*)(pg + 4 * i);
                v[4 * i] *= 1.f / (1.f + __expf(-g[0])); v[4 * i + 1] *= 1.f / (1.f + __expf(-g[1])); v[4 * i + 2] *= 1.f / (1.f + __expf(-g[2])); v[4 * i + 3] *= 1.f / (1.f + __expf(-g[3])); }
            dst = F.SEAM + SE_Z + (size_t)r * 256 + 64 * (u - 12);
        } else if (u < 24) {
            const int hq = u - 20; const float* g = F.in[I_QNG] + l * 64; float ss = 0.f;
#pragma unroll
            for (int i = 0; i < 64; ++i) ss += v[i] * v[i];
            const float rs = 1.f / sqrtf(ss * (1.f / 64.f) + EPS);
#pragma unroll
            for (int i = 0; i < 64; ++i) v[i] = v[i] * rs * g[i];
            if (!isc) rope_vec<64, 0>(v, F.tab, t);
            const float sc = 0.125f * LOG2E;
#pragma unroll
            for (int i = 0; i < 64; ++i) v[i] *= sc;
            dst = isc ? F.SEAM + SE_QGC + (((size_t)b * 4 + hq) * LC + t) * 64 : F.SEAM + SE_QG + (((size_t)b * 4 + hq) * S + t) * 64;
        } else if (u < 26) {
            const int hk = u - 24; const float* g = F.in[I_KNG] + l * 64; float ss = 0.f;
#pragma unroll
            for (int i = 0; i < 64; ++i) ss += v[i] * v[i];
            const float rs = 1.f / sqrtf(ss * (1.f / 64.f) + EPS);
#pragma unroll
            for (int i = 0; i < 64; ++i) v[i] = v[i] * rs * g[i];
            if (!isc) rope_vec<64, 0>(v, F.tab, t);
            dst = F.SEAM + SE_KG + (((size_t)b * 2 + hk) * KV + key) * 64;
        } else if (u < 28) { dst = F.SEAM + SE_VG + (((size_t)b * 2 + (u - 26)) * KV + key) * 64; }
        else if (u < 32) {
            const int h = u - 28;
            if (!isc) { rope_vec<32, 0>(v, F.tab, t); rope_vec<32, 32>(v, F.tab, t); }
            const float sc = 0.17677669529663687f * LOG2E;
#pragma unroll
            for (int i = 0; i < 64; ++i) v[i] *= sc;
            dst = isc ? F.SEAM + SE_QDC + (((size_t)b * 4 + h) * LC + t) * 64 : F.SEAM + SE_QD + (((size_t)b * 4 + h) * S + t) * 64;
        } else if (u < 36) {
            const int h = u - 32;
            if (!isc) { rope_vec<32, 0>(v, F.tab, t); rope_vec<32, 32>(v, F.tab, t); }
            dst = F.SEAM + SE_KD + (((size_t)b * 4 + h) * KV + key) * 64;
        } else { dst = F.SEAM + SE_VD + (((size_t)b * 4 + (u - 36)) * KV + key) * 64; }
        store64(dst, v);
    }
}

__device__ __forceinline__ void load64(float (&v)[64], const bf16_t* p) {
#pragma unroll
    for (int i = 0; i < 8; ++i) { const u32x4 w = *(const u32x4*)(p + 8 * i);
        v[8 * i] = bflo(w.x); v[8 * i + 1] = bfhi(w.x); v[8 * i + 2] = bflo(w.y); v[8 * i + 3] = bfhi(w.y); v[8 * i + 4] = bflo(w.z); v[8 * i + 5] = bfhi(w.z); v[8 * i + 6] = bflo(w.w); v[8 * i + 7] = bfhi(w.w); }
}
struct Q64 { u32x4 w[8]; };
__device__ __forceinline__ void loadq(Q64& q, const bf16_t* p) {
#pragma unroll
    for (int i = 0; i < 8; ++i) q.w[i] = *(const u32x4*)(p + 8 * i);
}
__device__ __forceinline__ float dot8(u32x4 a, const u32x4 w, float s) {
    asm volatile("" : "+v"(a));
    s += bflo(a.x) * bflo(w.x); s += bfhi(a.x) * bfhi(w.x); s += bflo(a.y) * bflo(w.y); s += bfhi(a.y) * bfhi(w.y);
    s += bflo(a.z) * bflo(w.z); s += bfhi(a.z) * bfhi(w.z); s += bflo(a.w) * bflo(w.w); s += bfhi(a.w) * bfhi(w.w); return s;
}
__device__ __forceinline__ float dot64(const Q64& q, const bf16_t* k) {
    float s0 = 0.f, s1 = 0.f;
#pragma unroll
    for (int i = 0; i < 8; i += 2) { s0 = dot8(q.w[i], *(const u32x4*)(k + 8 * i), s0); s1 = dot8(q.w[i + 1], *(const u32x4*)(k + 8 * i + 8), s1); }
    return s0 + s1;
}
template <int OFF> __device__ __forceinline__ float dot32(const Q64& q, const bf16_t* k) {
    float s0 = 0.f, s1 = 0.f;
#pragma unroll
    for (int i = 0; i < 4; i += 2) { s0 = dot8(q.w[OFF / 8 + i], *(const u32x4*)(k + OFF + 8 * i), s0); s1 = dot8(q.w[OFF / 8 + i + 1], *(const u32x4*)(k + OFF + 8 * i + 8), s1); }
    return s0 + s1;
}
__device__ __forceinline__ void axpy64(float (&o)[64], float p, const bf16_t* vrow) {
#pragma unroll
    for (int i = 0; i < 8; ++i) { const u32x4 w = *(const u32x4*)(vrow + 8 * i);
        o[8 * i] += p * bflo(w.x); o[8 * i + 1] += p * bfhi(w.x); o[8 * i + 2] += p * bflo(w.y); o[8 * i + 3] += p * bfhi(w.y);
        o[8 * i + 4] += p * bflo(w.z); o[8 * i + 5] += p * bfhi(w.z); o[8 * i + 6] += p * bflo(w.w); o[8 * i + 7] += p * bfhi(w.w); }
}
#define OSM_STEP(m, lsum, o, s, vrow) do { if ((s) > (m)) { const float f_ = exp2f((m) - (s)); (lsum) *= f_; _Pragma("unroll") for (int i_ = 0; i_ < 64; ++i_) (o)[i_] *= f_; (m) = (s); } \
    const float p_ = exp2f((s) - (m)); (lsum) += p_; axpy64((o), p_, (vrow)); } while (0)

__device__ __forceinline__ void axpy32(float (&o)[32], float p, const bf16_t* vrow) {
#pragma unroll
    for (int i = 0; i < 4; ++i) { const u32x4 w = *(const u32x4*)(vrow + 8 * i);
        o[8 * i] += p * bflo(w.x); o[8 * i + 1] += p * bfhi(w.x); o[8 * i + 2] += p * bflo(w.y); o[8 * i + 3] += p * bfhi(w.y);
        o[8 * i + 4] += p * bflo(w.z); o[8 * i + 5] += p * bfhi(w.z); o[8 * i + 6] += p * bflo(w.w); o[8 * i + 7] += p * bfhi(w.w); }
}
#define OSM_STEP32(m, lsum, o, s, vrow) do { if ((s) > (m)) { const float f_ = exp2f((m) - (s)); (lsum) *= f_; _Pragma("unroll") for (int i_ = 0; i_ < 32; ++i_) (o)[i_] *= f_; (m) = (s); } \
    const float p_ = exp2f((s) - (m)); (lsum) += p_; axpy32((o), p_, (vrow)); } while (0)
__device__ __forceinline__ void naive_diff(Frame& F, int l, const bf16_t* qp, const bf16_t* K, const bf16_t* V, int nk, int dh, bf16_t* dst) {
    Q64 q; loadq(q, qp);
    float o1[32], o2[32]; float m1 = -1e30f, l1 = 0.f, m2 = -1e30f, l2 = 0.f;
#pragma unroll
    for (int i = 0; i < 32; ++i) { o1[i] = 0.f; o2[i] = 0.f; }
    const int z = vzero();
#pragma unroll 1
    for (int j = 0; j < nk; ++j) {
        const bf16_t* kr = K + (size_t)(j + z) * 64; const bf16_t* vr = V + (size_t)(j + z) * 64 + 32 * dh;
        const float s1 = dot32<0>(q, kr), s2 = dot32<32>(q, kr);
        OSM_STEP32(m1, l1, o1, s1, vr); OSM_STEP32(m2, l2, o2, s2, vr);
    }
    const float lam = F.tab[TB_LAM + 2 * l], oml = F.tab[TB_LAM + 2 * l + 1];
    const float i1 = 1.f / l1, i2 = lam / l2; float ss = 0.f;
#pragma unroll
    for (int i = 0; i < 32; ++i) { o1[i] = o1[i] * i1 - o2[i] * i2; ss += o1[i] * o1[i]; }
    ss += __shfl_xor(ss, 1);
    const float rs = oml / sqrtf(ss * (1.f / 64.f) + EPS);
    const float* g = F.in[I_DNG] + l * 64 + 32 * dh;
#pragma unroll
    for (int i = 0; i < 4; ++i) { u32x4 w; w.x = pk2(o1[8 * i] * rs * g[8 * i], o1[8 * i + 1] * rs * g[8 * i + 1]); w.y = pk2(o1[8 * i + 2] * rs * g[8 * i + 2], o1[8 * i + 3] * rs * g[8 * i + 3]);
        w.z = pk2(o1[8 * i + 4] * rs * g[8 * i + 4], o1[8 * i + 5] * rs * g[8 * i + 5]); w.w = pk2(o1[8 * i + 6] * rs * g[8 * i + 6], o1[8 * i + 7] * rs * g[8 * i + 7]); *(u32x4*)(dst + 8 * i) = w; }
}
__device__ __forceinline__ void store32n(bf16_t* dst, const float (&o)[32], float inv) {
#pragma unroll
    for (int i = 0; i < 4; ++i) { u32x4 w; w.x = pk2(o[8 * i] * inv, o[8 * i + 1] * inv); w.y = pk2(o[8 * i + 2] * inv, o[8 * i + 3] * inv);
        w.z = pk2(o[8 * i + 4] * inv, o[8 * i + 5] * inv); w.w = pk2(o[8 * i + 6] * inv, o[8 * i + 7] * inv); *(u32x4*)(dst + 8 * i) = w; }
}
__device__ __forceinline__ void naive_attn(const bf16_t* qp, const bf16_t* K, const bf16_t* V, int nk, int dh, bf16_t* dst) {
    Q64 q; loadq(q, qp);
    float o[32]; float m = -1e30f, ls = 0.f;
#pragma unroll
    for (int i = 0; i < 32; ++i) o[i] = 0.f;
    const int z = vzero();
#pragma unroll 1
    for (int j = 0; j < nk; ++j) { const float s = dot64(q, K + (size_t)(j + z) * 64); OSM_STEP32(m, ls, o, s, V + (size_t)(j + z) * 64 + 32 * dh); }
    store32n(dst, o, 1.f / ls);
}
__device__ __forceinline__ void naive_na(Frame& F, int l, int b, int h, int t, int dh, bf16_t* dst) {
    Q64 q; loadq(q, F.SEAM + SE_QA + (((size_t)b * 4 + h) * S + t) * 64);
    const bf16_t* K = F.SEAM + SE_KA + ((size_t)b * 4 + h) * KV * 64; const bf16_t* V = F.SEAM + SE_VA + ((size_t)b * 4 + h) * KV * 64 + 32 * dh;
    const float* rpb = F.in[I_RPB] + ((size_t)l * 4 + h) * 15 * 31;
    const int r = t >> 6, jq = t & 63;
    int rs = r - 4; rs = rs < 0 ? 0 : (rs > 120 ? 120 : rs);
    int cs = jq - 8; cs = cs < 0 ? 0 : (cs > 48 ? 48 : cs);
    float o[32]; float m = -1e30f, ls = 0.f;
#pragma unroll
    for (int i = 0; i < 32; ++i) o[i] = 0.f;
#pragma unroll 1
    for (int kk = 0; kk < 128 + LC; ++kk) {
        int key; float bias = 0.f;
        if (kk < 128) { const int rr = rs + (kk >> 4), cc = cs + (kk & 15); key = LC + rr * 64 + cc;
            const int dr = rr - r + 7; int dc = cc - jq; dc = dc < -15 ? -15 : (dc > 15 ? 15 : dc); dc += 15; bias = rpb[dr * 31 + dc] * LOG2E; }
        else key = kk - 128;
        const float s = dot64(q, K + (size_t)key * 64) + bias;
        OSM_STEP32(m, ls, o, s, V + (size_t)key * 64);
    }
    store32n(dst, o, 1.f / ls);
}
__device__ __forceinline__ void phase_conv_naive(Frame& F, int l, int unit, bool ctxu) {
    LAS float* zc = (LAS float*)F.lds;
    const int row0 = ctxu ? ROWS_L + unit * 16 : unit * 16;
    const int seqlen = ctxu ? LC : S; const int t0 = (ctxu ? unit * 16 : unit * 16) % seqlen; const int seqrow0 = row0 - t0;
    const bf16_t* Z = F.SEAM + SE_Z;
    const float* dww = F.in[I_DWW] + (size_t)l * 31 * 256; const float* dwb = F.in[I_DWB] + l * 256;
    __syncthreads();
#pragma unroll 1
    for (int i = F.tid; i < 16 * 256; i += NTHR) {
        const int tt = i >> 8, c = i & 255; float a = dwb[c];
#pragma unroll 4
        for (int k = 0; k < 31; ++k) { const int ts = t0 + tt + k - 15; if (ts >= 0 && ts < seqlen) a += bf2f(Z[(size_t)(seqrow0 + ts) * 256 + c]) * dww[k * 256 + c]; }
        zc[i] = a;
    }
    __syncthreads();
    for (int tt = F.wave * 2; tt < F.wave * 2 + 2; ++tt) {
        float x[4]; float s = 0.f;
#pragma unroll
        for (int j = 0; j < 4; ++j) { x[j] = zc[tt * 256 + F.lane + 64 * j]; s += x[j]; }
        const float mu = wave_sum(s) * (1.f / 256.f); float q = 0.f;
#pragma unroll
        for (int j = 0; j < 4; ++j) { x[j] -= mu; q += x[j] * x[j]; }
        const float rs = 1.f / sqrtf(wave_sum(q) * (1.f / 256.f) + EPS);
#pragma unroll
        for (int j = 0; j < 4; ++j) { const int c = F.lane + 64 * j; const float y = x[j] * rs * F.in[I_LNG][l * 256 + c] + F.in[I_LNB][l * 256 + c]; zc[tt * 256 + c] = silu_f(y); }
    }
    __syncthreads();
    const float* pw = F.in[I_PWW] + (size_t)l * 256 * 256; const float* pb = F.in[I_PWB] + l * 256;
#pragma unroll 1
    for (int i = F.tid; i < 16 * 256; i += NTHR) {
        const int tt = i >> 8, c = i & 255; float a = pb[c];
#pragma unroll 8
        for (int k = 0; k < 256; ++k) a += zc[tt * 256 + k] * pw[k * 256 + c];
        F.Y[(size_t)(row0 + tt) * D + 256 + c] = (bf16_t)f2bf(a);
    }
}
#ifndef FAST_ATTN_SKIP
#define FAST_ATTN_SKIP 1
#endif
__device__ __forceinline__ void phase_mixers_naive(Frame& F, int l, bool with_ctx) {
    const int NA_U = with_ctx ? 264 : 256;
#define UNIT_DECODE const bool cu = u >= 256; const int nq = cu ? LC : S; const int idx = cu ? u - 256 : u; const int q0 = idx * 256 + (F.tid >> 1), dh = F.tid & 1; \
        const int b = q0 / (4 * nq), h = (q0 / nq) % 4, t = q0 % nq; const int row = cu ? ROWS_L + b * LC + t : b * S + t;
#pragma unroll 1
    for (int u = F.bid; u < (FAST_ATTN_SKIP ? 0 : NA_U); u += F.G) { UNIT_DECODE
        const bf16_t* qp = F.SEAM + (cu ? SE_QGC : SE_QG) + (((size_t)b * 4 + h) * nq + t) * 64;
        const size_t kvo = ((size_t)b * 2 + (h >> 1)) * KV * 64;
        naive_attn(qp, F.SEAM + SE_KG + kvo, F.SEAM + SE_VG + kvo, cu ? LC : KV, dh, F.Y + (size_t)row * D + 512 + h * 64 + 32 * dh);
    }
    asm volatile("" ::: "memory");
#pragma unroll 1
    for (int u = F.G - 1 - F.bid; u < (FAST_ATTN_SKIP ? 0 : NA_U); u += F.G) { UNIT_DECODE
        const bf16_t* qp = F.SEAM + (cu ? SE_QDC : SE_QD) + (((size_t)b * 4 + h) * nq + t) * 64;
        const size_t kvo = ((size_t)b * 4 + h) * KV * 64;
        naive_diff(F, l, qp, F.SEAM + SE_KD + kvo, F.SEAM + SE_VD + kvo, cu ? LC : KV, dh, F.Y + (size_t)row * D + 768 + h * 64 + 32 * dh);
    }
    asm volatile("" ::: "memory");
#pragma unroll 1
    for (int u = F.bid; u < NA_U; u += F.G) { UNIT_DECODE
        if (cu) { const bf16_t* qp = F.SEAM + SE_QAC + (((size_t)b * 4 + h) * LC + t) * 64; const size_t kvo = ((size_t)b * 4 + h) * KV * 64;
            naive_attn(qp, F.SEAM + SE_KA + kvo, F.SEAM + SE_VA + kvo, LC, dh, F.Y + (size_t)row * D + h * 64 + 32 * dh); }
        else naive_na(F, l, b, h, t, dh, F.Y + (size_t)row * D + h * 64 + 32 * dh);
    }
#undef UNIT_DECODE
    asm volatile("" ::: "memory");
#pragma unroll 1
    for (int u = F.bid; u < (with_ctx ? 1056 : 1024); u += F.G) { if (u < 1024) phase_conv_naive(F, l, u, false); else phase_conv_naive(F, l, u - 1024, true); }
    __syncthreads();
}


#ifndef FAST_INPROJ
#define FAST_INPROJ 1
#endif
#ifndef FAST_OUTPROJ
#define FAST_OUTPROJ 1
#endif
#ifndef FAST_MOE
#define FAST_MOE 1
#endif
constexpr size_t WB_GU = 0;
constexpr size_t WB_DN = 128 * MiB;
constexpr size_t WB_IN = 192 * MiB;
constexpr size_t WB_OUT = 202 * MiB;
static_assert(!(FAST_MOE && !FAST_INPROJ), "naive P overlays the MoE weight copies");
constexpr int GOFS_OFF = 131072 + 1024;

namespace pg8 {
typedef short bf16x8 __attribute__((ext_vector_type(8)));
constexpr int BM = 256, BK = 64, HALF = 128, HTB = HALF * BK * 2, STAGE_BYTES = 8 * HTB;
__device__ __forceinline__ int lds_byte(int r, int c) { const int st = (r >> 4) * 2 + (c >> 5), rr = r & 15, cc = c & 31, ob = rr * 64 + cc * 2; return st * 1024 + (ob ^ (((ob >> 9) & 1) << 5)); }
__device__ __forceinline__ void stage_rc(int b, int& R, int& C) { const int st = b / 1024, sb = b % 1024, swz = sb ^ (((sb >> 9) & 1) << 5); R = (st >> 1) * 16 + swz / 64; C = (st & 1) * 32 + (swz % 64) / 2; }
__device__ __forceinline__ int perm32(int rho) { const int n = rho >> 4, i = rho & 15; return 8 * (i >> 2) + 4 * n + (i & 3); }
struct Unit { int pm, pn; };
struct Gemm { const bf16_t* A; const bf16_t* Bt; int K; };

template <class Epi, class Sched, bool GATHER>
__device__ __forceinline__ void gemm_phase(LAS unsigned char* lds, const Gemm g, const Sched& S, const Epi& E, const LAS unsigned* gofs) {
    const int tid = threadIdx.x, wid = __builtin_amdgcn_readfirstlane(tid >> 6), lane = tid & 63, wr = wid >> 2, wc = wid & 3, fr = lane & 15, fq = lane >> 4;
    const int K = g.K, nt = K / BK;
    unsigned voffB[2];
#pragma unroll
    for (int i = 0; i < 2; ++i) { int R, C; stage_rc(tid * 16 + i * 8192, R, C); const int Rb = (R & ~31) + perm32(R & 31);
        voffB[i] = (unsigned)(Rb * K + C) * 2u; }
    const size_t kstep = (size_t)(BK * 2);
    const size_t hstep = (size_t)HALF * K * 2;
    const size_t tstep = 2 * hstep;
    const unsigned ldsw = (unsigned)wid * 1024u;
    const int aoff = lds_byte(wr * 64 + fr, fq * 8), boff = lds_byte(wc * 32 + fr, fq * 8);
#define PG8_SA(b, h) (((b) * 2 + (h)) * HTB)
#define PG8_SB(b, h) ((4 + (b) * 2 + (h)) * HTB)
#define PG8_STAGE(bufoff, gbase, voff) do { _Pragma("unroll") for (int _i = 0; _i < 2; ++_i) \
        __builtin_amdgcn_global_load_lds((const unsigned*)((const char*)(gbase) + (voff)[_i]), (LAS unsigned*)(lds + (bufoff) + ldsw + _i * 8192), 16, 0, 0); } while (0)
#define PG8_LDA(dst, b, h) do { _Pragma("unroll") for (int m = 0; m < 4; ++m) _Pragma("unroll") for (int k = 0; k < 2; ++k) dst[m][k] = *(const LAS bf16x8*)(lds + PG8_SA(b, h) + aoff + m * 2048 + k * 1024); } while (0)
#define PG8_LDB(dst, b, h) do { _Pragma("unroll") for (int n = 0; n < 2; ++n) _Pragma("unroll") for (int k = 0; k < 2; ++k) dst[n][k] = *(const LAS bf16x8*)(lds + PG8_SB(b, h) + boff + n * 2048 + k * 1024); } while (0)
#define PG8_MMA(ai, bj, At, Bt) do { __builtin_amdgcn_s_setprio(1); _Pragma("unroll") for (int m = 0; m < 4; ++m) _Pragma("unroll") for (int n = 0; n < 2; ++n) _Pragma("unroll") for (int k = 0; k < 2; ++k) \
        acc[ai][bj][m][n] = __builtin_amdgcn_mfma_f32_16x16x32_bf16(Bt[n][k], At[m][k], acc[ai][bj][m][n], 0, 0, 0); __builtin_amdgcn_s_setprio(0); } while (0)
#define PG8_WAIT_V(n) asm volatile("s_waitcnt vmcnt(" #n ")" ::: "memory")
#define PG8_WAIT_L(n) asm volatile("s_waitcnt lgkmcnt(" #n ")" ::: "memory")
#define PG8_BAR __builtin_amdgcn_s_barrier()
#define PG8_SCHED __builtin_amdgcn_sched_barrier(0)
#define PG8_AOFF(dst, u, slot) do { int _t = tid; asm volatile("" : "+v"(_t)); _Pragma("unroll") for (int _i = 0; _i < 2; ++_i) { int _R, _C; stage_rc(_t * 16 + _i * 8192, _R, _C); \
        _Pragma("unroll") for (int _h = 0; _h < 2; ++_h) \
        dst[_h][_i] = (GATHER ? gofs[(slot) * 256 + _h * HALF + _R] : (unsigned)((u).pm * BM + _h * HALF + _R) * (unsigned)(K * 2)) + (unsigned)_C * 2u; } } while (0)
    Unit cur, nxt; int ui = 0;
    if (!S.next(0, cur)) return;
    f32x4 acc[2][2][4][2];
#pragma unroll
    for (int a = 0; a < 2; ++a)
#pragma unroll
        for (int b = 0; b < 2; ++b)
#pragma unroll
            for (int m = 0; m < 4; ++m)
#pragma unroll
                for (int n = 0; n < 2; ++n) acc[a][b][m][n] = (f32x4){0.f, 0.f, 0.f, 0.f};
    bf16x8 At[4][2], B0[2][2], B1[2][2];
    unsigned ca[2][2];
    PG8_AOFF(ca, cur, 0);
    const char* Ab = (const char*)g.A; const char* cB = (const char*)g.Bt + (size_t)cur.pn * tstep;
    PG8_STAGE(PG8_SB(0, 0), cB, voffB); PG8_STAGE(PG8_SB(0, 1), cB + hstep, voffB); PG8_STAGE(PG8_SA(0, 0), Ab, ca[0]); PG8_STAGE(PG8_SA(0, 1), Ab, ca[1]);
    if (wr == 1) PG8_BAR;
    PG8_WAIT_V(2); PG8_BAR;
    PG8_STAGE(PG8_SB(1, 0), cB + kstep, voffB); PG8_STAGE(PG8_SA(1, 0), Ab + kstep, ca[0]); PG8_STAGE(PG8_SB(1, 1), cB + hstep + kstep, voffB);
    PG8_WAIT_V(6); PG8_BAR;
    for (;;) {
        const bool has_next = S.next(ui + 1, nxt);
        const char* nB = has_next ? (const char*)g.Bt + (size_t)nxt.pn * tstep : cB;
        for (int t = 0; t < nt; t += 2) {
            const bool last = (t == nt - 2);
            const char* a1 = Ab + (size_t)(t + 1) * kstep;
            const char* a2 = last ? Ab : Ab + (size_t)(t + 2) * kstep; const char* b2 = last ? nB : cB + (size_t)(t + 2) * kstep;
            const char* a3 = a2 + kstep; const char* b3 = b2 + kstep;
            PG8_LDB(B0, 0, 0); PG8_LDB(B1, 0, 1); PG8_SCHED; PG8_LDA(At, 0, 0); PG8_STAGE(PG8_SA(1, 1), a1, ca[1]);
            if (last && has_next) { PG8_AOFF(ca, nxt, ui + 1); }
            PG8_WAIT_V(8); PG8_WAIT_L(0); PG8_BAR; PG8_MMA(0, 0, At, B0); PG8_MMA(0, 1, At, B1); PG8_BAR; PG8_SCHED;
            PG8_LDA(At, 0, 1); PG8_STAGE(PG8_SB(0, 0), b2, voffB); PG8_STAGE(PG8_SB(0, 1), b2 + hstep, voffB); PG8_STAGE(PG8_SA(0, 0), a2, ca[0]);
            PG8_WAIT_V(8); PG8_WAIT_L(0); PG8_BAR; PG8_MMA(1, 0, At, B0); PG8_MMA(1, 1, At, B1); PG8_BAR; PG8_SCHED;
            PG8_LDB(B0, 1, 0); PG8_LDB(B1, 1, 1); PG8_SCHED; PG8_LDA(At, 1, 0); PG8_STAGE(PG8_SA(0, 1), a2, ca[1]);
            PG8_WAIT_V(8); PG8_WAIT_L(0); PG8_BAR; PG8_MMA(0, 0, At, B0); PG8_MMA(0, 1, At, B1); PG8_BAR; PG8_SCHED;
            PG8_LDA(At, 1, 1); PG8_STAGE(PG8_SB(1, 0), b3, voffB); PG8_STAGE(PG8_SB(1, 1), b3 + hstep, voffB); PG8_STAGE(PG8_SA(1, 0), a3, ca[0]);
            PG8_WAIT_V(8); PG8_WAIT_L(0); PG8_BAR; PG8_MMA(1, 0, At, B0); PG8_MMA(1, 1, At, B1); PG8_BAR; PG8_SCHED;
        }
        if (wr == 0) PG8_BAR;
        { int fr_ = fr, fq_ = fq, wr_ = wr, wc_ = wc; asm volatile("" : "+v"(fr_), "+v"(fq_), "+s"(wr_), "+s"(wc_));
          E(acc, cur, wr_, wc_, fr_, fq_); }
        if (!has_next) break;
#pragma unroll
        for (int a = 0; a < 2; ++a)
#pragma unroll
            for (int b = 0; b < 2; ++b)
#pragma unroll
                for (int m = 0; m < 4; ++m)
#pragma unroll
                    for (int n = 0; n < 2; ++n) acc[a][b][m][n] = (f32x4){0.f, 0.f, 0.f, 0.f};
        cur = nxt; cB = nB; ++ui;
        if (wr == 1) PG8_BAR;
    }
    PG8_WAIT_V(0);
    PG8_BAR;
#undef PG8_SA
#undef PG8_SB
#undef PG8_STAGE
#undef PG8_LDA
#undef PG8_LDB
#undef PG8_MMA
#undef PG8_WAIT_V
#undef PG8_WAIT_L
#undef PG8_BAR
#undef PG8_SCHED
#undef PG8_AOFF
}

struct OrderDense {
    int nM, nN, G, v;
    __device__ __forceinline__ bool next(int i, Unit& u) const {
        const int id = i * G + v; if (id >= nM * nN) return false;
        const int nig = 8 * nN, gid = id / nig, fm = gid * 8, gsz = (nM - fm) < 8 ? (nM - fm) : 8;
        u.pm = fm + ((id % nig) % gsz); u.pn = (id % nig) / gsz; return true;
    }
};
struct OrderMoe {
    int nM, nN, G, v;
    __device__ __forceinline__ bool next(int i, Unit& u) const {
        const int id = i * G + v; if (id >= NE * nM * nN) return false;
        const int e = id / (nM * nN), r = id % (nM * nN);
        u.pm = e * 9 + (r % nM); u.pn = e * nN + (r / nM); return true;
    }
};
}

__device__ __forceinline__ unsigned cvt_pk_bf16(float lo, float hi) { unsigned r; asm volatile("v_cvt_pk_bf16_f32 %0, %1, %2" : "=v"(r) : "v"(lo), "v"(hi)); return r; }
__device__ __forceinline__ u32x4 pack8(const f32x4 a, const f32x4 b) { u32x4 w; w.x = cvt_pk_bf16(a[0], a[1]); w.y = cvt_pk_bf16(a[2], a[3]); w.z = cvt_pk_bf16(b[0], b[1]); w.w = cvt_pk_bf16(b[2], b[3]); return w; }
__device__ __forceinline__ float fast_sigmoid(float x) { return __builtin_amdgcn_rcpf(1.f + __expf(-x)); }

struct EpiIn {
    bf16_t* SEAM; const float* tab; const float* qng; const float* kng;
    __device__ __forceinline__ void operator()(const f32x4 (&acc)[2][2][4][2], const pg8::Unit& u, int wr, int wc, int fr, int fq) const {
        const bool isc = u.pm >= 64; const int b = isc ? u.pm - 64 : u.pm >> 5; const int pn = u.pn; const int nq = isc ? LC : S;
        f32x4 gn[2][2];
        if (pn == 5 || pn == 6) { const float* g = (pn == 5) ? qng : kng;
#pragma unroll
            for (int bj = 0; bj < 2; ++bj)
#pragma unroll
                for (int n = 0; n < 2; ++n) gn[bj][n] = *(const f32x4*)(g + 32 * bj + 8 * fq + 4 * n); }
#pragma unroll
        for (int ai = 0; ai < 2; ++ai)
#pragma unroll
            for (int m = 0; m < 4; ++m) {
                const int rl = 128 * ai + 64 * wr + 16 * m + fr; const int r = u.pm * 256 + rl; const int t = isc ? rl : (r & (S - 1)); const int key = isc ? t : LC + t;
                const int e0 = 8 * fq;
                if (pn <= 2 || pn == 9 || (pn == 6 && wc >= 2)) {
                    bf16_t* base;
                    if (pn == 0) base = isc ? SEAM + SE_QAC + (((size_t)b * 4 + wc) * LC + t) * 64 : SEAM + SE_QA + (((size_t)b * 4 + wc) * S + t) * 64;
                    else if (pn == 1) base = SEAM + SE_KA + (((size_t)b * 4 + wc) * KV + key) * 64;
                    else if (pn == 2) base = SEAM + SE_VA + (((size_t)b * 4 + wc) * KV + key) * 64;
                    else if (pn == 9) base = SEAM + SE_VD + (((size_t)b * 4 + wc) * KV + key) * 64;
                    else base = SEAM + SE_VG + (((size_t)b * 2 + (wc - 2)) * KV + key) * 64;
                    const float sc = (pn == 0) ? 0.125f * LOG2E : 1.f;
#pragma unroll
                    for (int bj = 0; bj < 2; ++bj) *(u32x4*)(base + 32 * bj + e0) = pack8(acc[ai][bj][m][0] * sc, acc[ai][bj][m][1] * sc);
                } else if (pn == 3 || pn == 4) {
                    f32x4 z0, z1;
#pragma unroll
                    for (int j = 0; j < 4; ++j) { z0[j] = acc[ai][0][m][0][j] * fast_sigmoid(acc[ai][1][m][0][j]); z1[j] = acc[ai][0][m][1][j] * fast_sigmoid(acc[ai][1][m][1][j]); }
                    *(u32x4*)(SEAM + SE_Z + (size_t)r * 256 + 128 * (pn - 3) + 32 * wc + e0) = pack8(z0, z1);
                } else if (pn == 5 || pn == 6) {
                    float ss = 0.f;
#pragma unroll
                    for (int bj = 0; bj < 2; ++bj)
#pragma unroll
                        for (int n = 0; n < 2; ++n) { const f32x4 x = acc[ai][bj][m][n]; ss += (x[0] * x[0] + x[1] * x[1]) + (x[2] * x[2] + x[3] * x[3]); }
                    ss += __shfl_xor(ss, 16); ss += __shfl_xor(ss, 32);
                    const float rs = 1.f / sqrtf(ss * (1.f / 64.f) + EPS);
                    f32x4 x1[2], x2[2];
#pragma unroll
                    for (int n = 0; n < 2; ++n) { x1[n] = acc[ai][0][m][n] * rs * gn[0][n]; x2[n] = acc[ai][1][m][n] * rs * gn[1][n]; }
                    if (!isc) { const int pos = (fq < 2) ? (t >> 6) : (t & 63);
#pragma unroll
                        for (int n = 0; n < 2; ++n) { const f32x4 c = *(const f32x4*)(tab + TB_C64 + pos * 16 + 8 * (fq & 1) + 4 * n), sn = *(const f32x4*)(tab + TB_S64 + pos * 16 + 8 * (fq & 1) + 4 * n);
                            const f32x4 a = x1[n] * c - x2[n] * sn, bb = x2[n] * c + x1[n] * sn; x1[n] = a; x2[n] = bb; } }
                    bf16_t* base;
                    if (pn == 5) { base = isc ? SEAM + SE_QGC + (((size_t)b * 4 + wc) * LC + t) * 64 : SEAM + SE_QG + (((size_t)b * 4 + wc) * S + t) * 64;
                        const float sc = 0.125f * LOG2E;
#pragma unroll
                        for (int n = 0; n < 2; ++n) { x1[n] = x1[n] * sc; x2[n] = x2[n] * sc; } }
                    else base = SEAM + SE_KG + (((size_t)b * 2 + wc) * KV + key) * 64;
                    *(u32x4*)(base + e0) = pack8(x1[0], x1[1]); *(u32x4*)(base + 32 + e0) = pack8(x2[0], x2[1]);
                } else {
                    bf16_t* base;
                    if (pn == 7) base = isc ? SEAM + SE_QDC + (((size_t)b * 4 + wc) * LC + t) * 64 : SEAM + SE_QD + (((size_t)b * 4 + wc) * S + t) * 64;
                    else base = SEAM + SE_KD + (((size_t)b * 4 + wc) * KV + key) * 64;
                    const float sc = (pn == 7) ? 0.17677669529663687f * LOG2E : 1.f;
                    f32x4 c = (f32x4){1.f, 1.f, 1.f, 1.f}, sn = (f32x4){0.f, 0.f, 0.f, 0.f};
                    if (!isc) { const int pos = (fq < 2) ? (t >> 6) : (t & 63); c = *(const f32x4*)(tab + TB_C32 + pos * 8 + 4 * (fq & 1)); sn = *(const f32x4*)(tab + TB_S32 + pos * 8 + 4 * (fq & 1)); }
#pragma unroll
                    for (int bj = 0; bj < 2; ++bj) { const f32x4 x1 = acc[ai][bj][m][0], x2 = acc[ai][bj][m][1];
                        const f32x4 a = (x1 * c - x2 * sn) * sc, bb = (x2 * c + x1 * sn) * sc;
                        uint2 w1, w2; w1.x = cvt_pk_bf16(a[0], a[1]); w1.y = cvt_pk_bf16(a[2], a[3]); w2.x = cvt_pk_bf16(bb[0], bb[1]); w2.y = cvt_pk_bf16(bb[2], bb[3]);
                        *(uint2*)(base + 32 * bj + 4 * fq) = w1; *(uint2*)(base + 32 * bj + 16 + 4 * fq) = w2; }
                }
            }
    }
};
__device__ __forceinline__ int inproj_srccol(int nrow) {
    const int pn = nrow >> 8, p = nrow & 255, bj = p >> 7, wc = (p >> 5) & 3, j32 = p & 31;
    if (pn == 3 || pn == 4) return (bj ? 1024 : 768) + 128 * (pn - 3) + (p & 127);
    if (pn == 7 || pn == 8) { const int fq = j32 >> 3, n = (j32 >> 2) & 1, j = j32 & 3; return 256 * pn + 64 * wc + 32 * bj + 16 * n + 4 * fq + j; }
    return 256 * pn + 64 * wc + 32 * bj + j32;
}
struct EpiOut {
    const float* xl; const float* xc; const float* hin; float* hout; const float* modl;
    __device__ __forceinline__ void operator()(const f32x4 (&acc)[2][2][4][2], const pg8::Unit& u, int wr, int wc, int fr, int fq) const {
        const bool isc = u.pm >= 64; const int b = isc ? u.pm - 64 : u.pm >> 5; const float* g1 = modl + (isc ? 2 : b) * 6144 + 2 * D;
        const int col0 = u.pn * 256 + 32 * wc + 8 * fq;
        f32x4 g[2][2];
#pragma unroll
        for (int bj = 0; bj < 2; ++bj)
#pragma unroll
            for (int n = 0; n < 2; ++n) g[bj][n] = *(const f32x4*)(g1 + col0 + 128 * bj + 4 * n);
#pragma unroll
        for (int ai = 0; ai < 2; ++ai)
#pragma unroll
            for (int m = 0; m < 4; ++m) { const int r = u.pm * 256 + 128 * ai + 64 * wr + 16 * m + fr;
                const float* src = hin ? hin + (size_t)r * D : (isc ? xc + (size_t)(r - ROWS_L) * D : xl + (size_t)r * D);
#pragma unroll
                for (int bj = 0; bj < 2; ++bj)
#pragma unroll
                    for (int n = 0; n < 2; ++n) { const int c = col0 + 128 * bj + 4 * n; const f32x4 h = *(const f32x4*)(src + c); *(f32x4*)(hout + (size_t)r * D + c) = h + g[bj][n] * acc[ai][bj][m][n]; }
            }
    }
};
struct EpiMoe1 {
    bf16_t* HE;
    __device__ __forceinline__ void operator()(const f32x4 (&acc)[2][2][4][2], const pg8::Unit& u, int wr, int wc, int fr, int fq) const {
        const int f0 = (u.pn & 7) * 128 + 32 * wc + 8 * fq;
#pragma unroll
        for (int ai = 0; ai < 2; ++ai)
#pragma unroll
            for (int m = 0; m < 4; ++m) { const size_t r = (size_t)u.pm * 256 + 128 * ai + 64 * wr + 16 * m + fr;
                f32x4 h0, h1;
#pragma unroll
                for (int j = 0; j < 4; ++j) { const float a0 = acc[ai][0][m][0][j], a1 = acc[ai][0][m][1][j]; h0[j] = a0 * fast_sigmoid(a0) * acc[ai][1][m][0][j]; h1[j] = a1 * fast_sigmoid(a1) * acc[ai][1][m][1][j]; }
                *(u32x4*)(HE + r * D + f0) = pack8(h0, h1); }
    }
};
struct EpiMoe2 {
    bf16_t* YE; const float* gate;
    __device__ __forceinline__ void operator()(const f32x4 (&acc)[2][2][4][2], const pg8::Unit& u, int wr, int wc, int fr, int fq) const {
        const int c0 = (u.pn & 3) * 256 + 32 * wc + 8 * fq;
#pragma unroll
        for (int ai = 0; ai < 2; ++ai)
#pragma unroll
            for (int m = 0; m < 4; ++m) { const size_t r = (size_t)u.pm * 256 + 128 * ai + 64 * wr + 16 * m + fr; const float gt = gate[r];
#pragma unroll
                for (int bj = 0; bj < 2; ++bj) *(u32x4*)(YE + r * D + c0 + 128 * bj) = pack8(acc[ai][bj][m][0] * gt, acc[ai][bj][m][1] * gt); }
    }
};

__device__ __forceinline__ int vcu_of(const Frame& F) { return (F.G % 8 == 0) ? (F.bid % 8) * (F.G / 8) + F.bid / 8 : F.bid; }

__device__ __forceinline__ void phase_inproj_fast(Frame& F, int l) {
    pg8::Gemm g{F.U, (const bf16_t*)(F.ws + WS_WBF + WB_IN + (size_t)l * 5 * MiB), D};
    pg8::OrderDense S{ROWS / 256, DIN / 256, F.G, vcu_of(F)};
    EpiIn E{F.SEAM, F.tab, F.in[I_QNG] + l * 64, F.in[I_KNG] + l * 64};
    pg8::gemm_phase<EpiIn, pg8::OrderDense, false>(F.lds, g, S, E, nullptr);
}
__device__ __forceinline__ void phase_outproj_fast(Frame& F, int l, bool with_ctx) {
    pg8::Gemm g{F.Y, (const bf16_t*)(F.ws + WS_WBF + WB_OUT + (size_t)l * 2 * MiB), D};
    pg8::OrderDense S{(with_ctx ? ROWS : ROWS_L) / 256, D / 256, F.G, vcu_of(F)};
    EpiOut E{F.in[I_X], F.in[I_CTX], (l == 0) ? nullptr : F.H, F.H, F.tab + TB_MOD + l * 3 * 6144};
    pg8::gemm_phase<EpiOut, pg8::OrderDense, false>(F.lds, g, S, E, nullptr);
}
__device__ __forceinline__ void phase_moe1_fast(Frame& F, int l, bool with_ctx) {
    pg8::Gemm g{F.U, (const bf16_t*)(F.ws + WS_WBF + WB_GU + (size_t)l * 64 * MiB), D};
    pg8::OrderMoe S{with_ctx ? 9 : 8, 8, F.G, vcu_of(F)};
    LAS unsigned* gofs = (LAS unsigned*)(F.lds + GOFS_OFF);
    { pg8::Unit u;
      for (int i = 0; i < 8 && S.next(i, u); ++i)
          for (int j = F.tid; j < 256; j += NTHR) { const int ri = F.RIDX[u.pm * 256 + j]; gofs[i * 256 + j] = (unsigned)(ri < 0 ? 0 : ri) * (unsigned)(D * 2); }
      __syncthreads(); }
    EpiMoe1 E{F.HE};
    pg8::gemm_phase<EpiMoe1, pg8::OrderMoe, true>(F.lds, g, S, E, gofs);
}
__device__ __forceinline__ void phase_moe2_fast(Frame& F, int l, bool with_ctx) {
    pg8::Gemm g{F.HE, (const bf16_t*)(F.ws + WS_WBF + WB_DN + (size_t)l * 32 * MiB), D};
    pg8::OrderMoe S{with_ctx ? 9 : 8, 4, F.G, vcu_of(F)};
    EpiMoe2 E{F.YE, F.GATE};
    pg8::gemm_phase<EpiMoe2, pg8::OrderMoe, false>(F.lds, g, S, E, nullptr);
}

__device__ __forceinline__ void transpose_item(const float* W, int ldw, int srccol, int k0, bf16_t* WTrow0, int K, LAS float* scr, int lane) {
#pragma unroll 8
    for (int i = 0; i < 32; ++i) { const int kk = 2 * i + (lane >> 5); scr[kk * 33 + (lane & 31)] = W[(size_t)(k0 + kk) * ldw + srccol]; }
    asm volatile("s_waitcnt lgkmcnt(0)" ::: "memory");
    const int c = lane & 7;
#pragma unroll
    for (int j = 0; j < 4; ++j) { const int n = (lane >> 3) + 8 * j; const LAS float* s_ = scr + (8 * c) * 33 + n;
        u32x4 o; o.x = pk2(s_[0 * 33], s_[1 * 33]); o.y = pk2(s_[2 * 33], s_[3 * 33]); o.z = pk2(s_[4 * 33], s_[5 * 33]); o.w = pk2(s_[6 * 33], s_[7 * 33]);
        *(u32x4*)(WTrow0 + (size_t)n * K + k0 + 8 * c) = o; }
    asm volatile("s_waitcnt lgkmcnt(0)" ::: "memory");
}
__device__ __forceinline__ void phase_convert(Frame& F) {
    LAS float* scr = (LAS float*)(F.lds + F.wave * 16384);
    const int gw = F.bid * NWAVES + F.wave, NGW = F.G * NWAVES;
    constexpr int IT_IN = 16 * 80, IT_OUT = 16 * 32, IT_E = 16 * 32;
    constexpr int PER_L = IT_IN + IT_OUT + NE * 3 * IT_E;
    const int nn = F.lane & 31;
    for (int it = gw; it < DEPTH * PER_L; it += NGW) {
        const int l = it / PER_L; int r = it % PER_L;
        if (r < IT_IN) { if (!FAST_INPROJ) continue; const int kb = r / 80, nb = r % 80;
            transpose_item(F.in[I_WIN] + (size_t)l * D * DIN, DIN, inproj_srccol(nb * 32 + nn), kb * 64, (bf16_t*)(F.ws + WS_WBF + WB_IN + (size_t)l * 5 * MiB) + (size_t)(nb * 32) * D, D, scr, F.lane); continue; }
        r -= IT_IN;
        if (r < IT_OUT) { if (!FAST_OUTPROJ) continue; const int kb = r / 32, nb = r % 32;
            transpose_item(F.in[I_WOUT] + (size_t)l * D * D, D, nb * 32 + nn, kb * 64, (bf16_t*)(F.ws + WS_WBF + WB_OUT + (size_t)l * 2 * MiB) + (size_t)(nb * 32) * D, D, scr, F.lane); continue; }
        r -= IT_OUT;
        if (!FAST_MOE) continue;
        const int e = r / (3 * IT_E), q = (r % (3 * IT_E)) / IT_E, r2 = r % IT_E, kb = r2 / 32, nb = r2 % 32;
        const size_t wo = ((size_t)l * NE + e) * D * D;
        if (q < 2) {
            const int f0 = nb * 32; const int row0 = (f0 >> 7) * 256 + q * 128 + (f0 & 127);
            transpose_item(F.in[q == 0 ? I_WG : I_WU] + wo, D, f0 + nn, kb * 64, (bf16_t*)(F.ws + WS_WBF + WB_GU + (size_t)l * 64 * MiB) + ((size_t)e * 2048 + row0) * D, D, scr, F.lane);
        } else transpose_item(F.in[I_WD] + wo, D, nb * 32 + nn, kb * 64, (bf16_t*)(F.ws + WS_WBF + WB_DN + (size_t)l * 32 * MiB) + ((size_t)e * 1024 + nb * 32) * D, D, scr, F.lane);
    }
}


#ifndef FAST_ATTN
#define FAST_ATTN 1
#endif
namespace att {
typedef short bf16x8 __attribute__((ext_vector_type(8)));
typedef short s16x4 __attribute__((ext_vector_type(4)));
typedef float f32x16 __attribute__((ext_vector_type(16)));
constexpr int SLOTB = 8192, NSLOT = 3;
constexpr int L_K = 0, L_V = NSLOT * SLOTB, L_WS = 2 * NSLOT * SLOTB, L_OST = L_WS + NWAVES * 256, L_END = L_OST + NWAVES * 32 * 68 * 4;
static_assert(L_END <= 131072, "attention LDS");
__device__ __forceinline__ int crow(int r, int hi) { return (r & 3) + 8 * (r >> 2) + 4 * hi; }
__device__ __forceinline__ s16x4 vtr(const LAS char* p) { return __builtin_bit_cast(s16x4, __builtin_amdgcn_ds_read_tr16_b64_v4i16((LAS s16x4*)p)); }
#define ATT_WAIT_BAR(N) asm volatile("s_waitcnt vmcnt(" #N ") lgkmcnt(0)\n\ts_barrier" ::: "memory")

template <int KIND> __device__ __forceinline__ void attn_unit(LAS char* lds, const bf16_t* Qw, const bf16_t* Kh, const bf16_t* Vh, int nt, bf16_t* Yw, float lam, float oml, const float* dng) {
    int tid = threadIdx.x; asm volatile("" : "+v"(tid));
    const int lane = tid & 63, r32 = lane & 31, hi = lane >> 5; const int wid = __builtin_amdgcn_readfirstlane(tid >> 6);
    LAS float* wsf = (LAS float*)(lds + L_WS) + wid * 64;
    const bf16_t* ksrc = Kh + (size_t)lane * 64 + wid * 8;
    const bf16_t* vsrc = Vh + (size_t)(16 * (wid & 3) + (lane >> 2)) * 64 + (wid >> 2) * 32 + (lane & 3) * 8;
    LAS char* kdst = lds + L_K + wid * 1024; LAS char* vdst = lds + L_V + wid * 1024;
#define ATT_DMA(t, slotb) do { __builtin_amdgcn_global_load_lds((const unsigned*)(ksrc + (size_t)(t) * 64 * 64), (LAS unsigned*)(kdst + (slotb)), 16, 0, 0); \
                               __builtin_amdgcn_global_load_lds((const unsigned*)(vsrc + (size_t)(t) * 64 * 64), (LAS unsigned*)(vdst + (slotb)), 16, 0, 0); } while (0)
    ATT_DMA(0, 0); ATT_DMA(nt > 1 ? 1 : 0, SLOTB);
    bf16x8 qr[4];
#pragma unroll
    for (int d0 = 0; d0 < 4; ++d0) qr[d0] = *(const bf16x8*)(Qw + (size_t)r32 * 64 + d0 * 16 + hi * 8);
    f32x16 o1[2], o2[2]; float l1 = 0.f, l2 = 0.f;
    o1[0] = f32x16{}; o1[1] = f32x16{}; o2[0] = f32x16{}; o2[1] = f32x16{};
    const LAS char* kp0 = lds + L_K + hi * 1024 + r32 * 16;
    const LAS char* vp0 = lds + L_V + ((lane >> 4) & 1) * 32 + (lane & 3) * 8 + (4 * hi + ((lane & 15) >> 2)) * 64;
    int sl_cur = 0, sl_nn = 2 * SLOTB;
#pragma unroll 1
    for (int t = 0; t < nt; ++t) {
        ATT_WAIT_BAR(2);
        { const int tn = (t + 2 < nt) ? t + 2 : nt - 1; ATT_DMA(tn, sl_nn); }
        const LAS char* kp = kp0 + sl_cur; const LAS char* vp = vp0 + sl_cur;
        u32x4 pw[4], qw[4];
        {
            f32x16 pa0, pa1; const f32x16 z = f32x16{};
            if (KIND == 0) {
                bf16x8 kf[8];
#pragma unroll
                for (int d0 = 0; d0 < 4; ++d0) { kf[2 * d0] = *(const LAS bf16x8*)(kp + d0 * 2048); kf[2 * d0 + 1] = *(const LAS bf16x8*)(kp + d0 * 2048 + 512); }
                pa0 = __builtin_amdgcn_mfma_f32_32x32x16_bf16(kf[0], qr[0], z, 0, 0, 0); pa1 = __builtin_amdgcn_mfma_f32_32x32x16_bf16(kf[1], qr[0], z, 0, 0, 0);
#pragma unroll
                for (int d0 = 1; d0 < 4; ++d0) { pa0 = __builtin_amdgcn_mfma_f32_32x32x16_bf16(kf[2 * d0], qr[d0], pa0, 0, 0, 0); pa1 = __builtin_amdgcn_mfma_f32_32x32x16_bf16(kf[2 * d0 + 1], qr[d0], pa1, 0, 0, 0); }
            } else {
                bf16x8 kf[4];
#pragma unroll
                for (int d0 = 0; d0 < 2; ++d0) { kf[2 * d0] = *(const LAS bf16x8*)(kp + d0 * 2048); kf[2 * d0 + 1] = *(const LAS bf16x8*)(kp + d0 * 2048 + 512); }
                pa0 = __builtin_amdgcn_mfma_f32_32x32x16_bf16(kf[0], qr[0], z, 0, 0, 0); pa1 = __builtin_amdgcn_mfma_f32_32x32x16_bf16(kf[1], qr[0], z, 0, 0, 0);
                pa0 = __builtin_amdgcn_mfma_f32_32x32x16_bf16(kf[2], qr[1], pa0, 0, 0, 0); pa1 = __builtin_amdgcn_mfma_f32_32x32x16_bf16(kf[3], qr[1], pa1, 0, 0, 0);
            }
            float sa = 0.f, sb = 0.f;
#pragma unroll
            for (int r = 0; r < 16; ++r) { pa0[r] = __builtin_amdgcn_exp2f(pa0[r]); pa1[r] = __builtin_amdgcn_exp2f(pa1[r]); sa += pa0[r]; sb += pa1[r]; }
            l1 += sa + sb;
#pragma unroll
            for (int i = 0; i < 4; ++i) { pw[0][i] = cvt_pk_bf16(pa0[2 * i], pa0[2 * i + 1]); pw[1][i] = cvt_pk_bf16(pa0[8 + 2 * i], pa0[9 + 2 * i]); pw[2][i] = cvt_pk_bf16(pa1[2 * i], pa1[2 * i + 1]); pw[3][i] = cvt_pk_bf16(pa1[8 + 2 * i], pa1[9 + 2 * i]); }
        }
        if (KIND == 1) {
            __builtin_amdgcn_sched_barrier(0);
            f32x16 pb0, pb1; const f32x16 z = f32x16{};
            bf16x8 kf[4];
#pragma unroll
            for (int d0 = 0; d0 < 2; ++d0) { kf[2 * d0] = *(const LAS bf16x8*)(kp + (d0 + 2) * 2048); kf[2 * d0 + 1] = *(const LAS bf16x8*)(kp + (d0 + 2) * 2048 + 512); }
            pb0 = __builtin_amdgcn_mfma_f32_32x32x16_bf16(kf[0], qr[2], z, 0, 0, 0); pb1 = __builtin_amdgcn_mfma_f32_32x32x16_bf16(kf[1], qr[2], z, 0, 0, 0);
            pb0 = __builtin_amdgcn_mfma_f32_32x32x16_bf16(kf[2], qr[3], pb0, 0, 0, 0); pb1 = __builtin_amdgcn_mfma_f32_32x32x16_bf16(kf[3], qr[3], pb1, 0, 0, 0);
            float sc_ = 0.f, sd = 0.f;
#pragma unroll
            for (int r = 0; r < 16; ++r) { pb0[r] = __builtin_amdgcn_exp2f(pb0[r]); pb1[r] = __builtin_amdgcn_exp2f(pb1[r]); sc_ += pb0[r]; sd += pb1[r]; }
            l2 += sc_ + sd;
#pragma unroll
            for (int i = 0; i < 4; ++i) { qw[0][i] = cvt_pk_bf16(pb0[2 * i], pb0[2 * i + 1]); qw[1][i] = cvt_pk_bf16(pb0[8 + 2 * i], pb0[9 + 2 * i]); qw[2][i] = cvt_pk_bf16(pb1[2 * i], pb1[2 * i + 1]); qw[3][i] = cvt_pk_bf16(pb1[8 + 2 * i], pb1[9 + 2 * i]); }
            __builtin_amdgcn_sched_barrier(0);
        }
#pragma unroll
        for (int d0 = 0; d0 < 2; ++d0) {
#pragma unroll
            for (int ks = 0; ks < 4; ++ks) {
                const s16x4 lo = vtr(vp + d0 * 4096 + ks * 1024), hh = vtr(vp + d0 * 4096 + ks * 1024 + 512);
                const bf16x8 vf = (bf16x8){lo[0], lo[1], lo[2], lo[3], hh[0], hh[1], hh[2], hh[3]};
                o1[d0] = __builtin_amdgcn_mfma_f32_32x32x16_bf16(__builtin_bit_cast(bf16x8, pw[ks]), vf, o1[d0], 0, 0, 0);
                if (KIND == 1) o2[d0] = __builtin_amdgcn_mfma_f32_32x32x16_bf16(__builtin_bit_cast(bf16x8, qw[ks]), vf, o2[d0], 0, 0, 0);
            }
        }
        sl_nn = sl_cur; sl_cur = (sl_cur == (NSLOT - 1) * SLOTB) ? 0 : sl_cur + SLOTB;
    }
    ATT_WAIT_BAR(0);
    { auto rr = __builtin_amdgcn_permlane32_swap(__float_as_uint(l1), __float_as_uint(l1), false, false); l1 = __uint_as_float(rr[0]) + __uint_as_float(rr[1]); }
    if (KIND == 1) { auto rr = __builtin_amdgcn_permlane32_swap(__float_as_uint(l2), __float_as_uint(l2), false, false); l2 = __uint_as_float(rr[0]) + __uint_as_float(rr[1]); }
    if (hi == 0) { wsf[r32] = 1.f / l1; if (KIND == 1) wsf[32 + r32] = lam / l2; }
    asm volatile("s_waitcnt lgkmcnt(0)" ::: "memory");
    LAS float* stg = (LAS float*)(lds + L_OST) + wid * (32 * 68);
#pragma unroll
    for (int r = 0; r < 16; ++r) { const int q = crow(r, hi); const float a = wsf[q], b = (KIND == 1) ? wsf[32 + q] : 0.f;
#pragma unroll
        for (int d0 = 0; d0 < 2; ++d0) stg[q * 68 + d0 * 32 + r32] = (KIND == 1) ? (o1[d0][r] * a - o2[d0][r] * b) : o1[d0][r] * a; }
    asm volatile("s_waitcnt lgkmcnt(0)" ::: "memory");
    {
        const int row = lane >> 1, hf = lane & 1; float v[32];
#pragma unroll
        for (int i = 0; i < 8; ++i) { const f32x4 x = *(const LAS f32x4*)(stg + row * 68 + hf * 32 + 4 * i); v[4 * i] = x[0]; v[4 * i + 1] = x[1]; v[4 * i + 2] = x[2]; v[4 * i + 3] = x[3]; }
        if (KIND == 1) {
            float ss = 0.f;
#pragma unroll
            for (int i = 0; i < 32; ++i) ss += v[i] * v[i];
            ss += __shfl_xor(ss, 1);
            const float rs = oml / sqrtf(ss * (1.f / 64.f) + EPS);
#pragma unroll
            for (int i = 0; i < 32; ++i) v[i] = v[i] * rs * dng[hf * 32 + i];
        }
        bf16_t* dst = Yw + (size_t)row * D + hf * 32;
#pragma unroll
        for (int i = 0; i < 4; ++i) { u32x4 w; w.x = cvt_pk_bf16(v[8 * i], v[8 * i + 1]); w.y = cvt_pk_bf16(v[8 * i + 2], v[8 * i + 3]); w.z = cvt_pk_bf16(v[8 * i + 4], v[8 * i + 5]); w.w = cvt_pk_bf16(v[8 * i + 6], v[8 * i + 7]); *(u32x4*)(dst + 8 * i) = w; }
    }
    asm volatile("s_waitcnt lgkmcnt(0)\n\ts_barrier" ::: "memory");
#undef ATT_DMA
}
}

__device__ __forceinline__ void gqa_unit_fast(Frame& F, int v, bool cu) {
    const int nblk = cu ? 2 : 64, bh = v / nblk, blk = v % nblk, b = bh >> 1, hk = bh & 1, hq = 2 * hk + (F.wave >> 2), t0 = blk * 128 + (F.wave & 3) * 32;
    const int nq = cu ? LC : S;
    const bf16_t* Qw = F.SEAM + (cu ? SE_QGC : SE_QG) + (((size_t)b * 4 + hq) * nq + t0) * 64;
    const size_t kvo = ((size_t)b * 2 + hk) * KV * 64;
    bf16_t* Yw = F.Y + (size_t)(cu ? ROWS_L + b * LC + t0 : b * S + t0) * D + 512 + hq * 64;
    att::attn_unit<0>((LAS char*)F.lds, Qw, F.SEAM + SE_KG + kvo, F.SEAM + SE_VG + kvo, cu ? LC / 64 : KV / 64, Yw, 0.f, 0.f, nullptr);
}
__device__ __forceinline__ void diff_unit_fast(Frame& F, int l, int v, bool cu) {
    const int nblk = cu ? 1 : 32, bh = v / nblk, blk = v % nblk, b = bh >> 2, h = bh & 3, t0 = blk * 256 + F.wave * 32;
    const int nq = cu ? LC : S;
    const bf16_t* Qw = F.SEAM + (cu ? SE_QDC : SE_QD) + (((size_t)b * 4 + h) * nq + t0) * 64;
    const size_t kvo = ((size_t)b * 4 + h) * KV * 64;
    bf16_t* Yw = F.Y + (size_t)(cu ? ROWS_L + b * LC + t0 : b * S + t0) * D + 768 + h * 64;
    att::attn_unit<1>((LAS char*)F.lds, Qw, F.SEAM + SE_KD + kvo, F.SEAM + SE_VD + kvo, cu ? LC / 64 : KV / 64, Yw, F.tab[TB_LAM + 2 * l], F.tab[TB_LAM + 2 * l + 1], F.in[I_DNG] + l * 64);
}
__device__ __forceinline__ void phase_attn_fast(Frame& F, int l, bool with_ctx) {
    const int v = vcu_of(F);
#pragma unroll 1
    for (int u = v; u < 256; u += F.G) gqa_unit_fast(F, u, false);
#pragma unroll 1
    for (int u = v; u < 256; u += F.G) diff_unit_fast(F, l, u, false);
    if (with_ctx) {
#pragma unroll 1
        for (int u = v; u < 8; u += F.G) gqa_unit_fast(F, u, true);
#pragma unroll 1
        for (int u = F.G - 1 - v; u < 8; u += F.G) diff_unit_fast(F, l, u, true);
    }
}

#ifndef PHMASK
#define PHMASK 0xffffffffu
#endif
#define REFRESH() do { asm volatile("" : "+v"(F.tid)); F.lane = F.tid & 63; F.wave = __builtin_amdgcn_readfirstlane(F.tid >> 6); } while (0)
#define PHX(i, call) do { if ((PHMASK >> (i)) & 1u) { REFRESH(); call; } } while (0)
constexpr int PH_PER_LAYER = 9;
constexpr int NPH = 1 + DEPTH * PH_PER_LAYER + 1;

__global__ void __launch_bounds__(NTHR, 2) mk_fwd(Args args) {
    extern __shared__ __attribute__((aligned(16))) unsigned char lds[];
    Frame F;
    F.lds = (LAS unsigned char*)lds;
    F.tid = threadIdx.x; F.lane = F.tid & 63; F.wave = __builtin_amdgcn_readfirstlane(F.tid >> 6);
    F.G = gridDim.x; F.bid = blockIdx.x;
    F.in = args.in; F.out = args.out; F.ws = args.ws;
    unsigned char* ws = args.ws;
    F.tab = (float*)(ws + WS_TAB); F.H = (float*)(ws + WS_H); F.U = (bf16_t*)(ws + WS_U); F.AFF = (float*)(ws + WS_AFF); F.SLOT = (int*)(ws + WS_SLOT);
    F.RIDX = (int*)(ws + WS_RIDX); F.GATE = (float*)(ws + WS_RIDX + 256 * 1024);
    F.SEAM = (bf16_t*)(ws + WS_SEAM); F.Y = (bf16_t*)(ws + WS_Y); F.HE = (bf16_t*)(ws + WS_HE); F.YE = (bf16_t*)(ws + WS_YE); F.P = (float*)(ws + WS_P);
    for (int u = F.tid; u < (LDS_BYTES - LDSCTL_OFF) / 4; u += NTHR) ((LAS unsigned*)(F.lds + LDSCTL_OFF))[u] = 0u;
    __syncthreads();
    XcdBarrier bar; bar.bar = (unsigned*)(ws + WS_CTL) + CW_BAR; bar.x = 0; bar.st = nullptr;
    const bool one = (MK_N_LAUNCHES == 1);
    if (one) bar = xcd_barrier_post((unsigned*)(ws + WS_CTL) + CW_BAR, (volatile LAS unsigned*)(F.lds + MISC_OFF) + 8);
    const int lo = args.ph_lo, hi = args.ph_hi;
#define IN(k) (lo <= (k) && (k) < hi)
#define SEAM_BAR(k) do { if (one && (k) + 1 < hi) xcd_barrier(bar); } while (0)
    if (IN(0)) { PHX(0, phase_prologue(F)); REFRESH(); phase_convert(F); SEAM_BAR(0); }
#pragma unroll 1
    for (int l = 0; l < DEPTH; ++l) {
        const int pb = 1 + l * PH_PER_LAYER; const bool wc = (l < DEPTH - 1);
        if (IN(pb + 0)) { REFRESH(); if (l == 0) phase_norm<0>(F, 0, true, -1, true); else phase_norm<0>(F, l, false, l - 1, true); SEAM_BAR(pb + 0); }
        if (IN(pb + 1)) { if (FAST_INPROJ) { REFRESH(); phase_inproj_fast(F, l); } else { PHX(1, phase_inproj_naive(F, l)); } SEAM_BAR(pb + 1); }
        if (IN(pb + 2)) { if (!FAST_INPROJ) { PHX(2, phase_post_naive(F, l)); SEAM_BAR(pb + 2); } }
        if (IN(pb + 3)) { if (FAST_ATTN) { REFRESH(); phase_attn_fast(F, l, wc); } PHX(3, phase_mixers_naive(F, l, wc)); SEAM_BAR(pb + 3); }
        if (IN(pb + 4)) { if (FAST_OUTPROJ) { REFRESH(); phase_outproj_fast(F, l, wc); } else { PHX(4, phase_outproj_naive(F, l, wc)); } SEAM_BAR(pb + 4); }
        if (IN(pb + 5)) { PHX(5, phase_norm2_router(F, l, wc)); SEAM_BAR(pb + 5); }
        if (IN(pb + 6)) { PHX(6, phase_select_naive(F, wc)); SEAM_BAR(pb + 6); }
        if (IN(pb + 7)) { if (FAST_MOE) { REFRESH(); phase_moe1_fast(F, l, wc); } else { PHX(7, phase_moe1_naive(F, l, wc)); } SEAM_BAR(pb + 7); }
        if (IN(pb + 8)) { if (FAST_MOE) { REFRESH(); phase_moe2_fast(F, l, wc); } else { PHX(8, phase_moe2_naive(F, l, wc)); } SEAM_BAR(pb + 8); }
    }
    if (IN(NPH - 1)) { REFRESH(); phase_norm<2>(F, 0, false, DEPTH - 1, false); }
#undef IN
#undef SEAM_BAR
}

extern "C" void kernel_launch(void* const* d_in, const int* in_sizes, int n_in, void* d_out, int out_size, void* d_ws, size_t ws_size, hipStream_t stream) {
    static int grid = 0;
    if (grid == 0) {
        if (n_in != N_IN || out_size != ROWS_L * D || ws_size < WS_END) { fprintf(stderr, "kernel_launch: unexpected shapes (n_in %d out %d ws %zu)\n", n_in, out_size, ws_size); grid = -1; return; }
        int dev = 0, cus = 0, per_cu = 0;
        if (hipGetDevice(&dev) != hipSuccess || hipDeviceGetAttribute(&cus, hipDeviceAttributeMultiprocessorCount, dev) != hipSuccess) { grid = -1; return; }
        if (hipFuncSetAttribute((const void*)mk_fwd, hipFuncAttributeMaxDynamicSharedMemorySize, LDS_BYTES) != hipSuccess) { fprintf(stderr, "kernel_launch: hipFuncSetAttribute failed\n"); grid = -1; return; }
        if (hipOccupancyMaxActiveBlocksPerMultiprocessor(&per_cu, (const void*)mk_fwd, NTHR, LDS_BYTES) != hipSuccess || per_cu < 1) { fprintf(stderr, "kernel_launch: occupancy query says %d\n", per_cu); per_cu = 1; }
        (void)hipGetLastError();
        grid = cus;
    }
    if (grid < 0) return;
    (void)hipMemsetAsync((char*)d_ws + WS_CTL, 0, CTL_ZERO_BYTES, stream);
    Args a{};
    for (int i = 0; i < N_IN; ++i) a.in[i] = (const float*)d_in[i];
    a.out = (float*)d_out; a.ws = (unsigned char*)d_ws;
    if (MK_N_LAUNCHES == 1) { a.ph_lo = 0; a.ph_hi = NPH; hipLaunchKernelGGL(mk_fwd, dim3(grid), dim3(NTHR), LDS_BYTES, stream, a); }
    else for (int p = 0; p < NPH; ++p) { a.ph_lo = p; a.ph_hi = p + 1; hipLaunchKernelGGL(mk_fwd, dim3(grid), dim3(NTHR), LDS_BYTES, stream, a); }
}
```

```cpp
#include <hip/hip_runtime.h>
#include <cstdio>
#include <cstdint>

#ifndef MK_N_LAUNCHES
#define MK_N_LAUNCHES 1
#endif

constexpr int D = 1024, NB = 2, S = 8192, LC = 256, DEPTH = 2;
constexpr int ROWS_L = NB * S;
constexpr int ROWS_C = NB * LC;
constexpr int ROWS = ROWS_L + ROWS_C;
constexpr int KV = LC + S;
constexpr int DIN = 2560;
constexpr int NE = 16, CAP_L = 1024, CAP_C = 32;
constexpr int ESLOTS = 2 * CAP_L + 2 * CAP_C;
constexpr int EPAD = 2304;
constexpr float EPS = 1e-6f;
constexpr float LOG2E = 1.4426950408889634f;
constexpr int NWAVES = 8, NTHR = 512;

typedef unsigned short bf16_t;
typedef unsigned u32x4 __attribute__((ext_vector_type(4)));
typedef float f32x4 __attribute__((ext_vector_type(4)));

constexpr size_t MiB = 1u << 20;
constexpr size_t WS_CTL = 0;
constexpr size_t CTL_ZERO_BYTES = 64 * 1024;
constexpr size_t WS_TAB = 1 * MiB;
constexpr size_t WS_H = 2 * MiB;
constexpr size_t WS_U = 68 * MiB;
constexpr size_t WS_AFF = 101 * MiB;
constexpr size_t WS_SLOT = 103 * MiB;
constexpr size_t WS_RIDX = 105 * MiB;
constexpr size_t WS_WBF = 106 * MiB;
constexpr size_t WS_R = 314 * MiB;
constexpr size_t WS_END = 458 * MiB;
constexpr size_t WS_P = WS_WBF;
constexpr size_t WS_SEAM = WS_R;
constexpr size_t WS_Y = WS_R + 83 * MiB;
constexpr size_t WS_HE = WS_R;
constexpr size_t WS_YE = WS_R + 72 * MiB;

constexpr size_t SE_QA = 0;
constexpr size_t SE_QAC = SE_QA + (size_t)NB * 4 * S * 64;
constexpr size_t SE_KA = SE_QAC + (size_t)NB * 4 * LC * 64;
constexpr size_t SE_VA = SE_KA + (size_t)NB * 4 * KV * 64;
constexpr size_t SE_Z = SE_VA + (size_t)NB * 4 * KV * 64;
constexpr size_t SE_QG = SE_Z + (size_t)ROWS * 256;
constexpr size_t SE_QGC = SE_QG + (size_t)NB * 4 * S * 64;
constexpr size_t SE_KG = SE_QGC + (size_t)NB * 4 * LC * 64;
constexpr size_t SE_VG = SE_KG + (size_t)NB * 2 * KV * 64;
constexpr size_t SE_QD = SE_VG + (size_t)NB * 2 * KV * 64;
constexpr size_t SE_QDC = SE_QD + (size_t)NB * 4 * S * 64;
constexpr size_t SE_KD = SE_QDC + (size_t)NB * 4 * LC * 64;
constexpr size_t SE_VD = SE_KD + (size_t)NB * 4 * KV * 64;
constexpr size_t SE_END = SE_VD + (size_t)NB * 4 * KV * 64;
static_assert(SE_END == (size_t)ROWS * (DIN - 256), "seam map");
static_assert(SE_END * 2 <= 83 * MiB, "seam fits");

constexpr int TB_C64 = 0;
constexpr int TB_S64 = 2048;
constexpr int TB_C32 = 4096;
constexpr int TB_S32 = 5120;
constexpr int TB_MOD = 8192;
constexpr int TB_LAM = TB_MOD + DEPTH * 3 * 6144;

constexpr int CW_BAR = 1024;

enum { I_X = 0, I_C, I_CTX, I_CCTX, I_N1G, I_WMOD, I_BMOD, I_WIN, I_RPB, I_DWW, I_DWB, I_LNG, I_LNB, I_PWW, I_PWB,
       I_QNG, I_KNG, I_LQ1, I_LK1, I_LQ2, I_LK2, I_DNG, I_WOUT, I_N2G, I_WR, I_WG, I_WU, I_WD, I_FG, N_IN };

constexpr int LDS_BYTES = 147456;
constexpr int MISC_OFF = 131072 + 320;
constexpr int LDSCTL_OFF = 131072;

#define GAS __attribute__((address_space(1)))
#define LAS __attribute__((address_space(3)))

__device__ __forceinline__ float bf2f(bf16_t v) { return __uint_as_float((unsigned)v << 16); }
__device__ __forceinline__ unsigned f2bf(float f) { unsigned u = __float_as_uint(f); return (u + 0x7fffu + ((u >> 16) & 1u)) >> 16; }
__device__ __forceinline__ unsigned pk2(float lo, float hi) { return f2bf(lo) | (f2bf(hi) << 16); }
__device__ __forceinline__ float bflo(unsigned w) { return __uint_as_float(w << 16); }
__device__ __forceinline__ float bfhi(unsigned w) { return __uint_as_float(w & 0xffff0000u); }
__device__ __forceinline__ float wave_sum(float v) {
#pragma unroll
    for (int o = 1; o < 64; o <<= 1) v += __shfl_xor(v, o);
    return v;
}
__device__ __forceinline__ float silu_f(float x) { return x / (1.f + __expf(-x)); }
__device__ __forceinline__ int vzero() { int z; asm volatile("v_mov_b32 %0, 0" : "=v"(z)); return z; }

#define XB_TMO      128
#define XB_XCNT(j)  (256  + 64 * (j))
#define XB_XSUB(j)  (1280 + 64 * (j))
#define XB_XGEN(j)  (2304 + 64 * (j))
#define XB_TOP      3328
#define XB_TOPGEN   3392
#define XCD_BAR_WORDS 3456
#define XB_SPIN_CAP (1u << 22)
__device__ __forceinline__ unsigned xb_ld(unsigned* p)              { return __hip_atomic_load(p, __ATOMIC_RELAXED, __HIP_MEMORY_SCOPE_AGENT); }
__device__ __forceinline__ unsigned xb_add(unsigned* p, unsigned v) { return __hip_atomic_fetch_add(p, v, __ATOMIC_RELAXED, __HIP_MEMORY_SCOPE_AGENT); }
__device__ __forceinline__ unsigned xb_xcc_id() { return (unsigned)__builtin_amdgcn_s_getreg((3 << 11) | 20) & 0xFu; }
#define XB_SPIN(cond, bar) do { unsigned _sp = 0; while (cond) { __builtin_amdgcn_s_sleep(1); \
    if ((++_sp & 255u) == 0u) { if (xb_ld(&(bar)[XB_TMO])) break; if (_sp > XB_SPIN_CAP) { atomicAdd(&(bar)[XB_TMO], 1u); break; } } } } while (0)
struct XcdBarrier { unsigned* bar; unsigned x; volatile LAS unsigned* st; };
__device__ __forceinline__ XcdBarrier xcd_barrier_post(unsigned* bar, volatile LAS unsigned* st) {
    XcdBarrier b; b.bar = bar; b.x = xb_xcc_id(); b.st = st;
    if (threadIdx.x == 0) (void)xb_add(&bar[XB_XCNT(b.x)], 1u);
    return b;
}
__device__ __forceinline__ void xcd_barrier_complete(unsigned* bar, unsigned x, unsigned& nloc, unsigned& nx) {
    const unsigned G = gridDim.x * gridDim.y * gridDim.z;
    unsigned sum, cnt, mine, sp = 0u;
    for (;;) {
        sum = 0u; cnt = 0u; mine = 0u;
#pragma unroll
        for (unsigned j = 0; j < 16; ++j) { const unsigned c = xb_ld(&bar[XB_XCNT(j)]); sum += c; cnt += (c > 0u) ? 1u : 0u; mine = (j == x) ? c : mine; }
        if (sum == G) break;
        __builtin_amdgcn_s_sleep(1);
        if ((++sp & 255u) == 0u) { if (xb_ld(&bar[XB_TMO])) break; if (sp > XB_SPIN_CAP) { atomicAdd(&bar[XB_TMO], 1u); break; } }
    }
    nloc = mine > 0u ? mine : 1u; nx = cnt > 0u ? cnt : 1u;
}
__device__ __forceinline__ void xcd_barrier(const XcdBarrier& b) {
    asm volatile("s_waitcnt vmcnt(0)" ::: "memory");
    __syncthreads();
    if (threadIdx.x == 0) {
        unsigned* bar = b.bar;
        __builtin_amdgcn_s_waitcnt(0);
        unsigned nloc = b.st[0], nx = b.st[1];
        if (nloc == 0u) { xcd_barrier_complete(bar, b.x, nloc, nx); b.st[0] = nloc; b.st[1] = nx; }
        const unsigned old = xb_add(&bar[XB_XSUB(b.x)], 1u);
        const unsigned gen = old / nloc;
        if (old + 1u == (gen + 1u) * nloc) {
            __builtin_amdgcn_fence(__ATOMIC_RELEASE, "agent");
            asm volatile("s_waitcnt vmcnt(0)" ::: "memory");
            const unsigned og = xb_add(&bar[XB_TOP], 1u);
            const unsigned tg = og / nx;
            if (og + 1u == (tg + 1u) * nx) xb_add(&bar[XB_TOPGEN], 1u);
            else XB_SPIN(xb_ld(&bar[XB_TOPGEN]) == tg, bar);
            __builtin_amdgcn_fence(__ATOMIC_ACQUIRE, "agent");
            xb_add(&bar[XB_XGEN(b.x)], 1u);
            asm volatile("s_waitcnt vmcnt(0)" ::: "memory");
        } else {
            XB_SPIN(xb_ld(&bar[XB_XGEN(b.x)]) == gen, bar);
            __builtin_amdgcn_fence(__ATOMIC_ACQUIRE, "agent");
            asm volatile("s_waitcnt vmcnt(0)" ::: "memory");
        }
    }
    __syncthreads();
}

struct Args { const float* in[N_IN]; float* out; unsigned char* ws; int ph_lo, ph_hi; };
struct Frame {
    LAS unsigned char* lds;
    int tid, lane, wave, G, bid;
    const float* const* in;
    float* out; unsigned char* ws;
    float* tab; float* H; bf16_t* U; float* AFF; int* SLOT; int* RIDX; float* GATE;
    bf16_t* SEAM; bf16_t* Y; bf16_t* HE; bf16_t* YE; float* P;
};

__device__ __forceinline__ double inv_freq(int f, int nf) {
    const double r16 = 0.5623413251903491;
    const int steps = (nf == 16) ? f : 2 * f;
    double v = 1.0;
    for (int i = 0; i < steps; ++i) v *= r16;
    return v;
}
__device__ __forceinline__ void sincos_d(double x, double& s, double& c) {
    const double TWO_PI = 6.283185307179586476925286766559;
    const double k = __builtin_rint(x / TWO_PI);
    const double r = x - k * TWO_PI;
    const double r2 = r * r;
    double ts = 1.0, tc = 1.0, ss = 1.0, cs = 1.0;
#pragma unroll 1
    for (int n = 1; n <= 14; ++n) {
        tc *= -r2 / (double)((2 * n - 1) * (2 * n));
        ts *= -r2 / (double)((2 * n) * (2 * n + 1));
        cs += tc; ss += ts;
    }
    s = r * ss; c = cs;
}

__device__ __forceinline__ void phase_prologue(Frame& F) {
    const int gt = F.bid * NTHR + F.tid, NGT = F.G * NTHR;
    for (int i = gt; i < 128 * 16 + 128 * 8; i += NGT) {
        if (i < 2048) { const int pos = i >> 4, f = i & 15; double s, c; sincos_d((double)pos * inv_freq(f, 16), s, c); F.tab[TB_C64 + i] = (float)c; F.tab[TB_S64 + i] = (float)s; }
        else { const int j = i - 2048, pos = j >> 3, f = j & 7; double s, c; sincos_d((double)pos * inv_freq(f, 8), s, c); F.tab[TB_C32 + j] = (float)c; F.tab[TB_S32 + j] = (float)s; }
    }
    if (gt < DEPTH) {
        const int l = gt; float a = 0.f, b = 0.f;
        for (int i = 0; i < 32; ++i) { a += F.in[I_LQ1][l * 32 + i] * F.in[I_LK1][l * 32 + i]; b += F.in[I_LQ2][l * 32 + i] * F.in[I_LK2][l * 32 + i]; }
        const float lam_init = 0.8f - 0.6f * expf(-0.3f * (float)l);
        F.tab[TB_LAM + 2 * l] = expf(a) - expf(b) + lam_init; F.tab[TB_LAM + 2 * l + 1] = 1.f - lam_init;
    }
    LAS float* red = (LAS float*)F.lds;
    for (int u = F.bid; u < DEPTH * 96; u += F.G) {
        const int l = u / 96, n0 = (u % 96) * 64, ks = F.tid >> 6, nn = F.tid & 63;
        const float* W = F.in[I_WMOD] + (size_t)l * D * 6144 + n0 + nn;
        float a0 = 0.f, a1 = 0.f, a2 = 0.f;
        for (int k = ks * 128; k < ks * 128 + 128; ++k) {
            const float w = W[(size_t)k * 6144];
            a0 += silu_f(F.in[I_C][k]) * w; a1 += silu_f(F.in[I_C][D + k]) * w; a2 += silu_f(F.in[I_CCTX][k]) * w;
        }
        red[(ks * 3 + 0) * 64 + nn] = a0; red[(ks * 3 + 1) * 64 + nn] = a1; red[(ks * 3 + 2) * 64 + nn] = a2;
        __syncthreads();
        if (F.tid < 192) { const int v = F.tid >> 6; float s = 0.f;
            for (int q = 0; q < 8; ++q) s += red[(q * 3 + v) * 64 + nn];
            F.tab[TB_MOD + (l * 3 + v) * 6144 + n0 + nn] = s + F.in[I_BMOD][l * 6144 + n0 + nn]; }
        __syncthreads();
    }
}

template <int MODE> __device__ __forceinline__ void phase_norm(Frame& F, int l, bool src0, int comb_l, bool with_ctx) {
    const int gw = F.bid * NWAVES + F.wave, NGW = F.G * NWAVES;
    const int nrows = with_ctx ? ROWS : ROWS_L;
    for (int r = gw; r < nrows; r += NGW) {
        const bool isc = r >= ROWS_L; const int b = isc ? (r - ROWS_L) / LC : r / S; const int mv = isc ? 2 : b;
        const float* src = src0 ? (isc ? F.in[I_CTX] + (size_t)(r - ROWS_L) * D : F.in[I_X] + (size_t)r * D) : F.H + (size_t)r * D;
        f32x4 v[4];
#pragma unroll
        for (int j = 0; j < 4; ++j) v[j] = *(const f32x4*)(src + 4 * F.lane + 256 * j);
        if (comb_l >= 0) {
            const float* g2 = F.tab + TB_MOD + (comb_l * 3 + mv) * 6144 + 5 * D;
            const int* sl = F.SLOT + (size_t)r * 16;
            f32x4 acc[4];
#pragma unroll
            for (int j = 0; j < 4; ++j) acc[j] = (f32x4){0.f, 0.f, 0.f, 0.f};
            for (int e = 0; e < NE; ++e) {
                const int s_ = sl[e];
                if (s_ >= 0) {
                    const int base = isc ? 2 * CAP_L + b * CAP_C : b * CAP_L;
                    const bf16_t* y = F.YE + ((size_t)e * EPAD + base + s_) * D;
#pragma unroll
                    for (int j = 0; j < 4; ++j) { const uint2 w = *(const uint2*)(y + 4 * F.lane + 256 * j);
                        acc[j][0] += bflo(w.x); acc[j][1] += bfhi(w.x); acc[j][2] += bflo(w.y); acc[j][3] += bfhi(w.y); }
                }
            }
#pragma unroll
            for (int j = 0; j < 4; ++j) { const f32x4 g = *(const f32x4*)(g2 + 4 * F.lane + 256 * j); v[j] += g * acc[j]; *(f32x4*)(F.H + (size_t)r * D + 4 * F.lane + 256 * j) = v[j]; }
        }
        float ss = 0.f;
#pragma unroll
        for (int j = 0; j < 4; ++j) ss += (v[j][0] * v[j][0] + v[j][1] * v[j][1]) + (v[j][2] * v[j][2] + v[j][3] * v[j][3]);
        const float rs = 1.f / sqrtf(wave_sum(ss) * (1.f / D) + EPS);
        if (MODE == 2) {
#pragma unroll
            for (int j = 0; j < 4; ++j) { const f32x4 g = *(const f32x4*)(F.in[I_FG] + 4 * F.lane + 256 * j); *(f32x4*)(F.out + (size_t)r * D + 4 * F.lane + 256 * j) = v[j] * rs * g; }
        } else {
            const float* md = F.tab + TB_MOD + (l * 3 + mv) * 6144;
            const float* ng = F.in[I_N1G] + l * D;
#pragma unroll
            for (int j = 0; j < 4; ++j) { const int c0 = 4 * F.lane + 256 * j; const f32x4 g = *(const f32x4*)(ng + c0), sh = *(const f32x4*)(md + c0), sc = *(const f32x4*)(md + D + c0);
                const f32x4 u = (v[j] * rs * g) * (1.f + sc) + sh; uint2 w; w.x = pk2(u[0], u[1]); w.y = pk2(u[2], u[3]); *(uint2*)(F.U + (size_t)r * D + c0) = w; }
        }
    }
}

__device__ __forceinline__ void phase_norm2_router(Frame& F, int l, bool with_ctx) {
    LAS float* wr = (LAS float*)F.lds;
    for (int i = F.tid; i < D * NE; i += NTHR) wr[i] = F.in[I_WR][(size_t)l * D * NE + i];
    __syncthreads();
    const int gw = F.bid * NWAVES + F.wave, NGW = F.G * NWAVES;
    const int nrows = with_ctx ? ROWS : ROWS_L;
    for (int r = gw; r < nrows; r += NGW) {
        const bool isc = r >= ROWS_L; const int b = isc ? (r - ROWS_L) / LC : r / S; const int mv = isc ? 2 : b;
        const float* src = F.H + (size_t)r * D;
        const float* md = F.tab + TB_MOD + (l * 3 + mv) * 6144;
        const float* ng = F.in[I_N2G] + l * D;
        f32x4 v[4]; float ss = 0.f;
#pragma unroll
        for (int j = 0; j < 4; ++j) { v[j] = *(const f32x4*)(src + 4 * F.lane + 256 * j); ss += (v[j][0] * v[j][0] + v[j][1] * v[j][1]) + (v[j][2] * v[j][2] + v[j][3] * v[j][3]); }
        const float rs = 1.f / sqrtf(wave_sum(ss) * (1.f / D) + EPS);
        float lg[NE];
#pragma unroll
        for (int e = 0; e < NE; ++e) lg[e] = 0.f;
#pragma unroll
        for (int j = 0; j < 4; ++j) { const int c0 = 4 * F.lane + 256 * j; const f32x4 g = *(const f32x4*)(ng + c0), sh = *(const f32x4*)(md + 3 * D + c0), sc = *(const f32x4*)(md + 4 * D + c0);
            const f32x4 u = (v[j] * rs * g) * (1.f + sc) + sh; uint2 w; w.x = pk2(u[0], u[1]); w.y = pk2(u[2], u[3]); *(uint2*)(F.U + (size_t)r * D + c0) = w;
#pragma unroll
            for (int i = 0; i < 4; ++i) {
#pragma unroll
                for (int e4 = 0; e4 < 4; ++e4) { const f32x4 ww = *(const LAS f32x4*)(wr + (c0 + i) * NE + 4 * e4);
                    lg[4 * e4 + 0] += u[i] * ww[0]; lg[4 * e4 + 1] += u[i] * ww[1]; lg[4 * e4 + 2] += u[i] * ww[2]; lg[4 * e4 + 3] += u[i] * ww[3]; }
                asm volatile("" ::: "memory");
            }
        }
        float mx = -1e30f;
#pragma unroll
        for (int e = 0; e < NE; ++e) { lg[e] = wave_sum(lg[e]); mx = fmaxf(mx, lg[e]); }
        float sm = 0.f;
#pragma unroll
        for (int e = 0; e < NE; ++e) { lg[e] = expf(lg[e] - mx); sm += lg[e]; }
        const float inv = 1.f / sm;
        float mine = 0.f;
#pragma unroll
        for (int e = 0; e < NE; ++e) mine = (F.lane == e) ? lg[e] * inv : mine;
        if (F.lane < NE) F.AFF[(size_t)r * NE + F.lane] = mine;
    }
    __syncthreads();
}

__device__ __forceinline__ void phase_select_naive(Frame& F, bool with_ctx) {
    LAS float* col = (LAS float*)F.lds;
    const int NU = 32 * 16 + (with_ctx ? 32 : 0);
    for (int i = F.bid * NTHR + F.tid; i < NE * EPAD; i += F.G * NTHR) { const int sl = i % EPAD; if (sl >= (with_ctx ? ESLOTS : 2 * CAP_L)) { F.RIDX[i] = -1; F.GATE[i] = 0.f; } }
    for (int u = F.bid; u < NU; u += F.G) {
        const bool isc = u >= 512; const int li = isc ? u - 512 : u / 16, ch = isc ? 0 : u % 16, b = li / NE, e = li % NE;
        const int N = isc ? LC : S, C = isc ? CAP_C : CAP_L, row0 = isc ? ROWS_L + b * LC : b * S;
        __syncthreads();
        for (int i = F.tid; i < N; i += NTHR) col[i] = F.AFF[(size_t)(row0 + i) * NE + e];
        __syncthreads();
        const int n = ch * 512 + F.tid;
        if (n < N) {
            const float a = col[n]; int rank = 0;
            for (int m = 0; m < N; ++m) { const float x = col[m]; rank += (x > a || (x == a && m < n)) ? 1 : 0; }
            if (rank < C) { const int sl = (isc ? 2 * CAP_L + b * CAP_C : b * CAP_L) + rank; F.RIDX[e * EPAD + sl] = row0 + n; F.GATE[e * EPAD + sl] = a; F.SLOT[(size_t)(row0 + n) * NE + e] = rank; }
            else F.SLOT[(size_t)(row0 + n) * NE + e] = -1;
        }
    }
    __syncthreads();
}

struct NaiveEpi { int mode; int l; float* P; const float* hin; float* hout; const float* mod; bf16_t* HE; bf16_t* YE; const float* gate; };
template <bool DUAL> __device__ __forceinline__ void naive_gemm_tile(Frame& F, const bf16_t* A, int lda, const int* ridx, int m0, int M, const float* W, const float* W2, int ldw, int n0, int K, const NaiveEpi& E, int erow0) {
    LAS float* As = (LAS float*)F.lds;
    LAS float* Bs = As + 16 * 132;
    LAS float* Bs2 = Bs + 16 * 64;
    const int ty = F.tid >> 4, tx = F.tid & 15;
    float acc[4][4], acc2[4][4];
#pragma unroll
    for (int i = 0; i < 4; ++i)
#pragma unroll
        for (int j = 0; j < 4; ++j) { acc[i][j] = 0.f; acc2[i][j] = 0.f; }
    const int ar = F.tid >> 1, ah = F.tid & 1;
    long arow = -1;
    if (F.tid < 256) { const int m = m0 + ar; if (m < M) arow = ridx ? (long)ridx[m] : (long)m; }
    const int bk = (F.tid - 256) >> 4, bc = (F.tid - 256) & 15;
    for (int k0 = 0; k0 < K; k0 += 16) {
        __syncthreads();
        if (F.tid < 256) {
            u32x4 w = (u32x4){0u, 0u, 0u, 0u};
            if (arow >= 0) w = *(const u32x4*)(A + (size_t)arow * lda + k0 + ah * 8);
            const int kb = ah * 8;
            As[(kb + 0) * 132 + ar] = bflo(w.x); As[(kb + 1) * 132 + ar] = bfhi(w.x); As[(kb + 2) * 132 + ar] = bflo(w.y); As[(kb + 3) * 132 + ar] = bfhi(w.y);
            As[(kb + 4) * 132 + ar] = bflo(w.z); As[(kb + 5) * 132 + ar] = bfhi(w.z); As[(kb + 6) * 132 + ar] = bflo(w.w); As[(kb + 7) * 132 + ar] = bfhi(w.w);
        } else {
            *(LAS f32x4*)(Bs + bk * 64 + bc * 4) = *(const f32x4*)(W + (size_t)(k0 + bk) * ldw + n0 + bc * 4);
            if (DUAL) *(LAS f32x4*)(Bs2 + bk * 64 + bc * 4) = *(const f32x4*)(W2 + (size_t)(k0 + bk) * ldw + n0 + bc * 4);
        }
        __syncthreads();
#pragma unroll
        for (int k = 0; k < 16; ++k) {
            const f32x4 a = *(const LAS f32x4*)(As + k * 132 + ty * 4), b = *(const LAS f32x4*)(Bs + k * 64 + tx * 4);
#pragma unroll
            for (int i = 0; i < 4; ++i)
#pragma unroll
                for (int j = 0; j < 4; ++j) acc[i][j] += a[i] * b[j];
            if (DUAL) { const f32x4 b2 = *(const LAS f32x4*)(Bs2 + k * 64 + tx * 4);
#pragma unroll
                for (int i = 0; i < 4; ++i)
#pragma unroll
                    for (int j = 0; j < 4; ++j) acc2[i][j] += a[i] * b2[j]; }
        }
    }
#pragma unroll
    for (int i = 0; i < 4; ++i) {
        const int m = m0 + ty * 4 + i; if (m >= M) continue;
        const int c0 = n0 + tx * 4;
        if (E.mode == 0) { *(f32x4*)(E.P + (size_t)m * DIN + c0) = (f32x4){acc[i][0], acc[i][1], acc[i][2], acc[i][3]}; }
        else if (E.mode == 1) {
            const bool isc = m >= ROWS_L; const int b = isc ? (m - ROWS_L) / LC : m / S; const int mv = isc ? 2 : b;
            const f32x4 g = *(const f32x4*)(E.mod + (E.l * 3 + mv) * 6144 + 2 * D + c0);
            const float* hi_ = (E.hin == nullptr) ? (isc ? F.in[I_CTX] + (size_t)(m - ROWS_L) * D : F.in[I_X] + (size_t)m * D) : E.hin + (size_t)m * D;
            const f32x4 h = *(const f32x4*)(hi_ + c0);
            *(f32x4*)(E.hout + (size_t)m * D + c0) = h + g * (f32x4){acc[i][0], acc[i][1], acc[i][2], acc[i][3]};
        } else if (E.mode == 2) {
            uint2 w; w.x = pk2(silu_f(acc[i][0]) * acc2[i][0], silu_f(acc[i][1]) * acc2[i][1]); w.y = pk2(silu_f(acc[i][2]) * acc2[i][2], silu_f(acc[i][3]) * acc2[i][3]);
            *(uint2*)(E.HE + (size_t)(erow0 + m) * D + c0) = w;
        } else {
            const float g = E.gate[erow0 + m];
            uint2 w; w.x = pk2(g * acc[i][0], g * acc[i][1]); w.y = pk2(g * acc[i][2], g * acc[i][3]);
            *(uint2*)(E.YE + (size_t)(erow0 + m) * D + c0) = w;
        }
    }
}

__device__ __forceinline__ void phase_inproj_naive(Frame& F, int l) {
    NaiveEpi E{}; E.mode = 0; E.P = F.P;
    const int nM = ROWS / 128, nN = DIN / 64;
    for (int u = F.bid; u < nM * nN; u += F.G) { const int pm = u / nN, pn = u % nN;
        naive_gemm_tile<false>(F, F.U, D, nullptr, pm * 128, ROWS, F.in[I_WIN] + (size_t)l * D * DIN, nullptr, DIN, pn * 64, D, E, 0); }
    __syncthreads();
}
__device__ __forceinline__ void phase_outproj_naive(Frame& F, int l, bool with_ctx) {
    NaiveEpi E{}; E.mode = 1; E.l = l; E.hin = (l == 0) ? nullptr : F.H; E.hout = F.H; E.mod = F.tab + TB_MOD;
    const int M = with_ctx ? ROWS : ROWS_L; const int nM = M / 128, nN = D / 64;
    for (int u = F.bid; u < nM * nN; u += F.G) { const int pm = u / nN, pn = u % nN;
        naive_gemm_tile<false>(F, F.Y, D, nullptr, pm * 128, M, F.in[I_WOUT] + (size_t)l * D * D, nullptr, D, pn * 64, D, E, 0); }
    __syncthreads();
}
__device__ __forceinline__ void phase_moe1_naive(Frame& F, int l, bool with_ctx) {
    NaiveEpi E{}; E.mode = 2; E.HE = F.HE;
    const int M = with_ctx ? ESLOTS : 2 * CAP_L; const int nM = (M + 127) / 128, nN = D / 64;
    for (int u = F.bid; u < NE * nM * nN; u += F.G) { const int e = u / (nM * nN), r = u % (nM * nN), pm = r / nN, pn = r % nN;
        naive_gemm_tile<true>(F, F.U, D, F.RIDX + e * EPAD, pm * 128, M, F.in[I_WG] + ((size_t)l * NE + e) * D * D, F.in[I_WU] + ((size_t)l * NE + e) * D * D, D, pn * 64, D, E, e * EPAD); }
    __syncthreads();
}
__device__ __forceinline__ void phase_moe2_naive(Frame& F, int l, bool with_ctx) {
    NaiveEpi E{}; E.mode = 3; E.YE = F.YE; E.gate = F.GATE;
    const int M = with_ctx ? ESLOTS : 2 * CAP_L; const int nM = (M + 127) / 128, nN = D / 64;
    for (int u = F.bid; u < NE * nM * nN; u += F.G) { const int e = u / (nM * nN), r = u % (nM * nN), pm = r / nN, pn = r % nN;
        naive_gemm_tile<false>(F, F.HE + (size_t)e * EPAD * D, D, nullptr, pm * 128, M, F.in[I_WD] + ((size_t)l * NE + e) * D * D, nullptr, D, pn * 64, D, E, e * EPAD); }
    __syncthreads();
}

__device__ __forceinline__ void store64(bf16_t* dst, const float (&v)[64]) {
#pragma unroll
    for (int i = 0; i < 8; ++i) { u32x4 w; w.x = pk2(v[8 * i], v[8 * i + 1]); w.y = pk2(v[8 * i + 2], v[8 * i + 3]); w.z = pk2(v[8 * i + 4], v[8 * i + 5]); w.w = pk2(v[8 * i + 6], v[8 * i + 7]); *(u32x4*)(dst + 8 * i) = w; }
}
template <int DIM, int OFF> __device__ __forceinline__ void rope_vec(float (&v)[64], const float* tab, int t) {
    constexpr int half = DIM / 2, nf = half / 2;
    const int pr = t >> 6, pc = t & 63;
    const float* C = tab + (DIM == 64 ? TB_C64 : TB_C32); const float* Sn = tab + (DIM == 64 ? TB_S64 : TB_S32);
#pragma unroll
    for (int i = 0; i < half; ++i) {
        const int pos = (i < nf) ? pr : pc, f = (i < nf) ? i : i - nf;
        const float c = C[pos * nf + f], s = Sn[pos * nf + f];
        const float x1 = v[OFF + i], x2 = v[OFF + half + i];
        v[OFF + i] = x1 * c - x2 * s; v[OFF + half + i] = x2 * c + x1 * s;
    }
}
__device__ __forceinline__ void phase_post_naive(Frame& F, int l) {
    const long NT = (long)ROWS * 40;
    for (long it = (long)F.bid * NTHR + F.tid; it < NT; it += (long)F.G * NTHR) {
        const int r = (int)(it / 40), u = (int)(it % 40);
        if (u >= 16 && u < 20) continue;
        const bool isc = r >= ROWS_L; const int b = isc ? (r - ROWS_L) / LC : r / S; const int t = isc ? (r - ROWS_L) % LC : r % S;
        const int key = isc ? t : LC + t;
        const float* p = F.P + (size_t)r * DIN + 64 * u;
        float v[64];
#pragma unroll
        for (int i = 0; i < 16; ++i) { const f32x4 x = *(const f32x4*)(p + 4 * i); v[4 * i] = x[0]; v[4 * i + 1] = x[1]; v[4 * i + 2] = x[2]; v[4 * i + 3] = x[3]; }
        bf16_t* dst;
        if (u < 4) {
            const float sc = 0.125f * LOG2E;
#pragma unroll
            for (int i = 0; i < 64; ++i) v[i] *= sc;
            dst = isc ? F.SEAM + SE_QAC + (((size_t)b * 4 + u) * LC + t) * 64 : F.SEAM + SE_QA + (((size_t)b * 4 + u) * S + t) * 64;
        } else if (u < 8) { dst = F.SEAM + SE_KA + (((size_t)b * 4 + (u - 4)) * KV + key) * 64; }
        else if (u < 12) { dst = F.SEAM + SE_VA + (((size_t)b * 4 + (u - 8)) * KV + key) * 64; }
        else if (u < 16) {
            const float* pg = p + 256;
#pragma unroll
            for (int i = 0; i < 16; ++i) { const f32x4 g = *(const f32x4*)(pg + 4 * i);
                v[4 * i] *= 1.f / (1.f + __expf(-g[0])); v[4 * i + 1] *= 1.f / (1.f + __expf(-g[1])); v[4 * i + 2] *= 1.f / (1.f + __expf(-g[2])); v[4 * i + 3] *= 1.f / (1.f + __expf(-g[3])); }
            dst = F.SEAM + SE_Z + (size_t)r * 256 + 64 * (u - 12);
        } else if (u < 24) {
            const int hq = u - 20; const float* g = F.in[I_QNG] + l * 64; float ss = 0.f;
#pragma unroll
            for (int i = 0; i < 64; ++i) ss += v[i] * v[i];
            const float rs = 1.f / sqrtf(ss * (1.f / 64.f) + EPS);
#pragma unroll
            for (int i = 0; i < 64; ++i) v[i] = v[i] * rs * g[i];
            if (!isc) rope_vec<64, 0>(v, F.tab, t);
            const float sc = 0.125f * LOG2E;
#pragma unroll
            for (int i = 0; i < 64; ++i) v[i] *= sc;
            dst = isc ? F.SEAM + SE_QGC + (((size_t)b * 4 + hq) * LC + t) * 64 : F.SEAM + SE_QG + (((size_t)b * 4 + hq) * S + t) * 64;
        } else if (u < 26) {
            const int hk = u - 24; const float* g = F.in[I_KNG] + l * 64; float ss = 0.f;
#pragma unroll
            for (int i = 0; i < 64; ++i) ss += v[i] * v[i];
            const float rs = 1.f / sqrtf(ss * (1.f / 64.f) + EPS);
#pragma unroll
            for (int i = 0; i < 64; ++i) v[i] = v[i] * rs * g[i];
            if (!isc) rope_vec<64, 0>(v, F.tab, t);
            dst = F.SEAM + SE_KG + (((size_t)b * 2 + hk) * KV + key) * 64;
        } else if (u < 28) { dst = F.SEAM + SE_VG + (((size_t)b * 2 + (u - 26)) * KV + key) * 64; }
        else if (u < 32) {
            const int h = u - 28;
            if (!isc) { rope_vec<32, 0>(v, F.tab, t); rope_vec<32, 32>(v, F.tab, t); }
            const float sc = 0.17677669529663687f * LOG2E;
#pragma unroll
            for (int i = 0; i < 64; ++i) v[i] *= sc;
            dst = isc ? F.SEAM + SE_QDC + (((size_t)b * 4 + h) * LC + t) * 64 : F.SEAM + SE_QD + (((size_t)b * 4 + h) * S + t) * 64;
        } else if (u < 36) {
            const int h = u - 32;
            if (!isc) { rope_vec<32, 0>(v, F.tab, t); rope_vec<32, 32>(v, F.tab, t); }
            dst = F.SEAM + SE_KD + (((size_t)b * 4 + h) * KV + key) * 64;
        } else { dst = F.SEAM + SE_VD + (((size_t)b * 4 + (u - 36)) * KV + key) * 64; }
        store64(dst, v);
    }
}

__device__ __forceinline__ void load64(float (&v)[64], const bf16_t* p) {
#pragma unroll
    for (int i = 0; i < 8; ++i) { const u32x4 w = *(const u32x4*)(p + 8 * i);
        v[8 * i] = bflo(w.x); v[8 * i + 1] = bfhi(w.x); v[8 * i + 2] = bflo(w.y); v[8 * i + 3] = bfhi(w.y); v[8 * i + 4] = bflo(w.z); v[8 * i + 5] = bfhi(w.z); v[8 * i + 6] = bflo(w.w); v[8 * i + 7] = bfhi(w.w); }
}
struct Q64 { u32x4 w[8]; };
__device__ __forceinline__ void loadq(Q64& q, const bf16_t* p) {
#pragma unroll
    for (int i = 0; i < 8; ++i) q.w[i] = *(const u32x4*)(p + 8 * i);
}
__device__ __forceinline__ float dot8(u32x4 a, const u32x4 w, float s) {
    asm volatile("" : "+v"(a));
    s += bflo(a.x) * bflo(w.x); s += bfhi(a.x) * bfhi(w.x); s += bflo(a.y) * bflo(w.y); s += bfhi(a.y) * bfhi(w.y);
    s += bflo(a.z) * bflo(w.z); s += bfhi(a.z) * bfhi(w.z); s += bflo(a.w) * bflo(w.w); s += bfhi(a.w) * bfhi(w.w); return s;
}
__device__ __forceinline__ float dot64(const Q64& q, const bf16_t* k) {
    float s0 = 0.f, s1 = 0.f;
#pragma unroll
    for (int i = 0; i < 8; i += 2) { s0 = dot8(q.w[i], *(const u32x4*)(k + 8 * i), s0); s1 = dot8(q.w[i + 1], *(const u32x4*)(k + 8 * i + 8), s1); }
    return s0 + s1;
}
template <int OFF> __device__ __forceinline__ float dot32(const Q64& q, const bf16_t* k) {
    float s0 = 0.f, s1 = 0.f;
#pragma unroll
    for (int i = 0; i < 4; i += 2) { s0 = dot8(q.w[OFF / 8 + i], *(const u32x4*)(k + OFF + 8 * i), s0); s1 = dot8(q.w[OFF / 8 + i + 1], *(const u32x4*)(k + OFF + 8 * i + 8), s1); }
    return s0 + s1;
}
__device__ __forceinline__ void axpy64(float (&o)[64], float p, const bf16_t* vrow) {
#pragma unroll
    for (int i = 0; i < 8; ++i) { const u32x4 w = *(const u32x4*)(vrow + 8 * i);
        o[8 * i] += p * bflo(w.x); o[8 * i + 1] += p * bfhi(w.x); o[8 * i + 2] += p * bflo(w.y); o[8 * i + 3] += p * bfhi(w.y);
        o[8 * i + 4] += p * bflo(w.z); o[8 * i + 5] += p * bfhi(w.z); o[8 * i + 6] += p * bflo(w.w); o[8 * i + 7] += p * bfhi(w.w); }
}
#define OSM_STEP(m, lsum, o, s, vrow) do { if ((s) > (m)) { const float f_ = exp2f((m) - (s)); (lsum) *= f_; _Pragma("unroll") for (int i_ = 0; i_ < 64; ++i_) (o)[i_] *= f_; (m) = (s); } \
    const float p_ = exp2f((s) - (m)); (lsum) += p_; axpy64((o), p_, (vrow)); } while (0)

__device__ __forceinline__ void axpy32(float (&o)[32], float p, const bf16_t* vrow) {
#pragma unroll
    for (int i = 0; i < 4; ++i) { const u32x4 w = *(const u32x4*)(vrow + 8 * i);
        o[8 * i] += p * bflo(w.x); o[8 * i + 1] += p * bfhi(w.x); o[8 * i + 2] += p * bflo(w.y); o[8 * i + 3] += p * bfhi(w.y);
        o[8 * i + 4] += p * bflo(w.z); o[8 * i + 5] += p * bfhi(w.z); o[8 * i + 6] += p * bflo(w.w); o[8 * i + 7] += p * bfhi(w.w); }
}
#define OSM_STEP32(m, lsum, o, s, vrow) do { if ((s) > (m)) { const float f_ = exp2f((m) - (s)); (lsum) *= f_; _Pragma("unroll") for (int i_ = 0; i_ < 32; ++i_) (o)[i_] *= f_; (m) = (s); } \
    const float p_ = exp2f((s) - (m)); (lsum) += p_; axpy32((o), p_, (vrow)); } while (0)
__device__ __forceinline__ void naive_diff(Frame& F, int l, const bf16_t* qp, const bf16_t* K, const bf16_t* V, int nk, int dh, bf16_t* dst) {
    Q64 q; loadq(q, qp);
    float o1[32], o2[32]; float m1 = -1e30f, l1 = 0.f, m2 = -1e30f, l2 = 0.f;
#pragma unroll
    for (int i = 0; i < 32; ++i) { o1[i] = 0.f; o2[i] = 0.f; }
    const int z = vzero();
#pragma unroll 1
    for (int j = 0; j < nk; ++j) {
        const bf16_t* kr = K + (size_t)(j + z) * 64; const bf16_t* vr = V + (size_t)(j + z) * 64 + 32 * dh;
        const float s1 = dot32<0>(q, kr), s2 = dot32<32>(q, kr);
        OSM_STEP32(m1, l1, o1, s1, vr); OSM_STEP32(m2, l2, o2, s2, vr);
    }
    const float lam = F.tab[TB_LAM + 2 * l], oml = F.tab[TB_LAM + 2 * l + 1];
    const float i1 = 1.f / l1, i2 = lam / l2; float ss = 0.f;
#pragma unroll
    for (int i = 0; i < 32; ++i) { o1[i] = o1[i] * i1 - o2[i] * i2; ss += o1[i] * o1[i]; }
    ss += __shfl_xor(ss, 1);
    const float rs = oml / sqrtf(ss * (1.f / 64.f) + EPS);
    const float* g = F.in[I_DNG] + l * 64 + 32 * dh;
#pragma unroll
    for (int i = 0; i < 4; ++i) { u32x4 w; w.x = pk2(o1[8 * i] * rs * g[8 * i], o1[8 * i + 1] * rs * g[8 * i + 1]); w.y = pk2(o1[8 * i + 2] * rs * g[8 * i + 2], o1[8 * i + 3] * rs * g[8 * i + 3]);
        w.z = pk2(o1[8 * i + 4] * rs * g[8 * i + 4], o1[8 * i + 5] * rs * g[8 * i + 5]); w.w = pk2(o1[8 * i + 6] * rs * g[8 * i + 6], o1[8 * i + 7] * rs * g[8 * i + 7]); *(u32x4*)(dst + 8 * i) = w; }
}
__device__ __forceinline__ void store32n(bf16_t* dst, const float (&o)[32], float inv) {
#pragma unroll
    for (int i = 0; i < 4; ++i) { u32x4 w; w.x = pk2(o[8 * i] * inv, o[8 * i + 1] * inv); w.y = pk2(o[8 * i + 2] * inv, o[8 * i + 3] * inv);
        w.z = pk2(o[8 * i + 4] * inv, o[8 * i + 5] * inv); w.w = pk2(o[8 * i + 6] * inv, o[8 * i + 7] * inv); *(u32x4*)(dst + 8 * i) = w; }
}
__device__ __forceinline__ void naive_attn(const bf16_t* qp, const bf16_t* K, const bf16_t* V, int nk, int dh, bf16_t* dst) {
    Q64 q; loadq(q, qp);
    float o[32]; float m = -1e30f, ls = 0.f;
#pragma unroll
    for (int i = 0; i < 32; ++i) o[i] = 0.f;
    const int z = vzero();
#pragma unroll 1
    for (int j = 0; j < nk; ++j) { const float s = dot64(q, K + (size_t)(j + z) * 64); OSM_STEP32(m, ls, o, s, V + (size_t)(j + z) * 64 + 32 * dh); }
    store32n(dst, o, 1.f / ls);
}
__device__ __forceinline__ void naive_na(Frame& F, int l, int b, int h, int t, int dh, bf16_t* dst) {
    Q64 q; loadq(q, F.SEAM + SE_QA + (((size_t)b * 4 + h) * S + t) * 64);
    const bf16_t* K = F.SEAM + SE_KA + ((size_t)b * 4 + h) * KV * 64; const bf16_t* V = F.SEAM + SE_VA + ((size_t)b * 4 + h) * KV * 64 + 32 * dh;
    const float* rpb = F.in[I_RPB] + ((size_t)l * 4 + h) * 15 * 31;
    const int r = t >> 6, jq = t & 63;
    int rs = r - 4; rs = rs < 0 ? 0 : (rs > 120 ? 120 : rs);
    int cs = jq - 8; cs = cs < 0 ? 0 : (cs > 48 ? 48 : cs);
    float o[32]; float m = -1e30f, ls = 0.f;
#pragma unroll
    for (int i = 0; i < 32; ++i) o[i] = 0.f;
#pragma unroll 1
    for (int kk = 0; kk < 128 + LC; ++kk) {
        int key; float bias = 0.f;
        if (kk < 128) { const int rr = rs + (kk >> 4), cc = cs + (kk & 15); key = LC + rr * 64 + cc;
            const int dr = rr - r + 7; int dc = cc - jq; dc = dc < -15 ? -15 : (dc > 15 ? 15 : dc); dc += 15; bias = rpb[dr * 31 + dc] * LOG2E; }
        else key = kk - 128;
        const float s = dot64(q, K + (size_t)key * 64) + bias;
        OSM_STEP32(m, ls, o, s, V + (size_t)key * 64);
    }
    store32n(dst, o, 1.f / ls);
}
__device__ __forceinline__ void phase_conv_naive(Frame& F, int l, int unit, bool ctxu) {
    LAS float* zc = (LAS float*)F.lds;
    const int row0 = ctxu ? ROWS_L + unit * 16 : unit * 16;
    const int seqlen = ctxu ? LC : S; const int t0 = (ctxu ? unit * 16 : unit * 16) % seqlen; const int seqrow0 = row0 - t0;
    const bf16_t* Z = F.SEAM + SE_Z;
    const float* dww = F.in[I_DWW] + (size_t)l * 31 * 256; const float* dwb = F.in[I_DWB] + l * 256;
    __syncthreads();
#pragma unroll 1
    for (int i = F.tid; i < 16 * 256; i += NTHR) {
        const int tt = i >> 8, c = i & 255; float a = dwb[c];
#pragma unroll 4
        for (int k = 0; k < 31; ++k) { const int ts = t0 + tt + k - 15; if (ts >= 0 && ts < seqlen) a += bf2f(Z[(size_t)(seqrow0 + ts) * 256 + c]) * dww[k * 256 + c]; }
        zc[i] = a;
    }
    __syncthreads();
    for (int tt = F.wave * 2; tt < F.wave * 2 + 2; ++tt) {
        float x[4]; float s = 0.f;
#pragma unroll
        for (int j = 0; j < 4; ++j) { x[j] = zc[tt * 256 + F.lane + 64 * j]; s += x[j]; }
        const float mu = wave_sum(s) * (1.f / 256.f); float q = 0.f;
#pragma unroll
        for (int j = 0; j < 4; ++j) { x[j] -= mu; q += x[j] * x[j]; }
        const float rs = 1.f / sqrtf(wave_sum(q) * (1.f / 256.f) + EPS);
#pragma unroll
        for (int j = 0; j < 4; ++j) { const int c = F.lane + 64 * j; const float y = x[j] * rs * F.in[I_LNG][l * 256 + c] + F.in[I_LNB][l * 256 + c]; zc[tt * 256 + c] = silu_f(y); }
    }
    __syncthreads();
    const float* pw = F.in[I_PWW] + (size_t)l * 256 * 256; const float* pb = F.in[I_PWB] + l * 256;
#pragma unroll 1
    for (int i = F.tid; i < 16 * 256; i += NTHR) {
        const int tt = i >> 8, c = i & 255; float a = pb[c];
#pragma unroll 8
        for (int k = 0; k < 256; ++k) a += zc[tt * 256 + k] * pw[k * 256 + c];
        F.Y[(size_t)(row0 + tt) * D + 256 + c] = (bf16_t)f2bf(a);
    }
}
#ifndef FAST_ATTN_SKIP
#define FAST_ATTN_SKIP 1
#endif
#ifndef FAST_NA_LAT
#define FAST_NA_LAT 1
#endif
#ifndef FAST_NA_CTX
#define FAST_NA_CTX 1
#endif
__device__ __forceinline__ void phase_mixers_naive(Frame& F, int l, bool with_ctx) {
    const int NA_U = with_ctx ? 264 : 256;
#define UNIT_DECODE const bool cu = u >= 256; const int nq = cu ? LC : S; const int idx = cu ? u - 256 : u; const int q0 = idx * 256 + (F.tid >> 1), dh = F.tid & 1; \
        const int b = q0 / (4 * nq), h = (q0 / nq) % 4, t = q0 % nq; const int row = cu ? ROWS_L + b * LC + t : b * S + t;
#pragma unroll 1
    for (int u = F.bid; u < (FAST_ATTN_SKIP ? 0 : NA_U); u += F.G) { UNIT_DECODE
        const bf16_t* qp = F.SEAM + (cu ? SE_QGC : SE_QG) + (((size_t)b * 4 + h) * nq + t) * 64;
        const size_t kvo = ((size_t)b * 2 + (h >> 1)) * KV * 64;
        naive_attn(qp, F.SEAM + SE_KG + kvo, F.SEAM + SE_VG + kvo, cu ? LC : KV, dh, F.Y + (size_t)row * D + 512 + h * 64 + 32 * dh);
    }
    asm volatile("" ::: "memory");
#pragma unroll 1
    for (int u = F.G - 1 - F.bid; u < (FAST_ATTN_SKIP ? 0 : NA_U); u += F.G) { UNIT_DECODE
        const bf16_t* qp = F.SEAM + (cu ? SE_QDC : SE_QD) + (((size_t)b * 4 + h) * nq + t) * 64;
        const size_t kvo = ((size_t)b * 4 + h) * KV * 64;
        naive_diff(F, l, qp, F.SEAM + SE_KD + kvo, F.SEAM + SE_VD + kvo, cu ? LC : KV, dh, F.Y + (size_t)row * D + 768 + h * 64 + 32 * dh);
    }
    asm volatile("" ::: "memory");
#pragma unroll 1
    for (int u = F.bid; u < NA_U; u += F.G) { UNIT_DECODE
        if (cu ? FAST_NA_CTX : FAST_NA_LAT) continue;
        if (cu) { const bf16_t* qp = F.SEAM + SE_QAC + (((size_t)b * 4 + h) * LC + t) * 64; const size_t kvo = ((size_t)b * 4 + h) * KV * 64;
            naive_attn(qp, F.SEAM + SE_KA + kvo, F.SEAM + SE_VA + kvo, LC, dh, F.Y + (size_t)row * D + h * 64 + 32 * dh); }
        else naive_na(F, l, b, h, t, dh, F.Y + (size_t)row * D + h * 64 + 32 * dh);
    }
#undef UNIT_DECODE
    asm volatile("" ::: "memory");
#pragma unroll 1
    for (int u = F.bid; u < (with_ctx ? 1056 : 1024); u += F.G) { if (u < 1024) phase_conv_naive(F, l, u, false); else phase_conv_naive(F, l, u - 1024, true); }
    __syncthreads();
}


#ifndef FAST_INPROJ
#define FAST_INPROJ 1
#endif
#ifndef FAST_OUTPROJ
#define FAST_OUTPROJ 1
#endif
#ifndef FAST_MOE
#define FAST_MOE 1
#endif
constexpr size_t WB_GU = 0;
constexpr size_t WB_DN = 128 * MiB;
constexpr size_t WB_IN = 192 * MiB;
constexpr size_t WB_OUT = 202 * MiB;
static_assert(!(FAST_MOE && !FAST_INPROJ), "naive P overlays the MoE weight copies");
constexpr int GOFS_OFF = 131072 + 1024;

namespace pg8 {
typedef short bf16x8 __attribute__((ext_vector_type(8)));
constexpr int BM = 256, BK = 64, HALF = 128, HTB = HALF * BK * 2, STAGE_BYTES = 8 * HTB;
__device__ __forceinline__ int lds_byte(int r, int c) { const int st = (r >> 4) * 2 + (c >> 5), rr = r & 15, cc = c & 31, ob = rr * 64 + cc * 2; return st * 1024 + (ob ^ (((ob >> 9) & 1) << 5)); }
__device__ __forceinline__ void stage_rc(int b, int& R, int& C) { const int st = b / 1024, sb = b % 1024, swz = sb ^ (((sb >> 9) & 1) << 5); R = (st >> 1) * 16 + swz / 64; C = (st & 1) * 32 + (swz % 64) / 2; }
__device__ __forceinline__ int perm32(int rho) { const int n = rho >> 4, i = rho & 15; return 8 * (i >> 2) + 4 * n + (i & 3); }
struct Unit { int pm, pn; };
struct Gemm { const bf16_t* A; const bf16_t* Bt; int K; };

template <class Epi, class Sched, bool GATHER>
__device__ __forceinline__ void gemm_phase(LAS unsigned char* lds, const Gemm g, const Sched& S, const Epi& E, const LAS unsigned* gofs) {
    const int tid = threadIdx.x, wid = __builtin_amdgcn_readfirstlane(tid >> 6), lane = tid & 63, wr = wid >> 2, wc = wid & 3, fr = lane & 15, fq = lane >> 4;
    const int K = g.K, nt = K / BK;
    unsigned voffB[2];
#pragma unroll
    for (int i = 0; i < 2; ++i) { int R, C; stage_rc(tid * 16 + i * 8192, R, C); const int Rb = (R & ~31) + perm32(R & 31);
        voffB[i] = (unsigned)(Rb * K + C) * 2u; }
    const size_t kstep = (size_t)(BK * 2);
    const size_t hstep = (size_t)HALF * K * 2;
    const size_t tstep = 2 * hstep;
    const unsigned ldsw = (unsigned)wid * 1024u;
    const int aoff = lds_byte(wr * 64 + fr, fq * 8), boff = lds_byte(wc * 32 + fr, fq * 8);
#define PG8_SA(b, h) (((b) * 2 + (h)) * HTB)
#define PG8_SB(b, h) ((4 + (b) * 2 + (h)) * HTB)
#define PG8_STAGE(bufoff, gbase, voff) do { _Pragma("unroll") for (int _i = 0; _i < 2; ++_i) \
        __builtin_amdgcn_global_load_lds((const unsigned*)((const char*)(gbase) + (voff)[_i]), (LAS unsigned*)(lds + (bufoff) + ldsw + _i * 8192), 16, 0, 0); } while (0)
#define PG8_LDA(dst, b, h) do { _Pragma("unroll") for (int m = 0; m < 4; ++m) _Pragma("unroll") for (int k = 0; k < 2; ++k) dst[m][k] = *(const LAS bf16x8*)(lds + PG8_SA(b, h) + aoff + m * 2048 + k * 1024); } while (0)
#define PG8_LDB(dst, b, h) do { _Pragma("unroll") for (int n = 0; n < 2; ++n) _Pragma("unroll") for (int k = 0; k < 2; ++k) dst[n][k] = *(const LAS bf16x8*)(lds + PG8_SB(b, h) + boff + n * 2048 + k * 1024); } while (0)
#define PG8_MMA(ai, bj, At, Bt) do { __builtin_amdgcn_s_setprio(1); _Pragma("unroll") for (int m = 0; m < 4; ++m) _Pragma("unroll") for (int n = 0; n < 2; ++n) _Pragma("unroll") for (int k = 0; k < 2; ++k) \
        acc[ai][bj][m][n] = __builtin_amdgcn_mfma_f32_16x16x32_bf16(Bt[n][k], At[m][k], acc[ai][bj][m][n], 0, 0, 0); __builtin_amdgcn_s_setprio(0); } while (0)
#define PG8_WAIT_V(n) asm volatile("s_waitcnt vmcnt(" #n ")" ::: "memory")
#define PG8_WAIT_L(n) asm volatile("s_waitcnt lgkmcnt(" #n ")" ::: "memory")
#define PG8_BAR __builtin_amdgcn_s_barrier()
#define PG8_SCHED __builtin_amdgcn_sched_barrier(0)
#define PG8_AOFF(dst, u, slot) do { int _t = tid; asm volatile("" : "+v"(_t)); _Pragma("unroll") for (int _i = 0; _i < 2; ++_i) { int _R, _C; stage_rc(_t * 16 + _i * 8192, _R, _C); \
        _Pragma("unroll") for (int _h = 0; _h < 2; ++_h) \
        dst[_h][_i] = (GATHER ? gofs[(slot) * 256 + _h * HALF + _R] : (unsigned)((u).pm * BM + _h * HALF + _R) * (unsigned)(K * 2)) + (unsigned)_C * 2u; } } while (0)
    Unit cur, nxt; int ui = 0;
    if (!S.next(0, cur)) return;
    f32x4 acc[2][2][4][2];
#pragma unroll
    for (int a = 0; a < 2; ++a)
#pragma unroll
        for (int b = 0; b < 2; ++b)
#pragma unroll
            for (int m = 0; m < 4; ++m)
#pragma unroll
                for (int n = 0; n < 2; ++n) acc[a][b][m][n] = (f32x4){0.f, 0.f, 0.f, 0.f};
    bf16x8 At[4][2], B0[2][2], B1[2][2];
    unsigned ca[2][2];
    PG8_AOFF(ca, cur, 0);
    const char* Ab = (const char*)g.A; const char* cB = (const char*)g.Bt + (size_t)cur.pn * tstep;
    PG8_STAGE(PG8_SB(0, 0), cB, voffB); PG8_STAGE(PG8_SB(0, 1), cB + hstep, voffB); PG8_STAGE(PG8_SA(0, 0), Ab, ca[0]); PG8_STAGE(PG8_SA(0, 1), Ab, ca[1]);
    if (wr == 1) PG8_BAR;
    PG8_WAIT_V(2); PG8_BAR;
    PG8_STAGE(PG8_SB(1, 0), cB + kstep, voffB); PG8_STAGE(PG8_SA(1, 0), Ab + kstep, ca[0]); PG8_STAGE(PG8_SB(1, 1), cB + hstep + kstep, voffB);
    PG8_WAIT_V(6); PG8_BAR;
    for (;;) {
        const bool has_next = S.next(ui + 1, nxt);
        const char* nB = has_next ? (const char*)g.Bt + (size_t)nxt.pn * tstep : cB;
        for (int t = 0; t < nt; t += 2) {
            const bool last = (t == nt - 2);
            const char* a1 = Ab + (size_t)(t + 1) * kstep;
            const char* a2 = last ? Ab : Ab + (size_t)(t + 2) * kstep; const char* b2 = last ? nB : cB + (size_t)(t + 2) * kstep;
            const char* a3 = a2 + kstep; const char* b3 = b2 + kstep;
            PG8_LDB(B0, 0, 0); PG8_LDB(B1, 0, 1); PG8_SCHED; PG8_LDA(At, 0, 0); PG8_STAGE(PG8_SA(1, 1), a1, ca[1]);
            if (last && has_next) { PG8_AOFF(ca, nxt, ui + 1); }
            PG8_WAIT_V(8); PG8_WAIT_L(0); PG8_BAR; PG8_MMA(0, 0, At, B0); PG8_MMA(0, 1, At, B1); PG8_BAR; PG8_SCHED;
            PG8_LDA(At, 0, 1); PG8_STAGE(PG8_SB(0, 0), b2, voffB); PG8_STAGE(PG8_SB(0, 1), b2 + hstep, voffB); PG8_STAGE(PG8_SA(0, 0), a2, ca[0]);
            PG8_WAIT_V(8); PG8_WAIT_L(0); PG8_BAR; PG8_MMA(1, 0, At, B0); PG8_MMA(1, 1, At, B1); PG8_BAR; PG8_SCHED;
            PG8_LDB(B0, 1, 0); PG8_LDB(B1, 1, 1); PG8_SCHED; PG8_LDA(At, 1, 0); PG8_STAGE(PG8_SA(0, 1), a2, ca[1]);
            PG8_WAIT_V(8); PG8_WAIT_L(0); PG8_BAR; PG8_MMA(0, 0, At, B0); PG8_MMA(0, 1, At, B1); PG8_BAR; PG8_SCHED;
            PG8_LDA(At, 1, 1); PG8_STAGE(PG8_SB(1, 0), b3, voffB); PG8_STAGE(PG8_SB(1, 1), b3 + hstep, voffB); PG8_STAGE(PG8_SA(1, 0), a3, ca[0]);
            PG8_WAIT_V(8); PG8_WAIT_L(0); PG8_BAR; PG8_MMA(1, 0, At, B0); PG8_MMA(1, 1, At, B1); PG8_BAR; PG8_SCHED;
        }
        if (wr == 0) PG8_BAR;
        { int fr_ = fr, fq_ = fq, wr_ = wr, wc_ = wc; asm volatile("" : "+v"(fr_), "+v"(fq_), "+s"(wr_), "+s"(wc_));
          E(acc, cur, wr_, wc_, fr_, fq_); }
        if (!has_next) break;
#pragma unroll
        for (int a = 0; a < 2; ++a)
#pragma unroll
            for (int b = 0; b < 2; ++b)
#pragma unroll
                for (int m = 0; m < 4; ++m)
#pragma unroll
                    for (int n = 0; n < 2; ++n) acc[a][b][m][n] = (f32x4){0.f, 0.f, 0.f, 0.f};
        cur = nxt; cB = nB; ++ui;
        if (wr == 1) PG8_BAR;
    }
    PG8_WAIT_V(0);
    PG8_BAR;
#undef PG8_SA
#undef PG8_SB
#undef PG8_STAGE
#undef PG8_LDA
#undef PG8_LDB
#undef PG8_MMA
#undef PG8_WAIT_V
#undef PG8_WAIT_L
#undef PG8_BAR
#undef PG8_SCHED
#undef PG8_AOFF
}

struct OrderDense {
    int nM, nN, G, v;
    __device__ __forceinline__ bool next(int i, Unit& u) const {
        const int id = i * G + v; if (id >= nM * nN) return false;
        const int nig = 8 * nN, gid = id / nig, fm = gid * 8, gsz = (nM - fm) < 8 ? (nM - fm) : 8;
        u.pm = fm + ((id % nig) % gsz); u.pn = (id % nig) / gsz; return true;
    }
};
struct OrderMoe {
    int nM, nN, G, v;
    __device__ __forceinline__ bool next(int i, Unit& u) const {
        const int id = i * G + v; if (id >= NE * nM * nN) return false;
        const int e = id / (nM * nN), r = id % (nM * nN);
        u.pm = e * 9 + (r % nM); u.pn = e * nN + (r / nM); return true;
    }
};
}

__device__ __forceinline__ unsigned cvt_pk_bf16(float lo, float hi) { unsigned r; asm volatile("v_cvt_pk_bf16_f32 %0, %1, %2" : "=v"(r) : "v"(lo), "v"(hi)); return r; }
__device__ __forceinline__ u32x4 pack8(const f32x4 a, const f32x4 b) { u32x4 w; w.x = cvt_pk_bf16(a[0], a[1]); w.y = cvt_pk_bf16(a[2], a[3]); w.z = cvt_pk_bf16(b[0], b[1]); w.w = cvt_pk_bf16(b[2], b[3]); return w; }
__device__ __forceinline__ float fast_sigmoid(float x) { return __builtin_amdgcn_rcpf(1.f + __expf(-x)); }

struct EpiIn {
    bf16_t* SEAM; const float* tab; const float* qng; const float* kng;
    __device__ __forceinline__ void operator()(const f32x4 (&acc)[2][2][4][2], const pg8::Unit& u, int wr, int wc, int fr, int fq) const {
        const bool isc = u.pm >= 64; const int b = isc ? u.pm - 64 : u.pm >> 5; const int pn = u.pn; const int nq = isc ? LC : S;
        f32x4 gn[2][2];
        if (pn == 5 || pn == 6) { const float* g = (pn == 5) ? qng : kng;
#pragma unroll
            for (int bj = 0; bj < 2; ++bj)
#pragma unroll
                for (int n = 0; n < 2; ++n) gn[bj][n] = *(const f32x4*)(g + 32 * bj + 8 * fq + 4 * n); }
#pragma unroll
        for (int ai = 0; ai < 2; ++ai)
#pragma unroll
            for (int m = 0; m < 4; ++m) {
                const int rl = 128 * ai + 64 * wr + 16 * m + fr; const int r = u.pm * 256 + rl; const int t = isc ? rl : (r & (S - 1)); const int key = isc ? t : LC + t;
                const int e0 = 8 * fq;
                if (pn <= 2 || pn == 9 || (pn == 6 && wc >= 2)) {
                    bf16_t* base;
                    if (pn == 0) base = isc ? SEAM + SE_QAC + (((size_t)b * 4 + wc) * LC + t) * 64 : SEAM + SE_QA + (((size_t)b * 4 + wc) * S + t) * 64;
                    else if (pn == 1) base = SEAM + SE_KA + (((size_t)b * 4 + wc) * KV + key) * 64;
                    else if (pn == 2) base = SEAM + SE_VA + (((size_t)b * 4 + wc) * KV + key) * 64;
                    else if (pn == 9) base = SEAM + SE_VD + (((size_t)b * 4 + wc) * KV + key) * 64;
                    else base = SEAM + SE_VG + (((size_t)b * 2 + (wc - 2)) * KV + key) * 64;
                    const float sc = (pn == 0) ? 0.125f * LOG2E : 1.f;
#pragma unroll
                    for (int bj = 0; bj < 2; ++bj) *(u32x4*)(base + 32 * bj + e0) = pack8(acc[ai][bj][m][0] * sc, acc[ai][bj][m][1] * sc);
                } else if (pn == 3 || pn == 4) {
                    f32x4 z0, z1;
#pragma unroll
                    for (int j = 0; j < 4; ++j) { z0[j] = acc[ai][0][m][0][j] * fast_sigmoid(acc[ai][1][m][0][j]); z1[j] = acc[ai][0][m][1][j] * fast_sigmoid(acc[ai][1][m][1][j]); }
                    *(u32x4*)(SEAM + SE_Z + (size_t)r * 256 + 128 * (pn - 3) + 32 * wc + e0) = pack8(z0, z1);
                } else if (pn == 5 || pn == 6) {
                    float ss = 0.f;
#pragma unroll
                    for (int bj = 0; bj < 2; ++bj)
#pragma unroll
                        for (int n = 0; n < 2; ++n) { const f32x4 x = acc[ai][bj][m][n]; ss += (x[0] * x[0] + x[1] * x[1]) + (x[2] * x[2] + x[3] * x[3]); }
                    ss += __shfl_xor(ss, 16); ss += __shfl_xor(ss, 32);
                    const float rs = 1.f / sqrtf(ss * (1.f / 64.f) + EPS);
                    f32x4 x1[2], x2[2];
#pragma unroll
                    for (int n = 0; n < 2; ++n) { x1[n] = acc[ai][0][m][n] * rs * gn[0][n]; x2[n] = acc[ai][1][m][n] * rs * gn[1][n]; }
                    if (!isc) { const int pos = (fq < 2) ? (t >> 6) : (t & 63);
#pragma unroll
                        for (int n = 0; n < 2; ++n) { const f32x4 c = *(const f32x4*)(tab + TB_C64 + pos * 16 + 8 * (fq & 1) + 4 * n), sn = *(const f32x4*)(tab + TB_S64 + pos * 16 + 8 * (fq & 1) + 4 * n);
                            const f32x4 a = x1[n] * c - x2[n] * sn, bb = x2[n] * c + x1[n] * sn; x1[n] = a; x2[n] = bb; } }
                    bf16_t* base;
                    if (pn == 5) { base = isc ? SEAM + SE_QGC + (((size_t)b * 4 + wc) * LC + t) * 64 : SEAM + SE_QG + (((size_t)b * 4 + wc) * S + t) * 64;
                        const float sc = 0.125f * LOG2E;
#pragma unroll
                        for (int n = 0; n < 2; ++n) { x1[n] = x1[n] * sc; x2[n] = x2[n] * sc; } }
                    else base = SEAM + SE_KG + (((size_t)b * 2 + wc) * KV + key) * 64;
                    *(u32x4*)(base + e0) = pack8(x1[0], x1[1]); *(u32x4*)(base + 32 + e0) = pack8(x2[0], x2[1]);
                } else {
                    bf16_t* base;
                    if (pn == 7) base = isc ? SEAM + SE_QDC + (((size_t)b * 4 + wc) * LC + t) * 64 : SEAM + SE_QD + (((size_t)b * 4 + wc) * S + t) * 64;
                    else base = SEAM + SE_KD + (((size_t)b * 4 + wc) * KV + key) * 64;
                    const float sc = (pn == 7) ? 0.17677669529663687f * LOG2E : 1.f;
                    f32x4 c = (f32x4){1.f, 1.f, 1.f, 1.f}, sn = (f32x4){0.f, 0.f, 0.f, 0.f};
                    if (!isc) { const int pos = (fq < 2) ? (t >> 6) : (t & 63); c = *(const f32x4*)(tab + TB_C32 + pos * 8 + 4 * (fq & 1)); sn = *(const f32x4*)(tab + TB_S32 + pos * 8 + 4 * (fq & 1)); }
#pragma unroll
                    for (int bj = 0; bj < 2; ++bj) { const f32x4 x1 = acc[ai][bj][m][0], x2 = acc[ai][bj][m][1];
                        const f32x4 a = (x1 * c - x2 * sn) * sc, bb = (x2 * c + x1 * sn) * sc;
                        uint2 w1, w2; w1.x = cvt_pk_bf16(a[0], a[1]); w1.y = cvt_pk_bf16(a[2], a[3]); w2.x = cvt_pk_bf16(bb[0], bb[1]); w2.y = cvt_pk_bf16(bb[2], bb[3]);
                        *(uint2*)(base + 32 * bj + 4 * fq) = w1; *(uint2*)(base + 32 * bj + 16 + 4 * fq) = w2; }
                }
            }
    }
};
__device__ __forceinline__ int inproj_srccol(int nrow) {
    const int pn = nrow >> 8, p = nrow & 255, bj = p >> 7, wc = (p >> 5) & 3, j32 = p & 31;
    if (pn == 3 || pn == 4) return (bj ? 1024 : 768) + 128 * (pn - 3) + (p & 127);
    if (pn == 7 || pn == 8) { const int fq = j32 >> 3, n = (j32 >> 2) & 1, j = j32 & 3; return 256 * pn + 64 * wc + 32 * bj + 16 * n + 4 * fq + j; }
    return 256 * pn + 64 * wc + 32 * bj + j32;
}
struct EpiOut {
    const float* xl; const float* xc; const float* hin; float* hout; const float* modl;
    __device__ __forceinline__ void operator()(const f32x4 (&acc)[2][2][4][2], const pg8::Unit& u, int wr, int wc, int fr, int fq) const {
        const bool isc = u.pm >= 64; const int b = isc ? u.pm - 64 : u.pm >> 5; const float* g1 = modl + (isc ? 2 : b) * 6144 + 2 * D;
        const int col0 = u.pn * 256 + 32 * wc + 8 * fq;
        f32x4 g[2][2];
#pragma unroll
        for (int bj = 0; bj < 2; ++bj)
#pragma unroll
            for (int n = 0; n < 2; ++n) g[bj][n] = *(const f32x4*)(g1 + col0 + 128 * bj + 4 * n);
#pragma unroll
        for (int ai = 0; ai < 2; ++ai)
#pragma unroll
            for (int m = 0; m < 4; ++m) { const int r = u.pm * 256 + 128 * ai + 64 * wr + 16 * m + fr;
                const float* src = hin ? hin + (size_t)r * D : (isc ? xc + (size_t)(r - ROWS_L) * D : xl + (size_t)r * D);
#pragma unroll
                for (int bj = 0; bj < 2; ++bj)
#pragma unroll
                    for (int n = 0; n < 2; ++n) { const int c = col0 + 128 * bj + 4 * n; const f32x4 h = *(const f32x4*)(src + c); *(f32x4*)(hout + (size_t)r * D + c) = h + g[bj][n] * acc[ai][bj][m][n]; }
            }
    }
};
struct EpiMoe1 {
    bf16_t* HE;
    __device__ __forceinline__ void operator()(const f32x4 (&acc)[2][2][4][2], const pg8::Unit& u, int wr, int wc, int fr, int fq) const {
        const int f0 = (u.pn & 7) * 128 + 32 * wc + 8 * fq;
#pragma unroll
        for (int ai = 0; ai < 2; ++ai)
#pragma unroll
            for (int m = 0; m < 4; ++m) { const size_t r = (size_t)u.pm * 256 + 128 * ai + 64 * wr + 16 * m + fr;
                f32x4 h0, h1;
#pragma unroll
                for (int j = 0; j < 4; ++j) { const float a0 = acc[ai][0][m][0][j], a1 = acc[ai][0][m][1][j]; h0[j] = a0 * fast_sigmoid(a0) * acc[ai][1][m][0][j]; h1[j] = a1 * fast_sigmoid(a1) * acc[ai][1][m][1][j]; }
                *(u32x4*)(HE + r * D + f0) = pack8(h0, h1); }
    }
};
struct EpiMoe2 {
    bf16_t* YE; const float* gate;
    __device__ __forceinline__ void operator()(const f32x4 (&acc)[2][2][4][2], const pg8::Unit& u, int wr, int wc, int fr, int fq) const {
        const int c0 = (u.pn & 3) * 256 + 32 * wc + 8 * fq;
#pragma unroll
        for (int ai = 0; ai < 2; ++ai)
#pragma unroll
            for (int m = 0; m < 4; ++m) { const size_t r = (size_t)u.pm * 256 + 128 * ai + 64 * wr + 16 * m + fr; const float gt = gate[r];
#pragma unroll
                for (int bj = 0; bj < 2; ++bj) *(u32x4*)(YE + r * D + c0 + 128 * bj) = pack8(acc[ai][bj][m][0] * gt, acc[ai][bj][m][1] * gt); }
    }
};

__device__ __forceinline__ int vcu_of(const Frame& F) { return (F.G % 8 == 0) ? (F.bid % 8) * (F.G / 8) + F.bid / 8 : F.bid; }

__device__ __forceinline__ void phase_inproj_fast(Frame& F, int l) {
    pg8::Gemm g{F.U, (const bf16_t*)(F.ws + WS_WBF + WB_IN + (size_t)l * 5 * MiB), D};
    pg8::OrderDense S{ROWS / 256, DIN / 256, F.G, vcu_of(F)};
    EpiIn E{F.SEAM, F.tab, F.in[I_QNG] + l * 64, F.in[I_KNG] + l * 64};
    pg8::gemm_phase<EpiIn, pg8::OrderDense, false>(F.lds, g, S, E, nullptr);
}
__device__ __forceinline__ void phase_outproj_fast(Frame& F, int l, bool with_ctx) {
    pg8::Gemm g{F.Y, (const bf16_t*)(F.ws + WS_WBF + WB_OUT + (size_t)l * 2 * MiB), D};
    pg8::OrderDense S{(with_ctx ? ROWS : ROWS_L) / 256, D / 256, F.G, vcu_of(F)};
    EpiOut E{F.in[I_X], F.in[I_CTX], (l == 0) ? nullptr : F.H, F.H, F.tab + TB_MOD + l * 3 * 6144};
    pg8::gemm_phase<EpiOut, pg8::OrderDense, false>(F.lds, g, S, E, nullptr);
}
__device__ __forceinline__ void phase_moe1_fast(Frame& F, int l, bool with_ctx) {
    pg8::Gemm g{F.U, (const bf16_t*)(F.ws + WS_WBF + WB_GU + (size_t)l * 64 * MiB), D};
    pg8::OrderMoe S{with_ctx ? 9 : 8, 8, F.G, vcu_of(F)};
    LAS unsigned* gofs = (LAS unsigned*)(F.lds + GOFS_OFF);
    { pg8::Unit u;
      for (int i = 0; i < 8 && S.next(i, u); ++i)
          for (int j = F.tid; j < 256; j += NTHR) { const int ri = F.RIDX[u.pm * 256 + j]; gofs[i * 256 + j] = (unsigned)(ri < 0 ? 0 : ri) * (unsigned)(D * 2); }
      __syncthreads(); }
    EpiMoe1 E{F.HE};
    pg8::gemm_phase<EpiMoe1, pg8::OrderMoe, true>(F.lds, g, S, E, gofs);
}
__device__ __forceinline__ void phase_moe2_fast(Frame& F, int l, bool with_ctx) {
    pg8::Gemm g{F.HE, (const bf16_t*)(F.ws + WS_WBF + WB_DN + (size_t)l * 32 * MiB), D};
    pg8::OrderMoe S{with_ctx ? 9 : 8, 4, F.G, vcu_of(F)};
    EpiMoe2 E{F.YE, F.GATE};
    pg8::gemm_phase<EpiMoe2, pg8::OrderMoe, false>(F.lds, g, S, E, nullptr);
}

__device__ __forceinline__ void transpose_item(const float* W, int ldw, int srccol, int k0, bf16_t* WTrow0, int K, LAS float* scr, int lane) {
#pragma unroll 8
    for (int i = 0; i < 32; ++i) { const int kk = 2 * i + (lane >> 5); scr[kk * 33 + (lane & 31)] = W[(size_t)(k0 + kk) * ldw + srccol]; }
    asm volatile("s_waitcnt lgkmcnt(0)" ::: "memory");
    const int c = lane & 7;
#pragma unroll
    for (int j = 0; j < 4; ++j) { const int n = (lane >> 3) + 8 * j; const LAS float* s_ = scr + (8 * c) * 33 + n;
        u32x4 o; o.x = pk2(s_[0 * 33], s_[1 * 33]); o.y = pk2(s_[2 * 33], s_[3 * 33]); o.z = pk2(s_[4 * 33], s_[5 * 33]); o.w = pk2(s_[6 * 33], s_[7 * 33]);
        *(u32x4*)(WTrow0 + (size_t)n * K + k0 + 8 * c) = o; }
    asm volatile("s_waitcnt lgkmcnt(0)" ::: "memory");
}
__device__ __forceinline__ void phase_convert(Frame& F) {
    LAS float* scr = (LAS float*)(F.lds + F.wave * 16384);
    const int gw = F.bid * NWAVES + F.wave, NGW = F.G * NWAVES;
    constexpr int IT_IN = 16 * 80, IT_OUT = 16 * 32, IT_E = 16 * 32;
    constexpr int PER_L = IT_IN + IT_OUT + NE * 3 * IT_E;
    const int nn = F.lane & 31;
    for (int it = gw; it < DEPTH * PER_L; it += NGW) {
        const int l = it / PER_L; int r = it % PER_L;
        if (r < IT_IN) { if (!FAST_INPROJ) continue; const int kb = r / 80, nb = r % 80;
            transpose_item(F.in[I_WIN] + (size_t)l * D * DIN, DIN, inproj_srccol(nb * 32 + nn), kb * 64, (bf16_t*)(F.ws + WS_WBF + WB_IN + (size_t)l * 5 * MiB) + (size_t)(nb * 32) * D, D, scr, F.lane); continue; }
        r -= IT_IN;
        if (r < IT_OUT) { if (!FAST_OUTPROJ) continue; const int kb = r / 32, nb = r % 32;
            transpose_item(F.in[I_WOUT] + (size_t)l * D * D, D, nb * 32 + nn, kb * 64, (bf16_t*)(F.ws + WS_WBF + WB_OUT + (size_t)l * 2 * MiB) + (size_t)(nb * 32) * D, D, scr, F.lane); continue; }
        r -= IT_OUT;
        if (!FAST_MOE) continue;
        const int e = r / (3 * IT_E), q = (r % (3 * IT_E)) / IT_E, r2 = r % IT_E, kb = r2 / 32, nb = r2 % 32;
        const size_t wo = ((size_t)l * NE + e) * D * D;
        if (q < 2) {
            const int f0 = nb * 32; const int row0 = (f0 >> 7) * 256 + q * 128 + (f0 & 127);
            transpose_item(F.in[q == 0 ? I_WG : I_WU] + wo, D, f0 + nn, kb * 64, (bf16_t*)(F.ws + WS_WBF + WB_GU + (size_t)l * 64 * MiB) + ((size_t)e * 2048 + row0) * D, D, scr, F.lane);
        } else transpose_item(F.in[I_WD] + wo, D, nb * 32 + nn, kb * 64, (bf16_t*)(F.ws + WS_WBF + WB_DN + (size_t)l * 32 * MiB) + ((size_t)e * 1024 + nb * 32) * D, D, scr, F.lane);
    }
}


#ifndef FAST_ATTN
#define FAST_ATTN 1
#endif
namespace att {
typedef short bf16x8 __attribute__((ext_vector_type(8)));
typedef short s16x4 __attribute__((ext_vector_type(4)));
typedef float f32x16 __attribute__((ext_vector_type(16)));
constexpr int SLOTB = 8192, NSLOT = 3;
constexpr int L_K = 0, L_V = NSLOT * SLOTB, L_WS = 2 * NSLOT * SLOTB, L_OST = L_WS + NWAVES * 256, L_END = L_OST + NWAVES * 32 * 68 * 4;
constexpr int L_NAB = L_END;
static_assert(L_NAB + 2048 <= 131072, "attention LDS");
__device__ __forceinline__ int crow(int r, int hi) { return (r & 3) + 8 * (r >> 2) + 4 * hi; }
__device__ __forceinline__ s16x4 vtr(const LAS char* p) { return __builtin_bit_cast(s16x4, __builtin_amdgcn_ds_read_tr16_b64_v4i16((LAS s16x4*)p)); }
#define ATT_WAIT_BAR(N) asm volatile("s_waitcnt vmcnt(" #N ") lgkmcnt(0)\n\ts_barrier" ::: "memory")

template <int KIND> __device__ __forceinline__ void attn_unit(LAS char* lds, const bf16_t* Qw, const bf16_t* Kh, const bf16_t* Vh, int nt, bf16_t* Yw, float lam, float oml, const float* dng,
                                                            int rmin = 0, int qrow = 0, int qc = 0) {
    int tid = threadIdx.x; asm volatile("" : "+v"(tid));
    const int lane = tid & 63, r32 = lane & 31, hi = lane >> 5; const int wid = __builtin_amdgcn_readfirstlane(tid >> 6);
    LAS float* wsf = (LAS float*)(lds + L_WS) + wid * 64;
    const bf16_t* ksrc = Kh + (size_t)lane * 64 + wid * 8;
    const bf16_t* vsrc = Vh + (size_t)(16 * (wid & 3) + (lane >> 2)) * 64 + (wid >> 2) * 32 + (lane & 3) * 8;
    LAS char* kdst = lds + L_K + wid * 1024; LAS char* vdst = lds + L_V + wid * 1024;
#define ATT_TILE(i) ((KIND == 2 && (i) >= 4) ? (i) + rmin : (i))
#define ATT_DMA(t, slotb) do { __builtin_amdgcn_global_load_lds((const unsigned*)(ksrc + (size_t)(t) * 64 * 64), (LAS unsigned*)(kdst + (slotb)), 16, 0, 0); \
                               __builtin_amdgcn_global_load_lds((const unsigned*)(vsrc + (size_t)(t) * 64 * 64), (LAS unsigned*)(vdst + (slotb)), 16, 0, 0); } while (0)
    ATT_DMA(0, 0); ATT_DMA(1, SLOTB);
    bf16x8 qr[4];
#pragma unroll
    for (int d0 = 0; d0 < 4; ++d0) qr[d0] = *(const bf16x8*)(Qw + (size_t)r32 * 64 + d0 * 16 + hi * 8);
    f32x16 o1[2], o2[2]; float l1 = 0.f, l2 = 0.f;
    o1[0] = f32x16{}; o1[1] = f32x16{}; o2[0] = f32x16{}; o2[1] = f32x16{};
    const LAS char* kp0 = lds + L_K + hi * 1024 + r32 * 16;
    const LAS char* vp0 = lds + L_V + ((lane >> 4) & 1) * 32 + (lane & 3) * 8 + (4 * hi + ((lane & 15) >> 2)) * 64;
    int sl_cur = 0, sl_nn = 2 * SLOTB;
#pragma unroll 1
    for (int t = 0; t < nt; ++t) {
        ATT_WAIT_BAR(2);
        { const int tn = (t + 2 < nt) ? t + 2 : nt - 1; ATT_DMA(ATT_TILE(tn), sl_nn); }
        const LAS char* kp = kp0 + sl_cur; const LAS char* vp = vp0 + sl_cur;
        int na_dr = 0;
        if (KIND == 2) { int rs_ = qrow - 4; rs_ = rs_ < 0 ? 0 : (rs_ > 120 ? 120 : rs_); const int rr = rmin + t - 4; na_dr = rr - qrow + 7;
            if (t >= 4 && (rr < rs_ || rr >= rs_ + 8)) { sl_nn = sl_cur; sl_cur = (sl_cur == (NSLOT - 1) * SLOTB) ? 0 : sl_cur + SLOTB; continue; } }
        u32x4 pw[4], qw[4];
        {
            f32x16 pa0, pa1; const f32x16 z = f32x16{};
            if (KIND != 1) {
                bf16x8 kf[8];
#pragma unroll
                for (int d0 = 0; d0 < 4; ++d0) { kf[2 * d0] = *(const LAS bf16x8*)(kp + d0 * 2048); kf[2 * d0 + 1] = *(const LAS bf16x8*)(kp + d0 * 2048 + 512); }
                pa0 = __builtin_amdgcn_mfma_f32_32x32x16_bf16(kf[0], qr[0], z, 0, 0, 0); pa1 = __builtin_amdgcn_mfma_f32_32x32x16_bf16(kf[1], qr[0], z, 0, 0, 0);
#pragma unroll
                for (int d0 = 1; d0 < 4; ++d0) { pa0 = __builtin_amdgcn_mfma_f32_32x32x16_bf16(kf[2 * d0], qr[d0], pa0, 0, 0, 0); pa1 = __builtin_amdgcn_mfma_f32_32x32x16_bf16(kf[2 * d0 + 1], qr[d0], pa1, 0, 0, 0); }
            } else {
                bf16x8 kf[4];
#pragma unroll
                for (int d0 = 0; d0 < 2; ++d0) { kf[2 * d0] = *(const LAS bf16x8*)(kp + d0 * 2048); kf[2 * d0 + 1] = *(const LAS bf16x8*)(kp + d0 * 2048 + 512); }
                pa0 = __builtin_amdgcn_mfma_f32_32x32x16_bf16(kf[0], qr[0], z, 0, 0, 0); pa1 = __builtin_amdgcn_mfma_f32_32x32x16_bf16(kf[1], qr[0], z, 0, 0, 0);
                pa0 = __builtin_amdgcn_mfma_f32_32x32x16_bf16(kf[2], qr[1], pa0, 0, 0, 0); pa1 = __builtin_amdgcn_mfma_f32_32x32x16_bf16(kf[3], qr[1], pa1, 0, 0, 0);
            }
            if (KIND == 2 && t >= 4) {
                const int jq = 32 * qc + r32; int cs = jq - 8; cs = cs < 0 ? 0 : (cs > 48 ? 48 : cs);
                const LAS float* nb = (const LAS float*)(lds + L_NAB) + na_dr * 32 - jq + 15;
#pragma unroll
                for (int r = 0; r < 16; ++r) { const int kc = crow(r, hi);
                    pa0[r] = ((unsigned)(kc - cs) < 16u) ? pa0[r] + nb[kc] : -INFINITY;
                    pa1[r] = ((unsigned)(kc + 32 - cs) < 16u) ? pa1[r] + nb[kc + 32] : -INFINITY; }
            }
            float sa = 0.f, sb = 0.f;
#pragma unroll
            for (int r = 0; r < 16; ++r) { pa0[r] = __builtin_amdgcn_exp2f(pa0[r]); pa1[r] = __builtin_amdgcn_exp2f(pa1[r]); sa += pa0[r]; sb += pa1[r]; }
            l1 += sa + sb;
#pragma unroll
            for (int i = 0; i < 4; ++i) { pw[0][i] = cvt_pk_bf16(pa0[2 * i], pa0[2 * i + 1]); pw[1][i] = cvt_pk_bf16(pa0[8 + 2 * i], pa0[9 + 2 * i]); pw[2][i] = cvt_pk_bf16(pa1[2 * i], pa1[2 * i + 1]); pw[3][i] = cvt_pk_bf16(pa1[8 + 2 * i], pa1[9 + 2 * i]); }
        }
        if (KIND == 1) {
            __builtin_amdgcn_sched_barrier(0);
            f32x16 pb0, pb1; const f32x16 z = f32x16{};
            bf16x8 kf[4];
#pragma unroll
            for (int d0 = 0; d0 < 2; ++d0) { kf[2 * d0] = *(const LAS bf16x8*)(kp + (d0 + 2) * 2048); kf[2 * d0 + 1] = *(const LAS bf16x8*)(kp + (d0 + 2) * 2048 + 512); }
            pb0 = __builtin_amdgcn_mfma_f32_32x32x16_bf16(kf[0], qr[2], z, 0, 0, 0); pb1 = __builtin_amdgcn_mfma_f32_32x32x16_bf16(kf[1], qr[2], z, 0, 0, 0);
            pb0 = __builtin_amdgcn_mfma_f32_32x32x16_bf16(kf[2], qr[3], pb0, 0, 0, 0); pb1 = __builtin_amdgcn_mfma_f32_32x32x16_bf16(kf[3], qr[3], pb1, 0, 0, 0);
            float sc_ = 0.f, sd = 0.f;
#pragma unroll
            for (int r = 0; r < 16; ++r) { pb0[r] = __builtin_amdgcn_exp2f(pb0[r]); pb1[r] = __builtin_amdgcn_exp2f(pb1[r]); sc_ += pb0[r]; sd += pb1[r]; }
            l2 += sc_ + sd;
#pragma unroll
            for (int i = 0; i < 4; ++i) { qw[0][i] = cvt_pk_bf16(pb0[2 * i], pb0[2 * i + 1]); qw[1][i] = cvt_pk_bf16(pb0[8 + 2 * i], pb0[9 + 2 * i]); qw[2][i] = cvt_pk_bf16(pb1[2 * i], pb1[2 * i + 1]); qw[3][i] = cvt_pk_bf16(pb1[8 + 2 * i], pb1[9 + 2 * i]); }
            __builtin_amdgcn_sched_barrier(0);
        }
#pragma unroll
        for (int d0 = 0; d0 < 2; ++d0) {
#pragma unroll
            for (int ks = 0; ks < 4; ++ks) {
                const s16x4 lo = vtr(vp + d0 * 4096 + ks * 1024), hh = vtr(vp + d0 * 4096 + ks * 1024 + 512);
                const bf16x8 vf = (bf16x8){lo[0], lo[1], lo[2], lo[3], hh[0], hh[1], hh[2], hh[3]};
                o1[d0] = __builtin_amdgcn_mfma_f32_32x32x16_bf16(__builtin_bit_cast(bf16x8, pw[ks]), vf, o1[d0], 0, 0, 0);
                if (KIND == 1) o2[d0] = __builtin_amdgcn_mfma_f32_32x32x16_bf16(__builtin_bit_cast(bf16x8, qw[ks]), vf, o2[d0], 0, 0, 0);
            }
        }
        sl_nn = sl_cur; sl_cur = (sl_cur == (NSLOT - 1) * SLOTB) ? 0 : sl_cur + SLOTB;
    }
    ATT_WAIT_BAR(0);
    { auto rr = __builtin_amdgcn_permlane32_swap(__float_as_uint(l1), __float_as_uint(l1), false, false); l1 = __uint_as_float(rr[0]) + __uint_as_float(rr[1]); }
    if (KIND == 1) { auto rr = __builtin_amdgcn_permlane32_swap(__float_as_uint(l2), __float_as_uint(l2), false, false); l2 = __uint_as_float(rr[0]) + __uint_as_float(rr[1]); }
    if (hi == 0) { wsf[r32] = 1.f / l1; if (KIND == 1) wsf[32 + r32] = lam / l2; }
    asm volatile("s_waitcnt lgkmcnt(0)" ::: "memory");
    LAS float* stg = (LAS float*)(lds + L_OST) + wid * (32 * 68);
#pragma unroll
    for (int r = 0; r < 16; ++r) { const int q = crow(r, hi); const float a = wsf[q], b = (KIND == 1) ? wsf[32 + q] : 0.f;
#pragma unroll
        for (int d0 = 0; d0 < 2; ++d0) stg[q * 68 + d0 * 32 + r32] = (KIND == 1) ? (o1[d0][r] * a - o2[d0][r] * b) : o1[d0][r] * a; }
    asm volatile("s_waitcnt lgkmcnt(0)" ::: "memory");
    {
        const int row = lane >> 1, hf = lane & 1; float v[32];
#pragma unroll
        for (int i = 0; i < 8; ++i) { const f32x4 x = *(const LAS f32x4*)(stg + row * 68 + hf * 32 + 4 * i); v[4 * i] = x[0]; v[4 * i + 1] = x[1]; v[4 * i + 2] = x[2]; v[4 * i + 3] = x[3]; }
        if (KIND == 1) {
            float ss = 0.f;
#pragma unroll
            for (int i = 0; i < 32; ++i) ss += v[i] * v[i];
            ss += __shfl_xor(ss, 1);
            const float rs = oml / sqrtf(ss * (1.f / 64.f) + EPS);
#pragma unroll
            for (int i = 0; i < 32; ++i) v[i] = v[i] * rs * dng[hf * 32 + i];
        }
        bf16_t* dst = Yw + (size_t)row * D + hf * 32;
#pragma unroll
        for (int i = 0; i < 4; ++i) { u32x4 w; w.x = cvt_pk_bf16(v[8 * i], v[8 * i + 1]); w.y = cvt_pk_bf16(v[8 * i + 2], v[8 * i + 3]); w.z = cvt_pk_bf16(v[8 * i + 4], v[8 * i + 5]); w.w = cvt_pk_bf16(v[8 * i + 6], v[8 * i + 7]); *(u32x4*)(dst + 8 * i) = w; }
    }
    asm volatile("s_waitcnt lgkmcnt(0)\n\ts_barrier" ::: "memory");
#undef ATT_DMA
#undef ATT_TILE
}
}

__device__ __forceinline__ void gqa_unit_fast(Frame& F, int v, bool cu) {
    const int nblk = cu ? 2 : 64, bh = v / nblk, blk = v % nblk, b = bh >> 1, hk = bh & 1, hq = 2 * hk + (F.wave >> 2), t0 = blk * 128 + (F.wave & 3) * 32;
    const int nq = cu ? LC : S;
    const bf16_t* Qw = F.SEAM + (cu ? SE_QGC : SE_QG) + (((size_t)b * 4 + hq) * nq + t0) * 64;
    const size_t kvo = ((size_t)b * 2 + hk) * KV * 64;
    bf16_t* Yw = F.Y + (size_t)(cu ? ROWS_L + b * LC + t0 : b * S + t0) * D + 512 + hq * 64;
    att::attn_unit<0>((LAS char*)F.lds, Qw, F.SEAM + SE_KG + kvo, F.SEAM + SE_VG + kvo, cu ? LC / 64 : KV / 64, Yw, 0.f, 0.f, nullptr);
}
__device__ __forceinline__ void diff_unit_fast(Frame& F, int l, int v, bool cu) {
    const int nblk = cu ? 1 : 32, bh = v / nblk, blk = v % nblk, b = bh >> 2, h = bh & 3, t0 = blk * 256 + F.wave * 32;
    const int nq = cu ? LC : S;
    const bf16_t* Qw = F.SEAM + (cu ? SE_QDC : SE_QD) + (((size_t)b * 4 + h) * nq + t0) * 64;
    const size_t kvo = ((size_t)b * 4 + h) * KV * 64;
    bf16_t* Yw = F.Y + (size_t)(cu ? ROWS_L + b * LC + t0 : b * S + t0) * D + 768 + h * 64;
    att::attn_unit<1>((LAS char*)F.lds, Qw, F.SEAM + SE_KD + kvo, F.SEAM + SE_VD + kvo, cu ? LC / 64 : KV / 64, Yw, F.tab[TB_LAM + 2 * l], F.tab[TB_LAM + 2 * l + 1], F.in[I_DNG] + l * 64);
}
__device__ __forceinline__ void na_unit_fast(Frame& F, int l, int v) {
    const int bh = v >> 5, g = v & 31, b = bh >> 2, h = bh & 3, qrow = 4 * g + (F.wave >> 1), qc = F.wave & 1;
    int rmin = 4 * g - 4; rmin = rmin < 0 ? 0 : rmin; int rmax = 4 * g + 3 - 4; rmax = rmax < 0 ? 0 : (rmax > 120 ? 120 : rmax); rmax += 7;
    LAS float* nab = (LAS float*)(F.lds + att::L_NAB);
    const float* rpb = F.in[I_RPB] + ((size_t)l * 4 + h) * 15 * 31;
    if (F.tid < 15 * 32) { const int dr = F.tid >> 5, i = F.tid & 31; nab[F.tid] = (i < 31) ? rpb[dr * 31 + i] * LOG2E : 0.f; }
    const int t0 = qrow * 64 + 32 * qc;
    const bf16_t* Qw = F.SEAM + SE_QA + (((size_t)b * 4 + h) * S + t0) * 64;
    const size_t kvo = ((size_t)b * 4 + h) * KV * 64;
    att::attn_unit<2>((LAS char*)F.lds, Qw, F.SEAM + SE_KA + kvo, F.SEAM + SE_VA + kvo, 4 + (rmax - rmin + 1), F.Y + (size_t)(b * S + t0) * D + h * 64, 0.f, 0.f, nullptr, rmin, qrow, qc);
}
__device__ __forceinline__ void nactx_unit_fast(Frame& F, int v) {
    const int b = v >> 2, h = v & 3, t0 = F.wave * 32;
    const size_t kvo = ((size_t)b * 4 + h) * KV * 64;
    att::attn_unit<0>((LAS char*)F.lds, F.SEAM + SE_QAC + (((size_t)b * 4 + h) * LC + t0) * 64, F.SEAM + SE_KA + kvo, F.SEAM + SE_VA + kvo, LC / 64, F.Y + (size_t)(ROWS_L + b * LC + t0) * D + h * 64, 0.f, 0.f, nullptr);
}
__device__ __forceinline__ void phase_attn_fast(Frame& F, int l, bool with_ctx) {
    const int v = vcu_of(F);
    if (FAST_NA_LAT) {
#pragma unroll 1
        for (int u = v; u < 256; u += F.G) na_unit_fast(F, l, u); }
    if (with_ctx && FAST_NA_CTX) {
#pragma unroll 1
        for (int u = v - 16; u >= 0 && u < 8; u += F.G) nactx_unit_fast(F, u);
    }
#pragma unroll 1
    for (int u = v; u < 256; u += F.G) gqa_unit_fast(F, u, false);
#pragma unroll 1
    for (int u = v; u < 256; u += F.G) diff_unit_fast(F, l, u, false);
    if (with_ctx) {
#pragma unroll 1
        for (int u = v; u < 8; u += F.G) gqa_unit_fast(F, u, true);
#pragma unroll 1
        for (int u = F.G - 1 - v; u < 8; u += F.G) diff_unit_fast(F, l, u, true);
    }
}

#ifndef PHMASK
#define PHMASK 0xffffffffu
#endif
#define REFRESH() do { asm volatile("" : "+v"(F.tid)); F.lane = F.tid & 63; F.wave = __builtin_amdgcn_readfirstlane(F.tid >> 6); } while (0)
#define PHX(i, call) do { if ((PHMASK >> (i)) & 1u) { REFRESH(); call; } } while (0)
constexpr int PH_PER_LAYER = 9;
constexpr int NPH = 1 + DEPTH * PH_PER_LAYER + 1;

__global__ void __launch_bounds__(NTHR, 2) mk_fwd(Args args) {
    extern __shared__ __attribute__((aligned(16))) unsigned char lds[];
    Frame F;
    F.lds = (LAS unsigned char*)lds;
    F.tid = threadIdx.x; F.lane = F.tid & 63; F.wave = __builtin_amdgcn_readfirstlane(F.tid >> 6);
    F.G = gridDim.x; F.bid = blockIdx.x;
    F.in = args.in; F.out = args.out; F.ws = args.ws;
    unsigned char* ws = args.ws;
    F.tab = (float*)(ws + WS_TAB); F.H = (float*)(ws + WS_H); F.U = (bf16_t*)(ws + WS_U); F.AFF = (float*)(ws + WS_AFF); F.SLOT = (int*)(ws + WS_SLOT);
    F.RIDX = (int*)(ws + WS_RIDX); F.GATE = (float*)(ws + WS_RIDX + 256 * 1024);
    F.SEAM = (bf16_t*)(ws + WS_SEAM); F.Y = (bf16_t*)(ws + WS_Y); F.HE = (bf16_t*)(ws + WS_HE); F.YE = (bf16_t*)(ws + WS_YE); F.P = (float*)(ws + WS_P);
    for (int u = F.tid; u < (LDS_BYTES - LDSCTL_OFF) / 4; u += NTHR) ((LAS unsigned*)(F.lds + LDSCTL_OFF))[u] = 0u;
    __syncthreads();
    XcdBarrier bar; bar.bar = (unsigned*)(ws + WS_CTL) + CW_BAR; bar.x = 0; bar.st = nullptr;
    const bool one = (MK_N_LAUNCHES == 1);
    if (one) bar = xcd_barrier_post((unsigned*)(ws + WS_CTL) + CW_BAR, (volatile LAS unsigned*)(F.lds + MISC_OFF) + 8);
    const int lo = args.ph_lo, hi = args.ph_hi;
#define IN(k) (lo <= (k) && (k) < hi)
#define SEAM_BAR(k) do { if (one && (k) + 1 < hi) xcd_barrier(bar); } while (0)
    if (IN(0)) { PHX(0, phase_prologue(F)); REFRESH(); phase_convert(F); SEAM_BAR(0); }
#pragma unroll 1
    for (int l = 0; l < DEPTH; ++l) {
        const int pb = 1 + l * PH_PER_LAYER; const bool wc = (l < DEPTH - 1);
        if (IN(pb + 0)) { REFRESH(); if (l == 0) phase_norm<0>(F, 0, true, -1, true); else phase_norm<0>(F, l, false, l - 1, true); SEAM_BAR(pb + 0); }
        if (IN(pb + 1)) { if (FAST_INPROJ) { REFRESH(); phase_inproj_fast(F, l); } else { PHX(1, phase_inproj_naive(F, l)); } SEAM_BAR(pb + 1); }
        if (IN(pb + 2)) { if (!FAST_INPROJ) { PHX(2, phase_post_naive(F, l)); SEAM_BAR(pb + 2); } }
        if (IN(pb + 3)) { if (FAST_ATTN) { REFRESH(); phase_attn_fast(F, l, wc); } PHX(3, phase_mixers_naive(F, l, wc)); SEAM_BAR(pb + 3); }
        if (IN(pb + 4)) { if (FAST_OUTPROJ) { REFRESH(); phase_outproj_fast(F, l, wc); } else { PHX(4, phase_outproj_naive(F, l, wc)); } SEAM_BAR(pb + 4); }
        if (IN(pb + 5)) { PHX(5, phase_norm2_router(F, l, wc)); SEAM_BAR(pb + 5); }
        if (IN(pb + 6)) { PHX(6, phase_select_naive(F, wc)); SEAM_BAR(pb + 6); }
        if (IN(pb + 7)) { if (FAST_MOE) { REFRESH(); phase_moe1_fast(F, l, wc); } else { PHX(7, phase_moe1_naive(F, l, wc)); } SEAM_BAR(pb + 7); }
        if (IN(pb + 8)) { if (FAST_MOE) { REFRESH(); phase_moe2_fast(F, l, wc); } else { PHX(8, phase_moe2_naive(F, l, wc)); } SEAM_BAR(pb + 8); }
    }
    if (IN(NPH - 1)) { REFRESH(); phase_norm<2>(F, 0, false, DEPTH - 1, false); }
#undef IN
#undef SEAM_BAR
}

extern "C" void kernel_launch(void* const* d_in, const int* in_sizes, int n_in, void* d_out, int out_size, void* d_ws, size_t ws_size, hipStream_t stream) {
    static int grid = 0;
    if (grid == 0) {
        if (n_in != N_IN || out_size != ROWS_L * D || ws_size < WS_END) { fprintf(stderr, "kernel_launch: unexpected shapes (n_in %d out %d ws %zu)\n", n_in, out_size, ws_size); grid = -1; return; }
        int dev = 0, cus = 0, per_cu = 0;
        if (hipGetDevice(&dev) != hipSuccess || hipDeviceGetAttribute(&cus, hipDeviceAttributeMultiprocessorCount, dev) != hipSuccess) { grid = -1; return; }
        if (hipFuncSetAttribute((const void*)mk_fwd, hipFuncAttributeMaxDynamicSharedMemorySize, LDS_BYTES) != hipSuccess) { fprintf(stderr, "kernel_launch: hipFuncSetAttribute failed\n"); grid = -1; return; }
        if (hipOccupancyMaxActiveBlocksPerMultiprocessor(&per_cu, (const void*)mk_fwd, NTHR, LDS_BYTES) != hipSuccess || per_cu < 1) { fprintf(stderr, "kernel_launch: occupancy query says %d\n", per_cu); per_cu = 1; }
        (void)hipGetLastError();
        grid = cus;
    }
    if (grid < 0) return;
    (void)hipMemsetAsync((char*)d_ws + WS_CTL, 0, CTL_ZERO_BYTES, stream);
    Args a{};
    for (int i = 0; i < N_IN; ++i) a.in[i] = (const float*)d_in[i];
    a.out = (float*)d_out; a.ws = (unsigned char*)d_ws;
    if (MK_N_LAUNCHES == 1) { a.ph_lo = 0; a.ph_hi = NPH; hipLaunchKernelGGL(mk_fwd, dim3(grid), dim3(NTHR), LDS_BYTES, stream, a); }
    else for (int p = 0; p < NPH; ++p) { a.ph_lo = p; a.ph_hi = p + 1; hipLaunchKernelGGL(mk_fwd, dim3(grid), dim3(NTHR), LDS_BYTES, stream, a); }
}
```

```cpp
#include <hip/hip_runtime.h>
#include <cstdio>
#include <cstdint>

#ifndef FAST_CONV
#define FAST_CONV 1
#endif
#ifndef MK_N_LAUNCHES
#define MK_N_LAUNCHES 1
#endif

constexpr int D = 1024, NB = 2, S = 8192, LC = 256, DEPTH = 2;
constexpr int ROWS_L = NB * S;
constexpr int ROWS_C = NB * LC;
constexpr int ROWS = ROWS_L + ROWS_C;
constexpr int KV = LC + S;
constexpr int DIN = 2560;
constexpr int NE = 16, CAP_L = 1024, CAP_C = 32;
constexpr int ESLOTS = 2 * CAP_L + 2 * CAP_C;
constexpr int EPAD = 2304;
constexpr float EPS = 1e-6f;
constexpr float LOG2E = 1.4426950408889634f;
constexpr int NWAVES = 8, NTHR = 512;

typedef unsigned short bf16_t;
typedef unsigned u32x4 __attribute__((ext_vector_type(4)));
typedef unsigned u32x2 __attribute__((ext_vector_type(2)));
typedef float f32x4 __attribute__((ext_vector_type(4)));

constexpr size_t MiB = 1u << 20;
constexpr size_t WS_CTL = 0;
constexpr size_t CTL_ZERO_BYTES = 64 * 1024;
constexpr size_t WS_TAB = 1 * MiB;
constexpr size_t WS_H = 2 * MiB;
constexpr size_t WS_U = 68 * MiB;
constexpr size_t WS_AFF = 101 * MiB;
constexpr size_t WS_SLOT = 103 * MiB;
constexpr size_t WS_RIDX = 105 * MiB;
constexpr size_t WS_WBF = 106 * MiB;
constexpr size_t WS_R = 314 * MiB;
constexpr size_t WS_END = 458 * MiB;
constexpr size_t WS_P = WS_WBF;
constexpr size_t WS_SEAM = WS_R;
constexpr size_t WS_Y = WS_R + 83 * MiB;
constexpr size_t WS_HE = WS_R;
constexpr size_t WS_YE = WS_R + 72 * MiB;

constexpr size_t SE_QA = 0;
constexpr size_t SE_QAC = SE_QA + (size_t)NB * 4 * S * 64;
constexpr size_t SE_KA = SE_QAC + (size_t)NB * 4 * LC * 64;
constexpr size_t SE_VA = SE_KA + (size_t)NB * 4 * KV * 64;
constexpr size_t SE_Z = SE_VA + (size_t)NB * 4 * KV * 64;
constexpr size_t SE_QG = SE_Z + (size_t)ROWS * 256;
constexpr size_t SE_QGC = SE_QG + (size_t)NB * 4 * S * 64;
constexpr size_t SE_KG = SE_QGC + (size_t)NB * 4 * LC * 64;
constexpr size_t SE_VG = SE_KG + (size_t)NB * 2 * KV * 64;
constexpr size_t SE_QD = SE_VG + (size_t)NB * 2 * KV * 64;
constexpr size_t SE_QDC = SE_QD + (size_t)NB * 4 * S * 64;
constexpr size_t SE_KD = SE_QDC + (size_t)NB * 4 * LC * 64;
constexpr size_t SE_VD = SE_KD + (size_t)NB * 4 * KV * 64;
constexpr size_t SE_END = SE_VD + (size_t)NB * 4 * KV * 64;
static_assert(SE_END == (size_t)ROWS * (DIN - 256), "seam map");
static_assert(SE_END * 2 <= 83 * MiB, "seam fits");

constexpr int TB_C64 = 0;
constexpr int TB_S64 = 2048;
constexpr int TB_C32 = 4096;
constexpr int TB_S32 = 5120;
constexpr int TB_MOD = 8192;
constexpr int TB_LAM = TB_MOD + DEPTH * 3 * 6144;
constexpr int TB_BP_ = TB_LAM + 2 * DEPTH;

constexpr int CW_BAR = 1024;

enum { I_X = 0, I_C, I_CTX, I_CCTX, I_N1G, I_WMOD, I_BMOD, I_WIN, I_RPB, I_DWW, I_DWB, I_LNG, I_LNB, I_PWW, I_PWB,
       I_QNG, I_KNG, I_LQ1, I_LK1, I_LQ2, I_LK2, I_DNG, I_WOUT, I_N2G, I_WR, I_WG, I_WU, I_WD, I_FG, N_IN };

constexpr int LDS_BYTES = 147456;
constexpr int MISC_OFF = 131072 + 320;
constexpr int LDSCTL_OFF = 131072;

#define GAS __attribute__((address_space(1)))
#define LAS __attribute__((address_space(3)))

__device__ __forceinline__ float bf2f(bf16_t v) { return __uint_as_float((unsigned)v << 16); }
__device__ __forceinline__ unsigned f2bf(float f) { unsigned u = __float_as_uint(f); return (u + 0x7fffu + ((u >> 16) & 1u)) >> 16; }
__device__ __forceinline__ unsigned pk2(float lo, float hi) { return f2bf(lo) | (f2bf(hi) << 16); }
__device__ __forceinline__ float bflo(unsigned w) { return __uint_as_float(w << 16); }
__device__ __forceinline__ float bfhi(unsigned w) { return __uint_as_float(w & 0xffff0000u); }
__device__ __forceinline__ float wave_sum(float v) {
#pragma unroll
    for (int o = 1; o < 64; o <<= 1) v += __shfl_xor(v, o);
    return v;
}
__device__ __forceinline__ float silu_f(float x) { return x / (1.f + __expf(-x)); }
__device__ __forceinline__ int vzero() { int z; asm volatile("v_mov_b32 %0, 0" : "=v"(z)); return z; }

#define XB_TMO      128
#define XB_XCNT(j)  (256  + 64 * (j))
#define XB_XSUB(j)  (1280 + 64 * (j))
#define XB_XGEN(j)  (2304 + 64 * (j))
#define XB_TOP      3328
#define XB_TOPGEN   3392
#define XCD_BAR_WORDS 3456
#define XB_SPIN_CAP (1u << 22)
__device__ __forceinline__ unsigned xb_ld(unsigned* p)              { return __hip_atomic_load(p, __ATOMIC_RELAXED, __HIP_MEMORY_SCOPE_AGENT); }
__device__ __forceinline__ unsigned xb_add(unsigned* p, unsigned v) { return __hip_atomic_fetch_add(p, v, __ATOMIC_RELAXED, __HIP_MEMORY_SCOPE_AGENT); }
__device__ __forceinline__ unsigned xb_xcc_id() { return (unsigned)__builtin_amdgcn_s_getreg((3 << 11) | 20) & 0xFu; }
#define XB_SPIN(cond, bar) do { unsigned _sp = 0; while (cond) { __builtin_amdgcn_s_sleep(1); \
    if ((++_sp & 255u) == 0u) { if (xb_ld(&(bar)[XB_TMO])) break; if (_sp > XB_SPIN_CAP) { atomicAdd(&(bar)[XB_TMO], 1u); break; } } } } while (0)
struct XcdBarrier { unsigned* bar; unsigned x; volatile LAS unsigned* st; };
__device__ __forceinline__ XcdBarrier xcd_barrier_post(unsigned* bar, volatile LAS unsigned* st) {
    XcdBarrier b; b.bar = bar; b.x = xb_xcc_id(); b.st = st;
    if (threadIdx.x == 0) (void)xb_add(&bar[XB_XCNT(b.x)], 1u);
    return b;
}
__device__ __forceinline__ void xcd_barrier_complete(unsigned* bar, unsigned x, unsigned& nloc, unsigned& nx) {
    const unsigned G = gridDim.x * gridDim.y * gridDim.z;
    unsigned sum, cnt, mine, sp = 0u;
    for (;;) {
        sum = 0u; cnt = 0u; mine = 0u;
#pragma unroll
        for (unsigned j = 0; j < 16; ++j) { const unsigned c = xb_ld(&bar[XB_XCNT(j)]); sum += c; cnt += (c > 0u) ? 1u : 0u; mine = (j == x) ? c : mine; }
        if (sum == G) break;
        __builtin_amdgcn_s_sleep(1);
        if ((++sp & 255u) == 0u) { if (xb_ld(&bar[XB_TMO])) break; if (sp > XB_SPIN_CAP) { atomicAdd(&bar[XB_TMO], 1u); break; } }
    }
    nloc = mine > 0u ? mine : 1u; nx = cnt > 0u ? cnt : 1u;
}
__device__ __forceinline__ void xcd_barrier(const XcdBarrier& b) {
    asm volatile("s_waitcnt vmcnt(0)" ::: "memory");
    __syncthreads();
    if (threadIdx.x == 0) {
        unsigned* bar = b.bar;
        __builtin_amdgcn_s_waitcnt(0);
        unsigned nloc = b.st[0], nx = b.st[1];
        if (nloc == 0u) { xcd_barrier_complete(bar, b.x, nloc, nx); b.st[0] = nloc; b.st[1] = nx; }
        const unsigned old = xb_add(&bar[XB_XSUB(b.x)], 1u);
        const unsigned gen = old / nloc;
        if (old + 1u == (gen + 1u) * nloc) {
            __builtin_amdgcn_fence(__ATOMIC_RELEASE, "agent");
            asm volatile("s_waitcnt vmcnt(0)" ::: "memory");
            const unsigned og = xb_add(&bar[XB_TOP], 1u);
            const unsigned tg = og / nx;
            if (og + 1u == (tg + 1u) * nx) xb_add(&bar[XB_TOPGEN], 1u);
            else XB_SPIN(xb_ld(&bar[XB_TOPGEN]) == tg, bar);
            __builtin_amdgcn_fence(__ATOMIC_ACQUIRE, "agent");
            xb_add(&bar[XB_XGEN(b.x)], 1u);
            asm volatile("s_waitcnt vmcnt(0)" ::: "memory");
        } else {
            XB_SPIN(xb_ld(&bar[XB_XGEN(b.x)]) == gen, bar);
            __builtin_amdgcn_fence(__ATOMIC_ACQUIRE, "agent");
            asm volatile("s_waitcnt vmcnt(0)" ::: "memory");
        }
    }
    __syncthreads();
}

struct Args { const float* in[N_IN]; float* out; unsigned char* ws; int ph_lo, ph_hi; };
struct Frame {
    LAS unsigned char* lds;
    int tid, lane, wave, G, bid;
    const float* const* in;
    float* out; unsigned char* ws;
    float* tab; float* H; bf16_t* U; float* AFF; int* SLOT; int* RIDX; float* GATE;
    bf16_t* SEAM; bf16_t* Y; bf16_t* HE; bf16_t* YE; float* P;
};

__device__ __forceinline__ double inv_freq(int f, int nf) {
    const double r16 = 0.5623413251903491;
    const int steps = (nf == 16) ? f : 2 * f;
    double v = 1.0;
    for (int i = 0; i < steps; ++i) v *= r16;
    return v;
}
__device__ __forceinline__ void sincos_d(double x, double& s, double& c) {
    const double TWO_PI = 6.283185307179586476925286766559;
    const double k = __builtin_rint(x / TWO_PI);
    const double r = x - k * TWO_PI;
    const double r2 = r * r;
    double ts = 1.0, tc = 1.0, ss = 1.0, cs = 1.0;
#pragma unroll 1
    for (int n = 1; n <= 14; ++n) {
        tc *= -r2 / (double)((2 * n - 1) * (2 * n));
        ts *= -r2 / (double)((2 * n) * (2 * n + 1));
        cs += tc; ss += ts;
    }
    s = r * ss; c = cs;
}

__device__ __forceinline__ void phase_prologue(Frame& F) {
    const int gt = F.bid * NTHR + F.tid, NGT = F.G * NTHR;
    for (int i = gt; i < 128 * 16 + 128 * 8; i += NGT) {
        if (i < 2048) { const int pos = i >> 4, f = i & 15; double s, c; sincos_d((double)pos * inv_freq(f, 16), s, c); F.tab[TB_C64 + i] = (float)c; F.tab[TB_S64 + i] = (float)s; }
        else { const int j = i - 2048, pos = j >> 3, f = j & 7; double s, c; sincos_d((double)pos * inv_freq(f, 8), s, c); F.tab[TB_C32 + j] = (float)c; F.tab[TB_S32 + j] = (float)s; }
    }
    if (gt < DEPTH) {
        const int l = gt; float a = 0.f, b = 0.f;
        for (int i = 0; i < 32; ++i) { a += F.in[I_LQ1][l * 32 + i] * F.in[I_LK1][l * 32 + i]; b += F.in[I_LQ2][l * 32 + i] * F.in[I_LK2][l * 32 + i]; }
        const float lam_init = 0.8f - 0.6f * expf(-0.3f * (float)l);
        F.tab[TB_LAM + 2 * l] = expf(a) - expf(b) + lam_init; F.tab[TB_LAM + 2 * l + 1] = 1.f - lam_init;
    }
    LAS float* red = (LAS float*)F.lds;
    for (int u = F.bid; u < DEPTH * 96; u += F.G) {
        const int l = u / 96, n0 = (u % 96) * 64, ks = F.tid >> 6, nn = F.tid & 63;
        const float* W = F.in[I_WMOD] + (size_t)l * D * 6144 + n0 + nn;
        float a0 = 0.f, a1 = 0.f, a2 = 0.f;
        for (int k = ks * 128; k < ks * 128 + 128; ++k) {
            const float w = W[(size_t)k * 6144];
            a0 += silu_f(F.in[I_C][k]) * w; a1 += silu_f(F.in[I_C][D + k]) * w; a2 += silu_f(F.in[I_CCTX][k]) * w;
        }
        red[(ks * 3 + 0) * 64 + nn] = a0; red[(ks * 3 + 1) * 64 + nn] = a1; red[(ks * 3 + 2) * 64 + nn] = a2;
        __syncthreads();
        if (F.tid < 192) { const int v = F.tid >> 6; float s = 0.f;
            for (int q = 0; q < 8; ++q) s += red[(q * 3 + v) * 64 + nn];
            F.tab[TB_MOD + (l * 3 + v) * 6144 + n0 + nn] = s + F.in[I_BMOD][l * 6144 + n0 + nn]; }
        __syncthreads();
    }
}

template <int MODE> __device__ __forceinline__ void phase_norm(Frame& F, int l, bool src0, int comb_l, bool with_ctx) {
    const int gw = F.bid * NWAVES + F.wave, NGW = F.G * NWAVES;
    const int nrows = with_ctx ? ROWS : ROWS_L;
    for (int r = gw; r < nrows; r += NGW) {
        const bool isc = r >= ROWS_L; const int b = isc ? (r - ROWS_L) / LC : r / S; const int mv = isc ? 2 : b;
        const float* src = src0 ? (isc ? F.in[I_CTX] + (size_t)(r - ROWS_L) * D : F.in[I_X] + (size_t)r * D) : F.H + (size_t)r * D;
        f32x4 v[4];
#pragma unroll
        for (int j = 0; j < 4; ++j) v[j] = *(const f32x4*)(src + 4 * F.lane + 256 * j);
        if (comb_l >= 0) {
            const float* g2 = F.tab + TB_MOD + (comb_l * 3 + mv) * 6144 + 5 * D;
            const int* sl = F.SLOT + (size_t)r * 16;
            f32x4 acc[4];
#pragma unroll
            for (int j = 0; j < 4; ++j) acc[j] = (f32x4){0.f, 0.f, 0.f, 0.f};
            for (int e = 0; e < NE; ++e) {
                const int s_ = sl[e];
                if (s_ >= 0) {
                    const int base = isc ? 2 * CAP_L + b * CAP_C : b * CAP_L;
                    const bf16_t* y = F.YE + ((size_t)e * EPAD + base + s_) * D;
#pragma unroll
                    for (int j = 0; j < 4; ++j) { const uint2 w = *(const uint2*)(y + 4 * F.lane + 256 * j);
                        acc[j][0] += bflo(w.x); acc[j][1] += bfhi(w.x); acc[j][2] += bflo(w.y); acc[j][3] += bfhi(w.y); }
                }
            }
#pragma unroll
            for (int j = 0; j < 4; ++j) { const f32x4 g = *(const f32x4*)(g2 + 4 * F.lane + 256 * j); v[j] += g * acc[j]; *(f32x4*)(F.H + (size_t)r * D + 4 * F.lane + 256 * j) = v[j]; }
        }
        float ss = 0.f;
#pragma unroll
        for (int j = 0; j < 4; ++j) ss += (v[j][0] * v[j][0] + v[j][1] * v[j][1]) + (v[j][2] * v[j][2] + v[j][3] * v[j][3]);
        const float rs = 1.f / sqrtf(wave_sum(ss) * (1.f / D) + EPS);
        if (MODE == 2) {
#pragma unroll
            for (int j = 0; j < 4; ++j) { const f32x4 g = *(const f32x4*)(F.in[I_FG] + 4 * F.lane + 256 * j); *(f32x4*)(F.out + (size_t)r * D + 4 * F.lane + 256 * j) = v[j] * rs * g; }
        } else {
            const float* md = F.tab + TB_MOD + (l * 3 + mv) * 6144;
            const float* ng = F.in[I_N1G] + l * D;
#pragma unroll
            for (int j = 0; j < 4; ++j) { const int c0 = 4 * F.lane + 256 * j; const f32x4 g = *(const f32x4*)(ng + c0), sh = *(const f32x4*)(md + c0), sc = *(const f32x4*)(md + D + c0);
                const f32x4 u = (v[j] * rs * g) * (1.f + sc) + sh; uint2 w; w.x = pk2(u[0], u[1]); w.y = pk2(u[2], u[3]); *(uint2*)(F.U + (size_t)r * D + c0) = w; }
        }
    }
}

__device__ __forceinline__ void phase_norm2_router(Frame& F, int l, bool with_ctx) {
    LAS float* wr = (LAS float*)F.lds;
    for (int i = F.tid; i < D * NE; i += NTHR) wr[i] = F.in[I_WR][(size_t)l * D * NE + i];
    __syncthreads();
    const int gw = F.bid * NWAVES + F.wave, NGW = F.G * NWAVES;
    const int nrows = with_ctx ? ROWS : ROWS_L;
    for (int r = gw; r < nrows; r += NGW) {
        const bool isc = r >= ROWS_L; const int b = isc ? (r - ROWS_L) / LC : r / S; const int mv = isc ? 2 : b;
        const float* src = F.H + (size_t)r * D;
        const float* md = F.tab + TB_MOD + (l * 3 + mv) * 6144;
        const float* ng = F.in[I_N2G] + l * D;
        f32x4 v[4]; float ss = 0.f;
#pragma unroll
        for (int j = 0; j < 4; ++j) { v[j] = *(const f32x4*)(src + 4 * F.lane + 256 * j); ss += (v[j][0] * v[j][0] + v[j][1] * v[j][1]) + (v[j][2] * v[j][2] + v[j][3] * v[j][3]); }
        const float rs = 1.f / sqrtf(wave_sum(ss) * (1.f / D) + EPS);
        float lg[NE];
#pragma unroll
        for (int e = 0; e < NE; ++e) lg[e] = 0.f;
#pragma unroll
        for (int j = 0; j < 4; ++j) { const int c0 = 4 * F.lane + 256 * j; const f32x4 g = *(const f32x4*)(ng + c0), sh = *(const f32x4*)(md + 3 * D + c0), sc = *(const f32x4*)(md + 4 * D + c0);
            const f32x4 u = (v[j] * rs * g) * (1.f + sc) + sh; uint2 w; w.x = pk2(u[0], u[1]); w.y = pk2(u[2], u[3]); *(uint2*)(F.U + (size_t)r * D + c0) = w;
#pragma unroll
            for (int i = 0; i < 4; ++i) {
#pragma unroll
                for (int e4 = 0; e4 < 4; ++e4) { const f32x4 ww = *(const LAS f32x4*)(wr + (c0 + i) * NE + 4 * e4);
                    lg[4 * e4 + 0] += u[i] * ww[0]; lg[4 * e4 + 1] += u[i] * ww[1]; lg[4 * e4 + 2] += u[i] * ww[2]; lg[4 * e4 + 3] += u[i] * ww[3]; }
                asm volatile("" ::: "memory");
            }
        }
        float mx = -1e30f;
#pragma unroll
        for (int e = 0; e < NE; ++e) { lg[e] = wave_sum(lg[e]); mx = fmaxf(mx, lg[e]); }
        float sm = 0.f;
#pragma unroll
        for (int e = 0; e < NE; ++e) { lg[e] = expf(lg[e] - mx); sm += lg[e]; }
        const float inv = 1.f / sm;
        float mine = 0.f;
#pragma unroll
        for (int e = 0; e < NE; ++e) mine = (F.lane == e) ? lg[e] * inv : mine;
        if (F.lane < NE) F.AFF[(size_t)r * NE + F.lane] = mine;
    }
    __syncthreads();
}

__device__ __forceinline__ void phase_select_naive(Frame& F, bool with_ctx) {
    LAS float* col = (LAS float*)F.lds;
    const int NU = 32 * 16 + (with_ctx ? 32 : 0);
    for (int i = F.bid * NTHR + F.tid; i < NE * EPAD; i += F.G * NTHR) { const int sl = i % EPAD; if (sl >= (with_ctx ? ESLOTS : 2 * CAP_L)) { F.RIDX[i] = -1; F.GATE[i] = 0.f; } }
    for (int u = F.bid; u < NU; u += F.G) {
        const bool isc = u >= 512; const int li = isc ? u - 512 : u / 16, ch = isc ? 0 : u % 16, b = li / NE, e = li % NE;
        const int N = isc ? LC : S, C = isc ? CAP_C : CAP_L, row0 = isc ? ROWS_L + b * LC : b * S;
        __syncthreads();
        for (int i = F.tid; i < N; i += NTHR) col[i] = F.AFF[(size_t)(row0 + i) * NE + e];
        __syncthreads();
        const int n = ch * 512 + F.tid;
        if (n < N) {
            const float a = col[n]; int rank = 0;
            for (int m = 0; m < N; ++m) { const float x = col[m]; rank += (x > a || (x == a && m < n)) ? 1 : 0; }
            if (rank < C) { const int sl = (isc ? 2 * CAP_L + b * CAP_C : b * CAP_L) + rank; F.RIDX[e * EPAD + sl] = row0 + n; F.GATE[e * EPAD + sl] = a; F.SLOT[(size_t)(row0 + n) * NE + e] = rank; }
            else F.SLOT[(size_t)(row0 + n) * NE + e] = -1;
        }
    }
    __syncthreads();
}

struct NaiveEpi { int mode; int l; float* P; const float* hin; float* hout; const float* mod; bf16_t* HE; bf16_t* YE; const float* gate; };
template <bool DUAL> __device__ __forceinline__ void naive_gemm_tile(Frame& F, const bf16_t* A, int lda, const int* ridx, int m0, int M, const float* W, const float* W2, int ldw, int n0, int K, const NaiveEpi& E, int erow0) {
    LAS float* As = (LAS float*)F.lds;
    LAS float* Bs = As + 16 * 132;
    LAS float* Bs2 = Bs + 16 * 64;
    const int ty = F.tid >> 4, tx = F.tid & 15;
    float acc[4][4], acc2[4][4];
#pragma unroll
    for (int i = 0; i < 4; ++i)
#pragma unroll
        for (int j = 0; j < 4; ++j) { acc[i][j] = 0.f; acc2[i][j] = 0.f; }
    const int ar = F.tid >> 1, ah = F.tid & 1;
    long arow = -1;
    if (F.tid < 256) { const int m = m0 + ar; if (m < M) arow = ridx ? (long)ridx[m] : (long)m; }
    const int bk = (F.tid - 256) >> 4, bc = (F.tid - 256) & 15;
    for (int k0 = 0; k0 < K; k0 += 16) {
        __syncthreads();
        if (F.tid < 256) {
            u32x4 w = (u32x4){0u, 0u, 0u, 0u};
            if (arow >= 0) w = *(const u32x4*)(A + (size_t)arow * lda + k0 + ah * 8);
            const int kb = ah * 8;
            As[(kb + 0) * 132 + ar] = bflo(w.x); As[(kb + 1) * 132 + ar] = bfhi(w.x); As[(kb + 2) * 132 + ar] = bflo(w.y); As[(kb + 3) * 132 + ar] = bfhi(w.y);
            As[(kb + 4) * 132 + ar] = bflo(w.z); As[(kb + 5) * 132 + ar] = bfhi(w.z); As[(kb + 6) * 132 + ar] = bflo(w.w); As[(kb + 7) * 132 + ar] = bfhi(w.w);
        } else {
            *(LAS f32x4*)(Bs + bk * 64 + bc * 4) = *(const f32x4*)(W + (size_t)(k0 + bk) * ldw + n0 + bc * 4);
            if (DUAL) *(LAS f32x4*)(Bs2 + bk * 64 + bc * 4) = *(const f32x4*)(W2 + (size_t)(k0 + bk) * ldw + n0 + bc * 4);
        }
        __syncthreads();
#pragma unroll
        for (int k = 0; k < 16; ++k) {
            const f32x4 a = *(const LAS f32x4*)(As + k * 132 + ty * 4), b = *(const LAS f32x4*)(Bs + k * 64 + tx * 4);
#pragma unroll
            for (int i = 0; i < 4; ++i)
#pragma unroll
                for (int j = 0; j < 4; ++j) acc[i][j] += a[i] * b[j];
            if (DUAL) { const f32x4 b2 = *(const LAS f32x4*)(Bs2 + k * 64 + tx * 4);
#pragma unroll
                for (int i = 0; i < 4; ++i)
#pragma unroll
                    for (int j = 0; j < 4; ++j) acc2[i][j] += a[i] * b2[j]; }
        }
    }
#pragma unroll
    for (int i = 0; i < 4; ++i) {
        const int m = m0 + ty * 4 + i; if (m >= M) continue;
        const int c0 = n0 + tx * 4;
        if (E.mode == 0) { *(f32x4*)(E.P + (size_t)m * DIN + c0) = (f32x4){acc[i][0], acc[i][1], acc[i][2], acc[i][3]}; }
        else if (E.mode == 1) {
            const bool isc = m >= ROWS_L; const int b = isc ? (m - ROWS_L) / LC : m / S; const int mv = isc ? 2 : b;
            const f32x4 g = *(const f32x4*)(E.mod + (E.l * 3 + mv) * 6144 + 2 * D + c0);
            const float* hi_ = (E.hin == nullptr) ? (isc ? F.in[I_CTX] + (size_t)(m - ROWS_L) * D : F.in[I_X] + (size_t)m * D) : E.hin + (size_t)m * D;
            const f32x4 h = *(const f32x4*)(hi_ + c0);
            *(f32x4*)(E.hout + (size_t)m * D + c0) = h + g * (f32x4){acc[i][0], acc[i][1], acc[i][2], acc[i][3]};
        } else if (E.mode == 2) {
            uint2 w; w.x = pk2(silu_f(acc[i][0]) * acc2[i][0], silu_f(acc[i][1]) * acc2[i][1]); w.y = pk2(silu_f(acc[i][2]) * acc2[i][2], silu_f(acc[i][3]) * acc2[i][3]);
            *(uint2*)(E.HE + (size_t)(erow0 + m) * D + c0) = w;
        } else {
            const float g = E.gate[erow0 + m];
            uint2 w; w.x = pk2(g * acc[i][0], g * acc[i][1]); w.y = pk2(g * acc[i][2], g * acc[i][3]);
            *(uint2*)(E.YE + (size_t)(erow0 + m) * D + c0) = w;
        }
    }
}

__device__ __forceinline__ void phase_inproj_naive(Frame& F, int l) {
    NaiveEpi E{}; E.mode = 0; E.P = F.P;
    const int nM = ROWS / 128, nN = DIN / 64;
    for (int u = F.bid; u < nM * nN; u += F.G) { const int pm = u / nN, pn = u % nN;
        naive_gemm_tile<false>(F, F.U, D, nullptr, pm * 128, ROWS, F.in[I_WIN] + (size_t)l * D * DIN, nullptr, DIN, pn * 64, D, E, 0); }
    __syncthreads();
}
__device__ __forceinline__ void phase_outproj_naive(Frame& F, int l, bool with_ctx) {
    NaiveEpi E{}; E.mode = 1; E.l = l; E.hin = (l == 0) ? nullptr : F.H; E.hout = F.H; E.mod = F.tab + TB_MOD;
    const int M = with_ctx ? ROWS : ROWS_L; const int nM = M / 128, nN = D / 64;
    for (int u = F.bid; u < nM * nN; u += F.G) { const int pm = u / nN, pn = u % nN;
        naive_gemm_tile<false>(F, F.Y, D, nullptr, pm * 128, M, F.in[I_WOUT] + (size_t)l * D * D, nullptr, D, pn * 64, D, E, 0); }
    __syncthreads();
}
__device__ __forceinline__ void phase_moe1_naive(Frame& F, int l, bool with_ctx) {
    NaiveEpi E{}; E.mode = 2; E.HE = F.HE;
    const int M = with_ctx ? ESLOTS : 2 * CAP_L; const int nM = (M + 127) / 128, nN = D / 64;
    for (int u = F.bid; u < NE * nM * nN; u += F.G) { const int e = u / (nM * nN), r = u % (nM * nN), pm = r / nN, pn = r % nN;
        naive_gemm_tile<true>(F, F.U, D, F.RIDX + e * EPAD, pm * 128, M, F.in[I_WG] + ((size_t)l * NE + e) * D * D, F.in[I_WU] + ((size_t)l * NE + e) * D * D, D, pn * 64, D, E, e * EPAD); }
    __syncthreads();
}
__device__ __forceinline__ void phase_moe2_naive(Frame& F, int l, bool with_ctx) {
    NaiveEpi E{}; E.mode = 3; E.YE = F.YE; E.gate = F.GATE;
    const int M = with_ctx ? ESLOTS : 2 * CAP_L; const int nM = (M + 127) / 128, nN = D / 64;
    for (int u = F.bid; u < NE * nM * nN; u += F.G) { const int e = u / (nM * nN), r = u % (nM * nN), pm = r / nN, pn = r % nN;
        naive_gemm_tile<false>(F, F.HE + (size_t)e * EPAD * D, D, nullptr, pm * 128, M, F.in[I_WD] + ((size_t)l * NE + e) * D * D, nullptr, D, pn * 64, D, E, e * EPAD); }
    __syncthreads();
}

__device__ __forceinline__ void store64(bf16_t* dst, const float (&v)[64]) {
#pragma unroll
    for (int i = 0; i < 8; ++i) { u32x4 w; w.x = pk2(v[8 * i], v[8 * i + 1]); w.y = pk2(v[8 * i + 2], v[8 * i + 3]); w.z = pk2(v[8 * i + 4], v[8 * i + 5]); w.w = pk2(v[8 * i + 6], v[8 * i + 7]); *(u32x4*)(dst + 8 * i) = w; }
}
template <int DIM, int OFF> __device__ __forceinline__ void rope_vec(float (&v)[64], const float* tab, int t) {
    constexpr int half = DIM / 2, nf = half / 2;
    const int pr = t >> 6, pc = t & 63;
    const float* C = tab + (DIM == 64 ? TB_C64 : TB_C32); const float* Sn = tab + (DIM == 64 ? TB_S64 : TB_S32);
#pragma unroll
    for (int i = 0; i < half; ++i) {
        const int pos = (i < nf) ? pr : pc, f = (i < nf) ? i : i - nf;
        const float c = C[pos * nf + f], s = Sn[pos * nf + f];
        const float x1 = v[OFF + i], x2 = v[OFF + half + i];
        v[OFF + i] = x1 * c - x2 * s; v[OFF + half + i] = x2 * c + x1 * s;
    }
}
__device__ __forceinline__ void phase_post_naive(Frame& F, int l) {
    const long NT = (long)ROWS * 40;
    for (long it = (long)F.bid * NTHR + F.tid; it < NT; it += (long)F.G * NTHR) {
        const int r = (int)(it / 40), u = (int)(it % 40);
        if (u >= 16 && u < 20) continue;
        const bool isc = r >= ROWS_L; const int b = isc ? (r - ROWS_L) / LC : r / S; const int t = isc ? (r - ROWS_L) % LC : r % S;
        const int key = isc ? t : LC + t;
        const float* p = F.P + (size_t)r * DIN + 64 * u;
        float v[64];
#pragma unroll
        for (int i = 0; i < 16; ++i) { const f32x4 x = *(const f32x4*)(p + 4 * i); v[4 * i] = x[0]; v[4 * i + 1] = x[1]; v[4 * i + 2] = x[2]; v[4 * i + 3] = x[3]; }
        bf16_t* dst;
        if (u < 4) {
            const float sc = 0.125f * LOG2E;
#pragma unroll
            for (int i = 0; i < 64; ++i) v[i] *= sc;
            dst = isc ? F.SEAM + SE_QAC + (((size_t)b * 4 + u) * LC + t) * 64 : F.SEAM + SE_QA + (((size_t)b * 4 + u) * S + t) * 64;
        } else if (u < 8) { dst = F.SEAM + SE_KA + (((size_t)b * 4 + (u - 4)) * KV + key) * 64; }
        else if (u < 12) { dst = F.SEAM + SE_VA + (((size_t)b * 4 + (u - 8)) * KV + key) * 64; }
        else if (u < 16) {
            const float* pg = p + 256;
#pragma unroll
            for (int i = 0; i < 16; ++i) { const f32x4 g = *(const f32x4*)(pg + 4 * i);
                v[4 * i] *= 1.f / (1.f + __expf(-g[0])); v[4 * i + 1] *= 1.f / (1.f + __expf(-g[1])); v[4 * i + 2] *= 1.f / (1.f + __expf(-g[2])); v[4 * i + 3] *= 1.f / (1.f + __expf(-g[3])); }
            dst = F.SEAM + SE_Z + (size_t)r * 256 + 64 * (u - 12);
        } else if (u < 24) {
            const int hq = u - 20; const float* g = F.in[I_QNG] + l * 64; float ss = 0.f;
#pragma unroll
            for (int i = 0; i < 64; ++i) ss += v[i] * v[i];
            const float rs = 1.f / sqrtf(ss * (1.f / 64.f) + EPS);
#pragma unroll
            for (int i = 0; i < 64; ++i) v[i] = v[i] * rs * g[i];
            if (!isc) rope_vec<64, 0>(v, F.tab, t);
            const float sc = 0.125f * LOG2E;
#pragma unroll
            for (int i = 0; i < 64; ++i) v[i] *= sc;
            dst = isc ? F.SEAM + SE_QGC + (((size_t)b * 4 + hq) * LC + t) * 64 : F.SEAM + SE_QG + (((size_t)b * 4 + hq) * S + t) * 64;
        } else if (u < 26) {
            const int hk = u - 24; const float* g = F.in[I_KNG] + l * 64; float ss = 0.f;
#pragma unroll
            for (int i = 0; i < 64; ++i) ss += v[i] * v[i];
            const float rs = 1.f / sqrtf(ss * (1.f / 64.f) + EPS);
#pragma unroll
            for (int i = 0; i < 64; ++i) v[i] = v[i] * rs * g[i];
            if (!isc) rope_vec<64, 0>(v, F.tab, t);
            dst = F.SEAM + SE_KG + (((size_t)b * 2 + hk) * KV + key) * 64;
        } else if (u < 28) { dst = F.SEAM + SE_VG + (((size_t)b * 2 + (u - 26)) * KV + key) * 64; }
        else if (u < 32) {
            const int h = u - 28;
            if (!isc) { rope_vec<32, 0>(v, F.tab, t); rope_vec<32, 32>(v, F.tab, t); }
            const float sc = 0.17677669529663687f * LOG2E;
#pragma unroll
            for (int i = 0; i < 64; ++i) v[i] *= sc;
            dst = isc ? F.SEAM + SE_QDC + (((size_t)b * 4 + h) * LC + t) * 64 : F.SEAM + SE_QD + (((size_t)b * 4 + h) * S + t) * 64;
        } else if (u < 36) {
            const int h = u - 32;
            if (!isc) { rope_vec<32, 0>(v, F.tab, t); rope_vec<32, 32>(v, F.tab, t); }
            dst = F.SEAM + SE_KD + (((size_t)b * 4 + h) * KV + key) * 64;
        } else { dst = F.SEAM + SE_VD + (((size_t)b * 4 + (u - 36)) * KV + key) * 64; }
        store64(dst, v);
    }
}

__device__ __forceinline__ void load64(float (&v)[64], const bf16_t* p) {
#pragma unroll
    for (int i = 0; i < 8; ++i) { const u32x4 w = *(const u32x4*)(p + 8 * i);
        v[8 * i] = bflo(w.x); v[8 * i + 1] = bfhi(w.x); v[8 * i + 2] = bflo(w.y); v[8 * i + 3] = bfhi(w.y); v[8 * i + 4] = bflo(w.z); v[8 * i + 5] = bfhi(w.z); v[8 * i + 6] = bflo(w.w); v[8 * i + 7] = bfhi(w.w); }
}
struct Q64 { u32x4 w[8]; };
__device__ __forceinline__ void loadq(Q64& q, const bf16_t* p) {
#pragma unroll
    for (int i = 0; i < 8; ++i) q.w[i] = *(const u32x4*)(p + 8 * i);
}
__device__ __forceinline__ float dot8(u32x4 a, const u32x4 w, float s) {
    asm volatile("" : "+v"(a));
    s += bflo(a.x) * bflo(w.x); s += bfhi(a.x) * bfhi(w.x); s += bflo(a.y) * bflo(w.y); s += bfhi(a.y) * bfhi(w.y);
    s += bflo(a.z) * bflo(w.z); s += bfhi(a.z) * bfhi(w.z); s += bflo(a.w) * bflo(w.w); s += bfhi(a.w) * bfhi(w.w); return s;
}
__device__ __forceinline__ float dot64(const Q64& q, const bf16_t* k) {
    float s0 = 0.f, s1 = 0.f;
#pragma unroll
    for (int i = 0; i < 8; i += 2) { s0 = dot8(q.w[i], *(const u32x4*)(k + 8 * i), s0); s1 = dot8(q.w[i + 1], *(const u32x4*)(k + 8 * i + 8), s1); }
    return s0 + s1;
}
template <int OFF> __device__ __forceinline__ float dot32(const Q64& q, const bf16_t* k) {
    float s0 = 0.f, s1 = 0.f;
#pragma unroll
    for (int i = 0; i < 4; i += 2) { s0 = dot8(q.w[OFF / 8 + i], *(const u32x4*)(k + OFF + 8 * i), s0); s1 = dot8(q.w[OFF / 8 + i + 1], *(const u32x4*)(k + OFF + 8 * i + 8), s1); }
    return s0 + s1;
}
__device__ __forceinline__ void axpy64(float (&o)[64], float p, const bf16_t* vrow) {
#pragma unroll
    for (int i = 0; i < 8; ++i) { const u32x4 w = *(const u32x4*)(vrow + 8 * i);
        o[8 * i] += p * bflo(w.x); o[8 * i + 1] += p * bfhi(w.x); o[8 * i + 2] += p * bflo(w.y); o[8 * i + 3] += p * bfhi(w.y);
        o[8 * i + 4] += p * bflo(w.z); o[8 * i + 5] += p * bfhi(w.z); o[8 * i + 6] += p * bflo(w.w); o[8 * i + 7] += p * bfhi(w.w); }
}
#define OSM_STEP(m, lsum, o, s, vrow) do { if ((s) > (m)) { const float f_ = exp2f((m) - (s)); (lsum) *= f_; _Pragma("unroll") for (int i_ = 0; i_ < 64; ++i_) (o)[i_] *= f_; (m) = (s); } \
    const float p_ = exp2f((s) - (m)); (lsum) += p_; axpy64((o), p_, (vrow)); } while (0)

__device__ __forceinline__ void axpy32(float (&o)[32], float p, const bf16_t* vrow) {
#pragma unroll
    for (int i = 0; i < 4; ++i) { const u32x4 w = *(const u32x4*)(vrow + 8 * i);
        o[8 * i] += p * bflo(w.x); o[8 * i + 1] += p * bfhi(w.x); o[8 * i + 2] += p * bflo(w.y); o[8 * i + 3] += p * bfhi(w.y);
        o[8 * i + 4] += p * bflo(w.z); o[8 * i + 5] += p * bfhi(w.z); o[8 * i + 6] += p * bflo(w.w); o[8 * i + 7] += p * bfhi(w.w); }
}
#define OSM_STEP32(m, lsum, o, s, vrow) do { if ((s) > (m)) { const float f_ = exp2f((m) - (s)); (lsum) *= f_; _Pragma("unroll") for (int i_ = 0; i_ < 32; ++i_) (o)[i_] *= f_; (m) = (s); } \
    const float p_ = exp2f((s) - (m)); (lsum) += p_; axpy32((o), p_, (vrow)); } while (0)
__device__ __forceinline__ void naive_diff(Frame& F, int l, const bf16_t* qp, const bf16_t* K, const bf16_t* V, int nk, int dh, bf16_t* dst) {
    Q64 q; loadq(q, qp);
    float o1[32], o2[32]; float m1 = -1e30f, l1 = 0.f, m2 = -1e30f, l2 = 0.f;
#pragma unroll
    for (int i = 0; i < 32; ++i) { o1[i] = 0.f; o2[i] = 0.f; }
    const int z = vzero();
#pragma unroll 1
    for (int j = 0; j < nk; ++j) {
        const bf16_t* kr = K + (size_t)(j + z) * 64; const bf16_t* vr = V + (size_t)(j + z) * 64 + 32 * dh;
        const float s1 = dot32<0>(q, kr), s2 = dot32<32>(q, kr);
        OSM_STEP32(m1, l1, o1, s1, vr); OSM_STEP32(m2, l2, o2, s2, vr);
    }
    const float lam = F.tab[TB_LAM + 2 * l], oml = F.tab[TB_LAM + 2 * l + 1];
    const float i1 = 1.f / l1, i2 = lam / l2; float ss = 0.f;
#pragma unroll
    for (int i = 0; i < 32; ++i) { o1[i] = o1[i] * i1 - o2[i] * i2; ss += o1[i] * o1[i]; }
    ss += __shfl_xor(ss, 1);
    const float rs = oml / sqrtf(ss * (1.f / 64.f) + EPS);
    const float* g = F.in[I_DNG] + l * 64 + 32 * dh;
#pragma unroll
    for (int i = 0; i < 4; ++i) { u32x4 w; w.x = pk2(o1[8 * i] * rs * g[8 * i], o1[8 * i + 1] * rs * g[8 * i + 1]); w.y = pk2(o1[8 * i + 2] * rs * g[8 * i + 2], o1[8 * i + 3] * rs * g[8 * i + 3]);
        w.z = pk2(o1[8 * i + 4] * rs * g[8 * i + 4], o1[8 * i + 5] * rs * g[8 * i + 5]); w.w = pk2(o1[8 * i + 6] * rs * g[8 * i + 6], o1[8 * i + 7] * rs * g[8 * i + 7]); *(u32x4*)(dst + 8 * i) = w; }
}
__device__ __forceinline__ void store32n(bf16_t* dst, const float (&o)[32], float inv) {
#pragma unroll
    for (int i = 0; i < 4; ++i) { u32x4 w; w.x = pk2(o[8 * i] * inv, o[8 * i + 1] * inv); w.y = pk2(o[8 * i + 2] * inv, o[8 * i + 3] * inv);
        w.z = pk2(o[8 * i + 4] * inv, o[8 * i + 5] * inv); w.w = pk2(o[8 * i + 6] * inv, o[8 * i + 7] * inv); *(u32x4*)(dst + 8 * i) = w; }
}
__device__ __forceinline__ void naive_attn(const bf16_t* qp, const bf16_t* K, const bf16_t* V, int nk, int dh, bf16_t* dst) {
    Q64 q; loadq(q, qp);
    float o[32]; float m = -1e30f, ls = 0.f;
#pragma unroll
    for (int i = 0; i < 32; ++i) o[i] = 0.f;
    const int z = vzero();
#pragma unroll 1
    for (int j = 0; j < nk; ++j) { const float s = dot64(q, K + (size_t)(j + z) * 64); OSM_STEP32(m, ls, o, s, V + (size_t)(j + z) * 64 + 32 * dh); }
    store32n(dst, o, 1.f / ls);
}
__device__ __forceinline__ void naive_na(Frame& F, int l, int b, int h, int t, int dh, bf16_t* dst) {
    Q64 q; loadq(q, F.SEAM + SE_QA + (((size_t)b * 4 + h) * S + t) * 64);
    const bf16_t* K = F.SEAM + SE_KA + ((size_t)b * 4 + h) * KV * 64; const bf16_t* V = F.SEAM + SE_VA + ((size_t)b * 4 + h) * KV * 64 + 32 * dh;
    const float* rpb = F.in[I_RPB] + ((size_t)l * 4 + h) * 15 * 31;
    const int r = t >> 6, jq = t & 63;
    int rs = r - 4; rs = rs < 0 ? 0 : (rs > 120 ? 120 : rs);
    int cs = jq - 8; cs = cs < 0 ? 0 : (cs > 48 ? 48 : cs);
    float o[32]; float m = -1e30f, ls = 0.f;
#pragma unroll
    for (int i = 0; i < 32; ++i) o[i] = 0.f;
#pragma unroll 1
    for (int kk = 0; kk < 128 + LC; ++kk) {
        int key; float bias = 0.f;
        if (kk < 128) { const int rr = rs + (kk >> 4), cc = cs + (kk & 15); key = LC + rr * 64 + cc;
            const int dr = rr - r + 7; int dc = cc - jq; dc = dc < -15 ? -15 : (dc > 15 ? 15 : dc); dc += 15; bias = rpb[dr * 31 + dc] * LOG2E; }
        else key = kk - 128;
        const float s = dot64(q, K + (size_t)key * 64) + bias;
        OSM_STEP32(m, ls, o, s, V + (size_t)key * 64);
    }
    store32n(dst, o, 1.f / ls);
}
__device__ __forceinline__ void phase_conv_naive(Frame& F, int l, int unit, bool ctxu) {
    LAS float* zc = (LAS float*)F.lds;
    const int row0 = ctxu ? ROWS_L + unit * 16 : unit * 16;
    const int seqlen = ctxu ? LC : S; const int t0 = (ctxu ? unit * 16 : unit * 16) % seqlen; const int seqrow0 = row0 - t0;
    const bf16_t* Z = F.SEAM + SE_Z;
    const float* dww = F.in[I_DWW] + (size_t)l * 31 * 256; const float* dwb = F.in[I_DWB] + l * 256;
    __syncthreads();
#pragma unroll 1
    for (int i = F.tid; i < 16 * 256; i += NTHR) {
        const int tt = i >> 8, c = i & 255; float a = dwb[c];
#pragma unroll 4
        for (int k = 0; k < 31; ++k) { const int ts = t0 + tt + k - 15; if (ts >= 0 && ts < seqlen) a += bf2f(Z[(size_t)(seqrow0 + ts) * 256 + c]) * dww[k * 256 + c]; }
        zc[i] = a;
    }
    __syncthreads();
    for (int tt = F.wave * 2; tt < F.wave * 2 + 2; ++tt) {
        float x[4]; float s = 0.f;
#pragma unroll
        for (int j = 0; j < 4; ++j) { x[j] = zc[tt * 256 + F.lane + 64 * j]; s += x[j]; }
        const float mu = wave_sum(s) * (1.f / 256.f); float q = 0.f;
#pragma unroll
        for (int j = 0; j < 4; ++j) { x[j] -= mu; q += x[j] * x[j]; }
        const float rs = 1.f / sqrtf(wave_sum(q) * (1.f / 256.f) + EPS);
#pragma unroll
        for (int j = 0; j < 4; ++j) { const int c = F.lane + 64 * j; const float y = x[j] * rs * F.in[I_LNG][l * 256 + c] + F.in[I_LNB][l * 256 + c]; zc[tt * 256 + c] = silu_f(y); }
    }
    __syncthreads();
    const float* pw = F.in[I_PWW] + (size_t)l * 256 * 256; const float* pb = F.in[I_PWB] + l * 256;
#pragma unroll 1
    for (int i = F.tid; i < 16 * 256; i += NTHR) {
        const int tt = i >> 8, c = i & 255; float a = pb[c];
#pragma unroll 8
        for (int k = 0; k < 256; ++k) a += zc[tt * 256 + k] * pw[k * 256 + c];
        F.Y[(size_t)(row0 + tt) * D + 256 + c] = (bf16_t)f2bf(a);
    }
}
#ifndef FAST_ATTN_SKIP
#define FAST_ATTN_SKIP 1
#endif
#ifndef FAST_NA_LAT
#define FAST_NA_LAT 1
#endif
#ifndef FAST_NA_CTX
#define FAST_NA_CTX 1
#endif
__device__ __forceinline__ void phase_mixers_naive(Frame& F, int l, bool with_ctx) {
    const int NA_U = with_ctx ? 264 : 256;
#define UNIT_DECODE const bool cu = u >= 256; const int nq = cu ? LC : S; const int idx = cu ? u - 256 : u; const int q0 = idx * 256 + (F.tid >> 1), dh = F.tid & 1; \
        const int b = q0 / (4 * nq), h = (q0 / nq) % 4, t = q0 % nq; const int row = cu ? ROWS_L + b * LC + t : b * S + t;
#pragma unroll 1
    for (int u = F.bid; u < (FAST_ATTN_SKIP ? 0 : NA_U); u += F.G) { UNIT_DECODE
        const bf16_t* qp = F.SEAM + (cu ? SE_QGC : SE_QG) + (((size_t)b * 4 + h) * nq + t) * 64;
        const size_t kvo = ((size_t)b * 2 + (h >> 1)) * KV * 64;
        naive_attn(qp, F.SEAM + SE_KG + kvo, F.SEAM + SE_VG + kvo, cu ? LC : KV, dh, F.Y + (size_t)row * D + 512 + h * 64 + 32 * dh);
    }
    asm volatile("" ::: "memory");
#pragma unroll 1
    for (int u = F.G - 1 - F.bid; u < (FAST_ATTN_SKIP ? 0 : NA_U); u += F.G) { UNIT_DECODE
        const bf16_t* qp = F.SEAM + (cu ? SE_QDC : SE_QD) + (((size_t)b * 4 + h) * nq + t) * 64;
        const size_t kvo = ((size_t)b * 4 + h) * KV * 64;
        naive_diff(F, l, qp, F.SEAM + SE_KD + kvo, F.SEAM + SE_VD + kvo, cu ? LC : KV, dh, F.Y + (size_t)row * D + 768 + h * 64 + 32 * dh);
    }
    asm volatile("" ::: "memory");
#pragma unroll 1
    for (int u = F.bid; u < NA_U; u += F.G) { UNIT_DECODE
        if (cu ? FAST_NA_CTX : FAST_NA_LAT) continue;
        if (cu) { const bf16_t* qp = F.SEAM + SE_QAC + (((size_t)b * 4 + h) * LC + t) * 64; const size_t kvo = ((size_t)b * 4 + h) * KV * 64;
            naive_attn(qp, F.SEAM + SE_KA + kvo, F.SEAM + SE_VA + kvo, LC, dh, F.Y + (size_t)row * D + h * 64 + 32 * dh); }
        else naive_na(F, l, b, h, t, dh, F.Y + (size_t)row * D + h * 64 + 32 * dh);
    }
#undef UNIT_DECODE
    asm volatile("" ::: "memory");
#pragma unroll 1
    for (int u = F.bid; u < (FAST_CONV ? 0 : (with_ctx ? 1056 : 1024)); u += F.G) { if (u < 1024) phase_conv_naive(F, l, u, false); else phase_conv_naive(F, l, u - 1024, true); }
    __syncthreads();
}


#ifndef FAST_INPROJ
#define FAST_INPROJ 1
#endif
#ifndef FAST_OUTPROJ
#define FAST_OUTPROJ 1
#endif
#ifndef FAST_MOE
#define FAST_MOE 1
#endif
constexpr size_t WB_GU = 0;
constexpr size_t WB_DN = 128 * MiB;
constexpr size_t WB_IN = 192 * MiB;
constexpr size_t WB_OUT = 202 * MiB;
static_assert(!(FAST_MOE && !FAST_INPROJ), "naive P overlays the MoE weight copies");
constexpr int GOFS_OFF = 131072 + 1024;

namespace pg8 {
typedef short bf16x8 __attribute__((ext_vector_type(8)));
constexpr int BM = 256, BK = 64, HALF = 128, HTB = HALF * BK * 2, STAGE_BYTES = 8 * HTB;
__device__ __forceinline__ int lds_byte(int r, int c) { const int st = (r >> 4) * 2 + (c >> 5), rr = r & 15, cc = c & 31, ob = rr * 64 + cc * 2; return st * 1024 + (ob ^ (((ob >> 9) & 1) << 5)); }
__device__ __forceinline__ void stage_rc(int b, int& R, int& C) { const int st = b / 1024, sb = b % 1024, swz = sb ^ (((sb >> 9) & 1) << 5); R = (st >> 1) * 16 + swz / 64; C = (st & 1) * 32 + (swz % 64) / 2; }
__device__ __forceinline__ int perm32(int rho) { const int n = rho >> 4, i = rho & 15; return 8 * (i >> 2) + 4 * n + (i & 3); }
struct Unit { int pm, pn; };
struct Gemm { const bf16_t* A; const bf16_t* Bt; int K; };

template <class Epi, class Sched, bool GATHER>
__device__ __forceinline__ void gemm_phase(LAS unsigned char* lds, const Gemm g, const Sched& S, const Epi& E, const LAS unsigned* gofs) {
    const int tid = threadIdx.x, wid = __builtin_amdgcn_readfirstlane(tid >> 6), lane = tid & 63, wr = wid >> 2, wc = wid & 3, fr = lane & 15, fq = lane >> 4;
    const int K = g.K, nt = K / BK;
    unsigned voffB[2];
#pragma unroll
    for (int i = 0; i < 2; ++i) { int R, C; stage_rc(tid * 16 + i * 8192, R, C); const int Rb = (R & ~31) + perm32(R & 31);
        voffB[i] = (unsigned)(Rb * K + C) * 2u; }
    const size_t kstep = (size_t)(BK * 2);
    const size_t hstep = (size_t)HALF * K * 2;
    const size_t tstep = 2 * hstep;
    const unsigned ldsw = (unsigned)wid * 1024u;
    const int aoff = lds_byte(wr * 64 + fr, fq * 8), boff = lds_byte(wc * 32 + fr, fq * 8);
#define PG8_SA(b, h) (((b) * 2 + (h)) * HTB)
#define PG8_SB(b, h) ((4 + (b) * 2 + (h)) * HTB)
#define PG8_STAGE(bufoff, gbase, voff) do { _Pragma("unroll") for (int _i = 0; _i < 2; ++_i) \
        __builtin_amdgcn_global_load_lds((const unsigned*)((const char*)(gbase) + (voff)[_i]), (LAS unsigned*)(lds + (bufoff) + ldsw + _i * 8192), 16, 0, 0); } while (0)
#define PG8_LDA(dst, b, h) do { _Pragma("unroll") for (int m = 0; m < 4; ++m) _Pragma("unroll") for (int k = 0; k < 2; ++k) dst[m][k] = *(const LAS bf16x8*)(lds + PG8_SA(b, h) + aoff + m * 2048 + k * 1024); } while (0)
#define PG8_LDB(dst, b, h) do { _Pragma("unroll") for (int n = 0; n < 2; ++n) _Pragma("unroll") for (int k = 0; k < 2; ++k) dst[n][k] = *(const LAS bf16x8*)(lds + PG8_SB(b, h) + boff + n * 2048 + k * 1024); } while (0)
#define PG8_MMA(ai, bj, At, Bt) do { __builtin_amdgcn_s_setprio(1); _Pragma("unroll") for (int m = 0; m < 4; ++m) _Pragma("unroll") for (int n = 0; n < 2; ++n) _Pragma("unroll") for (int k = 0; k < 2; ++k) \
        acc[ai][bj][m][n] = __builtin_amdgcn_mfma_f32_16x16x32_bf16(Bt[n][k], At[m][k], acc[ai][bj][m][n], 0, 0, 0); __builtin_amdgcn_s_setprio(0); } while (0)
#define PG8_WAIT_V(n) asm volatile("s_waitcnt vmcnt(" #n ")" ::: "memory")
#define PG8_WAIT_L(n) asm volatile("s_waitcnt lgkmcnt(" #n ")" ::: "memory")
#define PG8_BAR __builtin_amdgcn_s_barrier()
#define PG8_SCHED __builtin_amdgcn_sched_barrier(0)
#define PG8_AOFF(dst, u, slot) do { int _t = tid; asm volatile("" : "+v"(_t)); _Pragma("unroll") for (int _i = 0; _i < 2; ++_i) { int _R, _C; stage_rc(_t * 16 + _i * 8192, _R, _C); \
        _Pragma("unroll") for (int _h = 0; _h < 2; ++_h) \
        dst[_h][_i] = (GATHER ? gofs[(slot) * 256 + _h * HALF + _R] : (unsigned)((u).pm * BM + _h * HALF + _R) * (unsigned)(K * 2)) + (unsigned)_C * 2u; } } while (0)
    Unit cur, nxt; int ui = 0;
    if (!S.next(0, cur)) return;
    f32x4 acc[2][2][4][2];
#pragma unroll
    for (int a = 0; a < 2; ++a)
#pragma unroll
        for (int b = 0; b < 2; ++b)
#pragma unroll
            for (int m = 0; m < 4; ++m)
#pragma unroll
                for (int n = 0; n < 2; ++n) acc[a][b][m][n] = (f32x4){0.f, 0.f, 0.f, 0.f};
    bf16x8 At[4][2], B0[2][2], B1[2][2];
    unsigned ca[2][2];
    PG8_AOFF(ca, cur, 0);
    const char* Ab = (const char*)g.A; const char* cB = (const char*)g.Bt + (size_t)cur.pn * tstep;
    PG8_STAGE(PG8_SB(0, 0), cB, voffB); PG8_STAGE(PG8_SB(0, 1), cB + hstep, voffB); PG8_STAGE(PG8_SA(0, 0), Ab, ca[0]); PG8_STAGE(PG8_SA(0, 1), Ab, ca[1]);
    if (wr == 1) PG8_BAR;
    PG8_WAIT_V(2); PG8_BAR;
    PG8_STAGE(PG8_SB(1, 0), cB + kstep, voffB); PG8_STAGE(PG8_SA(1, 0), Ab + kstep, ca[0]); PG8_STAGE(PG8_SB(1, 1), cB + hstep + kstep, voffB);
    PG8_WAIT_V(6); PG8_BAR;
    for (;;) {
        const bool has_next = S.next(ui + 1, nxt);
        const char* nB = has_next ? (const char*)g.Bt + (size_t)nxt.pn * tstep : cB;
        for (int t = 0; t < nt; t += 2) {
            const bool last = (t == nt - 2);
            const char* a1 = Ab + (size_t)(t + 1) * kstep;
            const char* a2 = last ? Ab : Ab + (size_t)(t + 2) * kstep; const char* b2 = last ? nB : cB + (size_t)(t + 2) * kstep;
            const char* a3 = a2 + kstep; const char* b3 = b2 + kstep;
            PG8_LDB(B0, 0, 0); PG8_LDB(B1, 0, 1); PG8_SCHED; PG8_LDA(At, 0, 0); PG8_STAGE(PG8_SA(1, 1), a1, ca[1]);
            if (last && has_next) { PG8_AOFF(ca, nxt, ui + 1); }
            PG8_WAIT_V(8); PG8_WAIT_L(0); PG8_BAR; PG8_MMA(0, 0, At, B0); PG8_MMA(0, 1, At, B1); PG8_BAR; PG8_SCHED;
            PG8_LDA(At, 0, 1); PG8_STAGE(PG8_SB(0, 0), b2, voffB); PG8_STAGE(PG8_SB(0, 1), b2 + hstep, voffB); PG8_STAGE(PG8_SA(0, 0), a2, ca[0]);
            PG8_WAIT_V(8); PG8_WAIT_L(0); PG8_BAR; PG8_MMA(1, 0, At, B0); PG8_MMA(1, 1, At, B1); PG8_BAR; PG8_SCHED;
            PG8_LDB(B0, 1, 0); PG8_LDB(B1, 1, 1); PG8_SCHED; PG8_LDA(At, 1, 0); PG8_STAGE(PG8_SA(0, 1), a2, ca[1]);
            PG8_WAIT_V(8); PG8_WAIT_L(0); PG8_BAR; PG8_MMA(0, 0, At, B0); PG8_MMA(0, 1, At, B1); PG8_BAR; PG8_SCHED;
            PG8_LDA(At, 1, 1); PG8_STAGE(PG8_SB(1, 0), b3, voffB); PG8_STAGE(PG8_SB(1, 1), b3 + hstep, voffB); PG8_STAGE(PG8_SA(1, 0), a3, ca[0]);
            PG8_WAIT_V(8); PG8_WAIT_L(0); PG8_BAR; PG8_MMA(1, 0, At, B0); PG8_MMA(1, 1, At, B1); PG8_BAR; PG8_SCHED;
        }
        if (wr == 0) PG8_BAR;
        { int fr_ = fr, fq_ = fq, wr_ = wr, wc_ = wc; asm volatile("" : "+v"(fr_), "+v"(fq_), "+s"(wr_), "+s"(wc_));
          E(acc, cur, wr_, wc_, fr_, fq_); }
        if (!has_next) break;
#pragma unroll
        for (int a = 0; a < 2; ++a)
#pragma unroll
            for (int b = 0; b < 2; ++b)
#pragma unroll
                for (int m = 0; m < 4; ++m)
#pragma unroll
                    for (int n = 0; n < 2; ++n) acc[a][b][m][n] = (f32x4){0.f, 0.f, 0.f, 0.f};
        cur = nxt; cB = nB; ++ui;
        if (wr == 1) PG8_BAR;
    }
    PG8_WAIT_V(0);
    PG8_BAR;
#undef PG8_SA
#undef PG8_SB
#undef PG8_STAGE
#undef PG8_LDA
#undef PG8_LDB
#undef PG8_MMA
#undef PG8_WAIT_V
#undef PG8_WAIT_L
#undef PG8_BAR
#undef PG8_SCHED
#undef PG8_AOFF
}

struct OrderDense {
    int nM, nN, G, v;
    __device__ __forceinline__ bool next(int i, Unit& u) const {
        const int id = i * G + v; if (id >= nM * nN) return false;
        const int nig = 8 * nN, gid = id / nig, fm = gid * 8, gsz = (nM - fm) < 8 ? (nM - fm) : 8;
        u.pm = fm + ((id % nig) % gsz); u.pn = (id % nig) / gsz; return true;
    }
};
struct OrderMoe {
    int nM, nN, G, v;
    __device__ __forceinline__ bool next(int i, Unit& u) const {
        const int id = i * G + v; if (id >= NE * nM * nN) return false;
        const int e = id / (nM * nN), r = id % (nM * nN);
        u.pm = e * 9 + (r % nM); u.pn = e * nN + (r / nM); return true;
    }
};
}

__device__ __forceinline__ unsigned cvt_pk_bf16(float lo, float hi) { unsigned r; asm volatile("v_cvt_pk_bf16_f32 %0, %1, %2" : "=v"(r) : "v"(lo), "v"(hi)); return r; }
__device__ __forceinline__ u32x4 pack8(const f32x4 a, const f32x4 b) { u32x4 w; w.x = cvt_pk_bf16(a[0], a[1]); w.y = cvt_pk_bf16(a[2], a[3]); w.z = cvt_pk_bf16(b[0], b[1]); w.w = cvt_pk_bf16(b[2], b[3]); return w; }
__device__ __forceinline__ float fast_sigmoid(float x) { return __builtin_amdgcn_rcpf(1.f + __expf(-x)); }

struct EpiIn {
    bf16_t* SEAM; const float* tab; const float* qng; const float* kng;
    __device__ __forceinline__ void operator()(const f32x4 (&acc)[2][2][4][2], const pg8::Unit& u, int wr, int wc, int fr, int fq) const {
        const bool isc = u.pm >= 64; const int b = isc ? u.pm - 64 : u.pm >> 5; const int pn = u.pn; const int nq = isc ? LC : S;
        f32x4 gn[2][2];
        if (pn == 5 || pn == 6) { const float* g = (pn == 5) ? qng : kng;
#pragma unroll
            for (int bj = 0; bj < 2; ++bj)
#pragma unroll
                for (int n = 0; n < 2; ++n) gn[bj][n] = *(const f32x4*)(g + 32 * bj + 8 * fq + 4 * n); }
#pragma unroll
        for (int ai = 0; ai < 2; ++ai)
#pragma unroll
            for (int m = 0; m < 4; ++m) {
                const int rl = 128 * ai + 64 * wr + 16 * m + fr; const int r = u.pm * 256 + rl; const int t = isc ? rl : (r & (S - 1)); const int key = isc ? t : LC + t;
                const int e0 = 8 * fq;
                if (pn <= 2 || pn == 9 || (pn == 6 && wc >= 2)) {
                    bf16_t* base;
                    if (pn == 0) base = isc ? SEAM + SE_QAC + (((size_t)b * 4 + wc) * LC + t) * 64 : SEAM + SE_QA + (((size_t)b * 4 + wc) * S + t) * 64;
                    else if (pn == 1) base = SEAM + SE_KA + (((size_t)b * 4 + wc) * KV + key) * 64;
                    else if (pn == 2) base = SEAM + SE_VA + (((size_t)b * 4 + wc) * KV + key) * 64;
                    else if (pn == 9) base = SEAM + SE_VD + (((size_t)b * 4 + wc) * KV + key) * 64;
                    else base = SEAM + SE_VG + (((size_t)b * 2 + (wc - 2)) * KV + key) * 64;
                    const float sc = (pn == 0) ? 0.125f * LOG2E : 1.f;
#pragma unroll
                    for (int bj = 0; bj < 2; ++bj) *(u32x4*)(base + 32 * bj + e0) = pack8(acc[ai][bj][m][0] * sc, acc[ai][bj][m][1] * sc);
                } else if (pn == 3 || pn == 4) {
                    f32x4 z0, z1;
#pragma unroll
                    for (int j = 0; j < 4; ++j) { z0[j] = acc[ai][0][m][0][j] * fast_sigmoid(acc[ai][1][m][0][j]); z1[j] = acc[ai][0][m][1][j] * fast_sigmoid(acc[ai][1][m][1][j]); }
                    *(u32x4*)(SEAM + SE_Z + (size_t)r * 256 + 128 * (pn - 3) + 32 * wc + e0) = pack8(z0, z1);
                } else if (pn == 5 || pn == 6) {
                    float ss = 0.f;
#pragma unroll
                    for (int bj = 0; bj < 2; ++bj)
#pragma unroll
                        for (int n = 0; n < 2; ++n) { const f32x4 x = acc[ai][bj][m][n]; ss += (x[0] * x[0] + x[1] * x[1]) + (x[2] * x[2] + x[3] * x[3]); }
                    ss += __shfl_xor(ss, 16); ss += __shfl_xor(ss, 32);
                    const float rs = 1.f / sqrtf(ss * (1.f / 64.f) + EPS);
                    f32x4 x1[2], x2[2];
#pragma unroll
                    for (int n = 0; n < 2; ++n) { x1[n] = acc[ai][0][m][n] * rs * gn[0][n]; x2[n] = acc[ai][1][m][n] * rs * gn[1][n]; }
                    if (!isc) { const int pos = (fq < 2) ? (t >> 6) : (t & 63);
#pragma unroll
                        for (int n = 0; n < 2; ++n) { const f32x4 c = *(const f32x4*)(tab + TB_C64 + pos * 16 + 8 * (fq & 1) + 4 * n), sn = *(const f32x4*)(tab + TB_S64 + pos * 16 + 8 * (fq & 1) + 4 * n);
                            const f32x4 a = x1[n] * c - x2[n] * sn, bb = x2[n] * c + x1[n] * sn; x1[n] = a; x2[n] = bb; } }
                    bf16_t* base;
                    if (pn == 5) { base = isc ? SEAM + SE_QGC + (((size_t)b * 4 + wc) * LC + t) * 64 : SEAM + SE_QG + (((size_t)b * 4 + wc) * S + t) * 64;
                        const float sc = 0.125f * LOG2E;
#pragma unroll
                        for (int n = 0; n < 2; ++n) { x1[n] = x1[n] * sc; x2[n] = x2[n] * sc; } }
                    else base = SEAM + SE_KG + (((size_t)b * 2 + wc) * KV + key) * 64;
                    *(u32x4*)(base + e0) = pack8(x1[0], x1[1]); *(u32x4*)(base + 32 + e0) = pack8(x2[0], x2[1]);
                } else {
                    bf16_t* base;
                    if (pn == 7) base = isc ? SEAM + SE_QDC + (((size_t)b * 4 + wc) * LC + t) * 64 : SEAM + SE_QD + (((size_t)b * 4 + wc) * S + t) * 64;
                    else base = SEAM + SE_KD + (((size_t)b * 4 + wc) * KV + key) * 64;
                    const float sc = (pn == 7) ? 0.17677669529663687f * LOG2E : 1.f;
                    f32x4 c = (f32x4){1.f, 1.f, 1.f, 1.f}, sn = (f32x4){0.f, 0.f, 0.f, 0.f};
                    if (!isc) { const int pos = (fq < 2) ? (t >> 6) : (t & 63); c = *(const f32x4*)(tab + TB_C32 + pos * 8 + 4 * (fq & 1)); sn = *(const f32x4*)(tab + TB_S32 + pos * 8 + 4 * (fq & 1)); }
#pragma unroll
                    for (int bj = 0; bj < 2; ++bj) { const f32x4 x1 = acc[ai][bj][m][0], x2 = acc[ai][bj][m][1];
                        const f32x4 a = (x1 * c - x2 * sn) * sc, bb = (x2 * c + x1 * sn) * sc;
                        uint2 w1, w2; w1.x = cvt_pk_bf16(a[0], a[1]); w1.y = cvt_pk_bf16(a[2], a[3]); w2.x = cvt_pk_bf16(bb[0], bb[1]); w2.y = cvt_pk_bf16(bb[2], bb[3]);
                        *(uint2*)(base + 32 * bj + 4 * fq) = w1; *(uint2*)(base + 32 * bj + 16 + 4 * fq) = w2; }
                }
            }
    }
};
__device__ __forceinline__ int inproj_srccol(int nrow) {
    const int pn = nrow >> 8, p = nrow & 255, bj = p >> 7, wc = (p >> 5) & 3, j32 = p & 31;
    if (pn == 3 || pn == 4) return (bj ? 1024 : 768) + 128 * (pn - 3) + (p & 127);
    if (pn == 7 || pn == 8) { const int fq = j32 >> 3, n = (j32 >> 2) & 1, j = j32 & 3; return 256 * pn + 64 * wc + 32 * bj + 16 * n + 4 * fq + j; }
    return 256 * pn + 64 * wc + 32 * bj + j32;
}
struct EpiOut {
    const float* xl; const float* xc; const float* hin; float* hout; const float* modl; const float* bp;
    __device__ __forceinline__ void operator()(const f32x4 (&acc)[2][2][4][2], const pg8::Unit& u, int wr, int wc, int fr, int fq) const {
        const bool isc = u.pm >= 64; const int b = isc ? u.pm - 64 : u.pm >> 5; const float* g1 = modl + (isc ? 2 : b) * 6144 + 2 * D;
        const int col0 = u.pn * 256 + 32 * wc + 8 * fq;
        const int r0 = u.pm * 256 + 64 * wr + fr;
        const float* src0 = hin ? hin + (size_t)r0 * D : (isc ? xc + (size_t)(r0 - ROWS_L) * D : xl + (size_t)r0 * D);
        float* dst0 = hout + (size_t)r0 * D;
#pragma unroll
        for (int bj = 0; bj < 2; ++bj)
#pragma unroll
            for (int n = 0; n < 2; ++n) { const int c = col0 + 128 * bj + 4 * n;
                const f32x4 g = *(const f32x4*)(g1 + c), bb = *(const f32x4*)(bp + c);
#pragma unroll
                for (int ai = 0; ai < 2; ++ai)
#pragma unroll
                    for (int m = 0; m < 4; ++m) { const size_t ro = (size_t)(128 * ai + 16 * m) * D + c;
                        const f32x4 h = *(const f32x4*)(src0 + ro); *(f32x4*)(dst0 + ro) = h + g * (acc[ai][bj][m][n] + bb); }
                asm volatile("" ::: "memory"); }
    }
};
struct EpiMoe1 {
    bf16_t* HE;
    __device__ __forceinline__ void operator()(const f32x4 (&acc)[2][2][4][2], const pg8::Unit& u, int wr, int wc, int fr, int fq) const {
        const int f0 = (u.pn & 7) * 128 + 32 * wc + 8 * fq;
#pragma unroll
        for (int ai = 0; ai < 2; ++ai)
#pragma unroll
            for (int m = 0; m < 4; ++m) { const size_t r = (size_t)u.pm * 256 + 128 * ai + 64 * wr + 16 * m + fr;
                f32x4 h0, h1;
#pragma unroll
                for (int j = 0; j < 4; ++j) { const float a0 = acc[ai][0][m][0][j], a1 = acc[ai][0][m][1][j]; h0[j] = a0 * fast_sigmoid(a0) * acc[ai][1][m][0][j]; h1[j] = a1 * fast_sigmoid(a1) * acc[ai][1][m][1][j]; }
                *(u32x4*)(HE + r * D + f0) = pack8(h0, h1); }
    }
};
struct EpiMoe2 {
    bf16_t* YE; const float* gate;
    __device__ __forceinline__ void operator()(const f32x4 (&acc)[2][2][4][2], const pg8::Unit& u, int wr, int wc, int fr, int fq) const {
        const int c0 = (u.pn & 3) * 256 + 32 * wc + 8 * fq;
#pragma unroll
        for (int ai = 0; ai < 2; ++ai)
#pragma unroll
            for (int m = 0; m < 4; ++m) { const size_t r = (size_t)u.pm * 256 + 128 * ai + 64 * wr + 16 * m + fr; const float gt = gate[r];
#pragma unroll
                for (int bj = 0; bj < 2; ++bj) *(u32x4*)(YE + r * D + c0 + 128 * bj) = pack8(acc[ai][bj][m][0] * gt, acc[ai][bj][m][1] * gt); }
    }
};

__device__ __forceinline__ int vcu_of(const Frame& F) { return (F.G % 8 == 0) ? (F.bid % 8) * (F.G / 8) + F.bid / 8 : F.bid; }

__device__ __forceinline__ void phase_inproj_fast(Frame& F, int l) {
    pg8::Gemm g{F.U, (const bf16_t*)(F.ws + WS_WBF + WB_IN + (size_t)l * 5 * MiB), D};
    pg8::OrderDense S{ROWS / 256, DIN / 256, F.G, vcu_of(F)};
    EpiIn E{F.SEAM, F.tab, F.in[I_QNG] + l * 64, F.in[I_KNG] + l * 64};
    pg8::gemm_phase<EpiIn, pg8::OrderDense, false>(F.lds, g, S, E, nullptr);
}
__device__ __forceinline__ void phase_outproj_fast(Frame& F, int l, bool with_ctx) {
    pg8::Gemm g{F.Y, (const bf16_t*)(F.ws + WS_WBF + WB_OUT + (size_t)l * 2 * MiB), D};
    pg8::OrderDense S{(with_ctx ? ROWS : ROWS_L) / 256, D / 256, F.G, vcu_of(F)};
    EpiOut E{F.in[I_X], F.in[I_CTX], (l == 0) ? nullptr : F.H, F.H, F.tab + TB_MOD + l * 3 * 6144, F.tab + TB_BP_ + l * D};
    pg8::gemm_phase<EpiOut, pg8::OrderDense, false>(F.lds, g, S, E, nullptr);
}
__device__ __forceinline__ void phase_moe1_fast(Frame& F, int l, bool with_ctx) {
    pg8::Gemm g{F.U, (const bf16_t*)(F.ws + WS_WBF + WB_GU + (size_t)l * 64 * MiB), D};
    pg8::OrderMoe S{with_ctx ? 9 : 8, 8, F.G, vcu_of(F)};
    LAS unsigned* gofs = (LAS unsigned*)(F.lds + GOFS_OFF);
    { pg8::Unit u;
      for (int i = 0; i < 8 && S.next(i, u); ++i)
          for (int j = F.tid; j < 256; j += NTHR) { const int ri = F.RIDX[u.pm * 256 + j]; gofs[i * 256 + j] = (unsigned)(ri < 0 ? 0 : ri) * (unsigned)(D * 2); }
      __syncthreads(); }
    EpiMoe1 E{F.HE};
    pg8::gemm_phase<EpiMoe1, pg8::OrderMoe, true>(F.lds, g, S, E, gofs);
}
__device__ __forceinline__ void phase_moe2_fast(Frame& F, int l, bool with_ctx) {
    pg8::Gemm g{F.HE, (const bf16_t*)(F.ws + WS_WBF + WB_DN + (size_t)l * 32 * MiB), D};
    pg8::OrderMoe S{with_ctx ? 9 : 8, 4, F.G, vcu_of(F)};
    EpiMoe2 E{F.YE, F.GATE};
    pg8::gemm_phase<EpiMoe2, pg8::OrderMoe, false>(F.lds, g, S, E, nullptr);
}

#ifndef FAST_CONV_FOLD
#define FAST_CONV_FOLD 1
#endif
__device__ __forceinline__ void fold_item(const float* pw, const float* wo, int n0, int k0, bf16_t* WTrow0, LAS float* scr, int lane);
__device__ __forceinline__ void transpose_item(const float* W, int ldw, int srccol, int k0, bf16_t* WTrow0, int K, LAS float* scr, int lane) {
#pragma unroll 8
    for (int i = 0; i < 32; ++i) { const int kk = 2 * i + (lane >> 5); scr[kk * 33 + (lane & 31)] = W[(size_t)(k0 + kk) * ldw + srccol]; }
    asm volatile("s_waitcnt lgkmcnt(0)" ::: "memory");
    const int c = lane & 7;
#pragma unroll
    for (int j = 0; j < 4; ++j) { const int n = (lane >> 3) + 8 * j; const LAS float* s_ = scr + (8 * c) * 33 + n;
        u32x4 o; o.x = pk2(s_[0 * 33], s_[1 * 33]); o.y = pk2(s_[2 * 33], s_[3 * 33]); o.z = pk2(s_[4 * 33], s_[5 * 33]); o.w = pk2(s_[6 * 33], s_[7 * 33]);
        *(u32x4*)(WTrow0 + (size_t)n * K + k0 + 8 * c) = o; }
    asm volatile("s_waitcnt lgkmcnt(0)" ::: "memory");
}
__device__ __forceinline__ void phase_convert(Frame& F) {
    LAS float* scr = (LAS float*)(F.lds + F.wave * 16384);
    const int gw = F.bid * NWAVES + F.wave, NGW = F.G * NWAVES;
    constexpr int IT_IN = 16 * 80, IT_OUT = 16 * 32, IT_E = 16 * 32;
    constexpr int PER_L = IT_IN + IT_OUT + NE * 3 * IT_E;
    const int nn = F.lane & 31;
    for (int it = gw; it < DEPTH * PER_L; it += NGW) {
        const int l = it / PER_L; int r = it % PER_L;
        if (r < IT_IN) { if (!FAST_INPROJ) continue; const int kb = r / 80, nb = r % 80;
            transpose_item(F.in[I_WIN] + (size_t)l * D * DIN, DIN, inproj_srccol(nb * 32 + nn), kb * 64, (bf16_t*)(F.ws + WS_WBF + WB_IN + (size_t)l * 5 * MiB) + (size_t)(nb * 32) * D, D, scr, F.lane); continue; }
        r -= IT_IN;
        if (r < IT_OUT) { if (!FAST_OUTPROJ) continue; const int kb = r / 32, nb = r % 32;
            bf16_t* wt = (bf16_t*)(F.ws + WS_WBF + WB_OUT + (size_t)l * 2 * MiB) + (size_t)(nb * 32) * D;
            if (FAST_CONV_FOLD && kb >= 4 && kb < 8) fold_item(F.in[I_PWW] + (size_t)l * 256 * 256, F.in[I_WOUT] + (size_t)l * D * D, nb * 32, kb * 64, wt, scr, F.lane);
            else transpose_item(F.in[I_WOUT] + (size_t)l * D * D, D, nb * 32 + nn, kb * 64, wt, D, scr, F.lane);
            continue; }
        r -= IT_OUT;
        if (!FAST_MOE) continue;
        const int e = r / (3 * IT_E), q = (r % (3 * IT_E)) / IT_E, r2 = r % IT_E, kb = r2 / 32, nb = r2 % 32;
        const size_t wo = ((size_t)l * NE + e) * D * D;
        if (q < 2) {
            const int f0 = nb * 32; const int row0 = (f0 >> 7) * 256 + q * 128 + (f0 & 127);
            transpose_item(F.in[q == 0 ? I_WG : I_WU] + wo, D, f0 + nn, kb * 64, (bf16_t*)(F.ws + WS_WBF + WB_GU + (size_t)l * 64 * MiB) + ((size_t)e * 2048 + row0) * D, D, scr, F.lane);
        } else transpose_item(F.in[I_WD] + wo, D, nb * 32 + nn, kb * 64, (bf16_t*)(F.ws + WS_WBF + WB_DN + (size_t)l * 32 * MiB) + ((size_t)e * 1024 + nb * 32) * D, D, scr, F.lane);
    }
}


#ifndef FAST_ATTN
#define FAST_ATTN 1
#endif
namespace att {
typedef short bf16x8 __attribute__((ext_vector_type(8)));
typedef short s16x4 __attribute__((ext_vector_type(4)));
typedef float f32x16 __attribute__((ext_vector_type(16)));
constexpr int SLOTB = 8192, NSLOT = 3;
constexpr int L_K = 0, L_V = NSLOT * SLOTB, L_WS = 2 * NSLOT * SLOTB, L_OST = L_WS + NWAVES * 256, L_END = L_OST + NWAVES * 32 * 68 * 4;
constexpr int L_NAB = L_END;
static_assert(L_NAB + 2048 <= 131072, "attention LDS");
__device__ __forceinline__ int crow(int r, int hi) { return (r & 3) + 8 * (r >> 2) + 4 * hi; }
__device__ __forceinline__ s16x4 vtr(const LAS char* p) { return __builtin_bit_cast(s16x4, __builtin_amdgcn_ds_read_tr16_b64_v4i16((LAS s16x4*)p)); }
#define ATT_WAIT_BAR(N) asm volatile("s_waitcnt vmcnt(" #N ") lgkmcnt(0)\n\ts_barrier" ::: "memory")

template <int KIND> __device__ __forceinline__ void attn_unit(LAS char* lds, const bf16_t* Qw, const bf16_t* Kh, const bf16_t* Vh, int nt, bf16_t* Yw, float lam, float oml, const float* dng,
                                                            int rmin = 0, int qrow = 0, int qc = 0) {
    int tid = threadIdx.x; asm volatile("" : "+v"(tid));
    const int lane = tid & 63, r32 = lane & 31, hi = lane >> 5; const int wid = __builtin_amdgcn_readfirstlane(tid >> 6);
    LAS float* wsf = (LAS float*)(lds + L_WS) + wid * 64;
    const bf16_t* ksrc = Kh + (size_t)lane * 64 + wid * 8;
    const bf16_t* vsrc = Vh + (size_t)(16 * (wid & 3) + (lane >> 2)) * 64 + (wid >> 2) * 32 + (lane & 3) * 8;
    LAS char* kdst = lds + L_K + wid * 1024; LAS char* vdst = lds + L_V + wid * 1024;
#define ATT_TILE(i) ((KIND == 2 && (i) >= 4) ? (i) + rmin : (i))
#define ATT_DMA(t, slotb) do { __builtin_amdgcn_global_load_lds((const unsigned*)(ksrc + (size_t)(t) * 64 * 64), (LAS unsigned*)(kdst + (slotb)), 16, 0, 0); \
                               __builtin_amdgcn_global_load_lds((const unsigned*)(vsrc + (size_t)(t) * 64 * 64), (LAS unsigned*)(vdst + (slotb)), 16, 0, 0); } while (0)
    ATT_DMA(0, 0); ATT_DMA(1, SLOTB);
    bf16x8 qr[4];
#pragma unroll
    for (int d0 = 0; d0 < 4; ++d0) qr[d0] = *(const bf16x8*)(Qw + (size_t)r32 * 64 + d0 * 16 + hi * 8);
    f32x16 o1[2], o2[2]; float l1 = 0.f, l2 = 0.f;
    o1[0] = f32x16{}; o1[1] = f32x16{}; o2[0] = f32x16{}; o2[1] = f32x16{};
    const LAS char* kp0 = lds + L_K + hi * 1024 + r32 * 16;
    const LAS char* vp0 = lds + L_V + ((lane >> 4) & 1) * 32 + (lane & 3) * 8 + (4 * hi + ((lane & 15) >> 2)) * 64;
    int sl_cur = 0, sl_nn = 2 * SLOTB;
#pragma unroll 1
    for (int t = 0; t < nt; ++t) {
        ATT_WAIT_BAR(2);
        { const int tn = (t + 2 < nt) ? t + 2 : nt - 1; ATT_DMA(ATT_TILE(tn), sl_nn); }
        const LAS char* kp = kp0 + sl_cur; const LAS char* vp = vp0 + sl_cur;
        int na_dr = 0;
        if (KIND == 2) { int rs_ = qrow - 4; rs_ = rs_ < 0 ? 0 : (rs_ > 120 ? 120 : rs_); const int rr = rmin + t - 4; na_dr = rr - qrow + 7;
            if (t >= 4 && (rr < rs_ || rr >= rs_ + 8)) { sl_nn = sl_cur; sl_cur = (sl_cur == (NSLOT - 1) * SLOTB) ? 0 : sl_cur + SLOTB; continue; } }
        u32x4 pw[4], qw[4];
        {
            f32x16 pa0, pa1; const f32x16 z = f32x16{};
            if (KIND != 1) {
                bf16x8 kf[8];
#pragma unroll
                for (int d0 = 0; d0 < 4; ++d0) { kf[2 * d0] = *(const LAS bf16x8*)(kp + d0 * 2048); kf[2 * d0 + 1] = *(const LAS bf16x8*)(kp + d0 * 2048 + 512); }
                pa0 = __builtin_amdgcn_mfma_f32_32x32x16_bf16(kf[0], qr[0], z, 0, 0, 0); pa1 = __builtin_amdgcn_mfma_f32_32x32x16_bf16(kf[1], qr[0], z, 0, 0, 0);
#pragma unroll
                for (int d0 = 1; d0 < 4; ++d0) { pa0 = __builtin_amdgcn_mfma_f32_32x32x16_bf16(kf[2 * d0], qr[d0], pa0, 0, 0, 0); pa1 = __builtin_amdgcn_mfma_f32_32x32x16_bf16(kf[2 * d0 + 1], qr[d0], pa1, 0, 0, 0); }
            } else {
                bf16x8 kf[4];
#pragma unroll
                for (int d0 = 0; d0 < 2; ++d0) { kf[2 * d0] = *(const LAS bf16x8*)(kp + d0 * 2048); kf[2 * d0 + 1] = *(const LAS bf16x8*)(kp + d0 * 2048 + 512); }
                pa0 = __builtin_amdgcn_mfma_f32_32x32x16_bf16(kf[0], qr[0], z, 0, 0, 0); pa1 = __builtin_amdgcn_mfma_f32_32x32x16_bf16(kf[1], qr[0], z, 0, 0, 0);
                pa0 = __builtin_amdgcn_mfma_f32_32x32x16_bf16(kf[2], qr[1], pa0, 0, 0, 0); pa1 = __builtin_amdgcn_mfma_f32_32x32x16_bf16(kf[3], qr[1], pa1, 0, 0, 0);
            }
            if (KIND == 2 && t >= 4) {
                const int jq = 32 * qc + r32; int cs = jq - 8; cs = cs < 0 ? 0 : (cs > 48 ? 48 : cs);
                const LAS float* nb = (const LAS float*)(lds + L_NAB) + na_dr * 32 - jq + 15;
#pragma unroll
                for (int r = 0; r < 16; ++r) { const int kc = crow(r, hi);
                    pa0[r] = ((unsigned)(kc - cs) < 16u) ? pa0[r] + nb[kc] : -INFINITY;
                    pa1[r] = ((unsigned)(kc + 32 - cs) < 16u) ? pa1[r] + nb[kc + 32] : -INFINITY; }
            }
            float sa = 0.f, sb = 0.f;
#pragma unroll
            for (int r = 0; r < 16; ++r) { pa0[r] = __builtin_amdgcn_exp2f(pa0[r]); pa1[r] = __builtin_amdgcn_exp2f(pa1[r]); sa += pa0[r]; sb += pa1[r]; }
            l1 += sa + sb;
#pragma unroll
            for (int i = 0; i < 4; ++i) { pw[0][i] = cvt_pk_bf16(pa0[2 * i], pa0[2 * i + 1]); pw[1][i] = cvt_pk_bf16(pa0[8 + 2 * i], pa0[9 + 2 * i]); pw[2][i] = cvt_pk_bf16(pa1[2 * i], pa1[2 * i + 1]); pw[3][i] = cvt_pk_bf16(pa1[8 + 2 * i], pa1[9 + 2 * i]); }
        }
        if (KIND == 1) {
            __builtin_amdgcn_sched_barrier(0);
            f32x16 pb0, pb1; const f32x16 z = f32x16{};
            bf16x8 kf[4];
#pragma unroll
            for (int d0 = 0; d0 < 2; ++d0) { kf[2 * d0] = *(const LAS bf16x8*)(kp + (d0 + 2) * 2048); kf[2 * d0 + 1] = *(const LAS bf16x8*)(kp + (d0 + 2) * 2048 + 512); }
            pb0 = __builtin_amdgcn_mfma_f32_32x32x16_bf16(kf[0], qr[2], z, 0, 0, 0); pb1 = __builtin_amdgcn_mfma_f32_32x32x16_bf16(kf[1], qr[2], z, 0, 0, 0);
            pb0 = __builtin_amdgcn_mfma_f32_32x32x16_bf16(kf[2], qr[3], pb0, 0, 0, 0); pb1 = __builtin_amdgcn_mfma_f32_32x32x16_bf16(kf[3], qr[3], pb1, 0, 0, 0);
            float sc_ = 0.f, sd = 0.f;
#pragma unroll
            for (int r = 0; r < 16; ++r) { pb0[r] = __builtin_amdgcn_exp2f(pb0[r]); pb1[r] = __builtin_amdgcn_exp2f(pb1[r]); sc_ += pb0[r]; sd += pb1[r]; }
            l2 += sc_ + sd;
#pragma unroll
            for (int i = 0; i < 4; ++i) { qw[0][i] = cvt_pk_bf16(pb0[2 * i], pb0[2 * i + 1]); qw[1][i] = cvt_pk_bf16(pb0[8 + 2 * i], pb0[9 + 2 * i]); qw[2][i] = cvt_pk_bf16(pb1[2 * i], pb1[2 * i + 1]); qw[3][i] = cvt_pk_bf16(pb1[8 + 2 * i], pb1[9 + 2 * i]); }
            __builtin_amdgcn_sched_barrier(0);
        }
#pragma unroll
        for (int d0 = 0; d0 < 2; ++d0) {
#pragma unroll
            for (int ks = 0; ks < 4; ++ks) {
                const s16x4 lo = vtr(vp + d0 * 4096 + ks * 1024), hh = vtr(vp + d0 * 4096 + ks * 1024 + 512);
                const bf16x8 vf = (bf16x8){lo[0], lo[1], lo[2], lo[3], hh[0], hh[1], hh[2], hh[3]};
                o1[d0] = __builtin_amdgcn_mfma_f32_32x32x16_bf16(__builtin_bit_cast(bf16x8, pw[ks]), vf, o1[d0], 0, 0, 0);
                if (KIND == 1) o2[d0] = __builtin_amdgcn_mfma_f32_32x32x16_bf16(__builtin_bit_cast(bf16x8, qw[ks]), vf, o2[d0], 0, 0, 0);
            }
        }
        sl_nn = sl_cur; sl_cur = (sl_cur == (NSLOT - 1) * SLOTB) ? 0 : sl_cur + SLOTB;
    }
    ATT_WAIT_BAR(0);
    { auto rr = __builtin_amdgcn_permlane32_swap(__float_as_uint(l1), __float_as_uint(l1), false, false); l1 = __uint_as_float(rr[0]) + __uint_as_float(rr[1]); }
    if (KIND == 1) { auto rr = __builtin_amdgcn_permlane32_swap(__float_as_uint(l2), __float_as_uint(l2), false, false); l2 = __uint_as_float(rr[0]) + __uint_as_float(rr[1]); }
    if (hi == 0) { wsf[r32] = 1.f / l1; if (KIND == 1) wsf[32 + r32] = lam / l2; }
    asm volatile("s_waitcnt lgkmcnt(0)" ::: "memory");
    LAS float* stg = (LAS float*)(lds + L_OST) + wid * (32 * 68);
#pragma unroll
    for (int r = 0; r < 16; ++r) { const int q = crow(r, hi); const float a = wsf[q], b = (KIND == 1) ? wsf[32 + q] : 0.f;
#pragma unroll
        for (int d0 = 0; d0 < 2; ++d0) stg[q * 68 + d0 * 32 + r32] = (KIND == 1) ? (o1[d0][r] * a - o2[d0][r] * b) : o1[d0][r] * a; }
    asm volatile("s_waitcnt lgkmcnt(0)" ::: "memory");
    {
        const int row = lane >> 1, hf = lane & 1; float v[32];
#pragma unroll
        for (int i = 0; i < 8; ++i) { const f32x4 x = *(const LAS f32x4*)(stg + row * 68 + hf * 32 + 4 * i); v[4 * i] = x[0]; v[4 * i + 1] = x[1]; v[4 * i + 2] = x[2]; v[4 * i + 3] = x[3]; }
        if (KIND == 1) {
            float ss = 0.f;
#pragma unroll
            for (int i = 0; i < 32; ++i) ss += v[i] * v[i];
            ss += __shfl_xor(ss, 1);
            const float rs = oml / sqrtf(ss * (1.f / 64.f) + EPS);
#pragma unroll
            for (int i = 0; i < 32; ++i) v[i] = v[i] * rs * dng[hf * 32 + i];
        }
        bf16_t* dst = Yw + (size_t)row * D + hf * 32;
#pragma unroll
        for (int i = 0; i < 4; ++i) { u32x4 w; w.x = cvt_pk_bf16(v[8 * i], v[8 * i + 1]); w.y = cvt_pk_bf16(v[8 * i + 2], v[8 * i + 3]); w.z = cvt_pk_bf16(v[8 * i + 4], v[8 * i + 5]); w.w = cvt_pk_bf16(v[8 * i + 6], v[8 * i + 7]); *(u32x4*)(dst + 8 * i) = w; }
    }
    asm volatile("s_waitcnt lgkmcnt(0)\n\ts_barrier" ::: "memory");
#undef ATT_DMA
#undef ATT_TILE
}
}

__device__ __forceinline__ void gqa_unit_fast(Frame& F, int v, bool cu) {
    const int nblk = cu ? 2 : 64, bh = v / nblk, blk = v % nblk, b = bh >> 1, hk = bh & 1, hq = 2 * hk + (F.wave >> 2), t0 = blk * 128 + (F.wave & 3) * 32;
    const int nq = cu ? LC : S;
    const bf16_t* Qw = F.SEAM + (cu ? SE_QGC : SE_QG) + (((size_t)b * 4 + hq) * nq + t0) * 64;
    const size_t kvo = ((size_t)b * 2 + hk) * KV * 64;
    bf16_t* Yw = F.Y + (size_t)(cu ? ROWS_L + b * LC + t0 : b * S + t0) * D + 512 + hq * 64;
    att::attn_unit<0>((LAS char*)F.lds, Qw, F.SEAM + SE_KG + kvo, F.SEAM + SE_VG + kvo, cu ? LC / 64 : KV / 64, Yw, 0.f, 0.f, nullptr);
}
__device__ __forceinline__ void diff_unit_fast(Frame& F, int l, int v, bool cu) {
    const int nblk = cu ? 1 : 32, bh = v / nblk, blk = v % nblk, b = bh >> 2, h = bh & 3, t0 = blk * 256 + F.wave * 32;
    const int nq = cu ? LC : S;
    const bf16_t* Qw = F.SEAM + (cu ? SE_QDC : SE_QD) + (((size_t)b * 4 + h) * nq + t0) * 64;
    const size_t kvo = ((size_t)b * 4 + h) * KV * 64;
    bf16_t* Yw = F.Y + (size_t)(cu ? ROWS_L + b * LC + t0 : b * S + t0) * D + 768 + h * 64;
    att::attn_unit<1>((LAS char*)F.lds, Qw, F.SEAM + SE_KD + kvo, F.SEAM + SE_VD + kvo, cu ? LC / 64 : KV / 64, Yw, F.tab[TB_LAM + 2 * l], F.tab[TB_LAM + 2 * l + 1], F.in[I_DNG] + l * 64);
}
__device__ __forceinline__ void na_unit_fast(Frame& F, int l, int v) {
    const int bh = v >> 5, g = v & 31, b = bh >> 2, h = bh & 3, qrow = 4 * g + (F.wave >> 1), qc = F.wave & 1;
    int rmin = 4 * g - 4; rmin = rmin < 0 ? 0 : rmin; int rmax = 4 * g + 3 - 4; rmax = rmax < 0 ? 0 : (rmax > 120 ? 120 : rmax); rmax += 7;
    LAS float* nab = (LAS float*)(F.lds + att::L_NAB);
    const float* rpb = F.in[I_RPB] + ((size_t)l * 4 + h) * 15 * 31;
    if (F.tid < 15 * 32) { const int dr = F.tid >> 5, i = F.tid & 31; nab[F.tid] = (i < 31) ? rpb[dr * 31 + i] * LOG2E : 0.f; }
    const int t0 = qrow * 64 + 32 * qc;
    const bf16_t* Qw = F.SEAM + SE_QA + (((size_t)b * 4 + h) * S + t0) * 64;
    const size_t kvo = ((size_t)b * 4 + h) * KV * 64;
    att::attn_unit<2>((LAS char*)F.lds, Qw, F.SEAM + SE_KA + kvo, F.SEAM + SE_VA + kvo, 4 + (rmax - rmin + 1), F.Y + (size_t)(b * S + t0) * D + h * 64, 0.f, 0.f, nullptr, rmin, qrow, qc);
}
__device__ __forceinline__ void nactx_unit_fast(Frame& F, int v) {
    const int b = v >> 2, h = v & 3, t0 = F.wave * 32;
    const size_t kvo = ((size_t)b * 4 + h) * KV * 64;
    att::attn_unit<0>((LAS char*)F.lds, F.SEAM + SE_QAC + (((size_t)b * 4 + h) * LC + t0) * 64, F.SEAM + SE_KA + kvo, F.SEAM + SE_VA + kvo, LC / 64, F.Y + (size_t)(ROWS_L + b * LC + t0) * D + h * 64, 0.f, 0.f, nullptr);
}
__device__ __forceinline__ void phase_attn_fast(Frame& F, int l, bool with_ctx) {
    const int v = vcu_of(F);
    if (FAST_NA_LAT) {
#pragma unroll 1
        for (int u = v; u < 256; u += F.G) na_unit_fast(F, l, u); }
    if (with_ctx && FAST_NA_CTX) {
#pragma unroll 1
        for (int u = v - 16; u >= 0 && u < 8; u += F.G) nactx_unit_fast(F, u);
    }
#pragma unroll 1
    for (int u = v; u < 256; u += F.G) gqa_unit_fast(F, u, false);
#pragma unroll 1
    for (int u = v; u < 256; u += F.G) diff_unit_fast(F, l, u, false);
    if (with_ctx) {
#pragma unroll 1
        for (int u = v; u < 8; u += F.G) gqa_unit_fast(F, u, true);
#pragma unroll 1
        for (int u = F.G - 1 - v; u < 8; u += F.G) diff_unit_fast(F, l, u, true);
    }
}


static_assert(!(FAST_CONV && !FAST_OUTPROJ), "the folded pointwise projection lives in the fast out-proj weights");
constexpr int TB_BP = TB_BP_;
__device__ __forceinline__ void phase_conv_fast(Frame& F, int l, bool with_ctx) {
    const int c0 = 4 * F.lane;
    LAS float* wl = (LAS float*)F.lds;
    LAS bf16_t* zl = (LAS bf16_t*)(F.lds + 32768);
    for (int i = F.tid; i < 31 * 256; i += NTHR) wl[i] = F.in[I_DWW][(size_t)l * 31 * 256 + i];
    const f32x4 bias = *(const f32x4*)(F.in[I_DWB] + l * 256 + c0), lg = *(const f32x4*)(F.in[I_LNG] + l * 256 + c0), lb = *(const f32x4*)(F.in[I_LNB] + l * 256 + c0);
    const bf16_t* Z = F.SEAM + SE_Z;
    const int nu = (with_ctx ? ROWS : ROWS_L) / 64;
#pragma unroll 1
    for (int u = F.bid; u < nu; u += F.G) {
        const int row0 = u * 64; const bool isc = row0 >= ROWS_L;
        const int sb = isc ? ROWS_L + ((row0 - ROWS_L) / LC) * LC : (row0 / S) * S, se = sb + (isc ? LC : S);
        __syncthreads();
        for (int i = F.tid; i < 94 * 32; i += NTHR) { const int rr = i >> 5, ch = i & 31; const int grow = row0 - 15 + rr;
            u32x4 v = (u32x4){0u, 0u, 0u, 0u}; if (grow >= sb && grow < se) v = *(const u32x4*)(Z + (size_t)grow * 256 + ch * 8);
            *(LAS u32x4*)(zl + rr * 256 + ch * 8) = v; }
        __syncthreads();
#pragma unroll 1
        for (int tt = 0; tt < 8; ++tt) {
            const int tok = F.wave * 8 + tt;
            f32x4 a = bias;
#pragma unroll
            for (int k = 0; k < 31; ++k) { const u32x2 zz = *(const LAS u32x2*)(zl + (tok + k) * 256 + c0); const f32x4 wv = *(const LAS f32x4*)(wl + k * 256 + c0);
                a += (f32x4){bflo(zz.x), bfhi(zz.x), bflo(zz.y), bfhi(zz.y)} * wv; }
            const float mu = wave_sum((a[0] + a[1]) + (a[2] + a[3])) * (1.f / 256.f);
            const f32x4 d = a - mu;
            const float rs = 1.f / sqrtf(wave_sum((d[0] * d[0] + d[1] * d[1]) + (d[2] * d[2] + d[3] * d[3])) * (1.f / 256.f) + EPS);
            f32x4 y = d * rs * lg + lb;
#pragma unroll
            for (int j = 0; j < 4; ++j) y[j] = y[j] * fast_sigmoid(y[j]);
            uint2 o; o.x = cvt_pk_bf16(y[0], y[1]); o.y = cvt_pk_bf16(y[2], y[3]);
            *(uint2*)(F.Y + (size_t)(row0 + tok) * D + 256 + c0) = o;
        }
    }
    __syncthreads();
}
__device__ __forceinline__ void phase_fold_bias(Frame& F) {
    for (int i = F.bid * NTHR + F.tid; i < DEPTH * D; i += F.G * NTHR) {
        const int l = i / D, n = i % D; float a = 0.f;
        if (FAST_CONV_FOLD) for (int c = 0; c < 256; ++c) a += F.in[I_PWB][l * 256 + c] * F.in[I_WOUT][((size_t)l * D + 256 + c) * D + n];
        F.tab[TB_BP + i] = a;
    }
}
__device__ __forceinline__ void fold_item(const float* pw, const float* wo, int n0, int k0, bf16_t* WTrow0, LAS float* scr, int lane) {
    const int n = lane & 31, kh = lane >> 5;
    float acc[32];
#pragma unroll
    for (int i = 0; i < 32; ++i) acc[i] = 0.f;
#pragma unroll 1
    for (int cp = 0; cp < 256; ++cp) {
        const float b = wo[(size_t)(256 + cp) * D + n0 + n];
#pragma unroll
        for (int i = 0; i < 32; ++i) acc[i] += pw[(size_t)(k0 - 256 + 2 * i + kh) * 256 + cp] * b;
    }
#pragma unroll
    for (int i = 0; i < 32; ++i) scr[(2 * i + kh) * 33 + n] = acc[i];
    asm volatile("s_waitcnt lgkmcnt(0)" ::: "memory");
    const int c = lane & 7;
#pragma unroll
    for (int j = 0; j < 4; ++j) { const int nn = (lane >> 3) + 8 * j; const LAS float* s_ = scr + (8 * c) * 33 + nn;
        u32x4 o; o.x = pk2(s_[0 * 33], s_[1 * 33]); o.y = pk2(s_[2 * 33], s_[3 * 33]); o.z = pk2(s_[4 * 33], s_[5 * 33]); o.w = pk2(s_[6 * 33], s_[7 * 33]);
        *(u32x4*)(WTrow0 + (size_t)nn * D + k0 + 8 * c) = o; }
    asm volatile("s_waitcnt lgkmcnt(0)" ::: "memory");
}


#ifndef FAST_SELECT
#define FAST_SELECT 1
#endif
__device__ __forceinline__ void phase_select_fast(Frame& F, bool with_ctx) {
    LAS unsigned* hist = (LAS unsigned*)F.lds;
    LAS unsigned* sm = hist + 256;
    for (int i = F.bid * NTHR + F.tid; i < NE * EPAD; i += F.G * NTHR) { const int sl = i % EPAD; if (sl >= (with_ctx ? ESLOTS : 2 * CAP_L)) { F.RIDX[i] = -1; F.GATE[i] = 0.f; } }
    const int NL = with_ctx ? 64 : 32;
#pragma unroll 1
    for (int u = F.bid; u < NL; u += F.G) {
        const bool isc = u >= 32; const int li = isc ? u - 32 : u, b = li / NE, e = li % NE;
        const int N = isc ? LC : S, C = isc ? CAP_C : CAP_L, row0 = isc ? ROWS_L + b * LC : b * S;
        unsigned key[16];
#pragma unroll
        for (int j = 0; j < 16; ++j) { const int n = F.tid * 16 + j; key[j] = (n < N) ? __float_as_uint(F.AFF[(size_t)(row0 + n) * NE + e]) : 0u; }
        unsigned prefix = 0u, mask = 0u, remaining = (unsigned)C;
#pragma unroll 1
        for (int pass = 0; pass < 4; ++pass) {
            const int shift = 24 - 8 * pass;
            __syncthreads();
            if (F.tid < 256) hist[F.tid] = 0u;
            __syncthreads();
#pragma unroll
            for (int j = 0; j < 16; ++j) { const int n = F.tid * 16 + j; if (n < N && (key[j] & mask) == prefix) __hip_atomic_fetch_add(&hist[(key[j] >> shift) & 255u], 1u, __ATOMIC_RELAXED, __HIP_MEMORY_SCOPE_WORKGROUP); }
            __syncthreads();
            if (F.tid < 256) {
                unsigned above = 0u;
                for (int i = F.tid + 1; i < 256; ++i) above += hist[i];
                const unsigned mine = hist[F.tid];
                if (above < remaining && above + mine >= remaining) { sm[0] = (unsigned)F.tid; sm[1] = remaining - above; }
            }
            __syncthreads();
            prefix |= sm[0] << shift; mask |= 255u << shift; remaining = sm[1];
        }
        const unsigned T = prefix, quota = remaining;
        unsigned cg = 0u, ce = 0u;
#pragma unroll
        for (int j = 0; j < 16; ++j) { const int n = F.tid * 16 + j; if (n < N) { cg += key[j] > T ? 1u : 0u; ce += key[j] == T ? 1u : 0u; } }
        unsigned pk = cg | (ce << 16), inc = pk;
#pragma unroll
        for (int o = 1; o < 64; o <<= 1) { const unsigned v = __shfl_up(inc, o); if (F.lane >= o) inc += v; }
        __syncthreads();
        if (F.lane == 63) sm[8 + F.wave] = inc;
        __syncthreads();
        unsigned wbase = 0u;
        for (int w = 0; w < F.wave; ++w) wbase += sm[8 + w];
        const unsigned excl = wbase + inc - pk;
        unsigned gb = excl & 0xffffu, eb = excl >> 16;
        const int base = isc ? 2 * CAP_L + b * CAP_C : b * CAP_L;
#pragma unroll
        for (int j = 0; j < 16; ++j) { const int n = F.tid * 16 + j;
            if (n < N) {
                int slot = -1;
                if (key[j] > T) { slot = (int)(gb + (eb < quota ? eb : quota)); ++gb; }
                else if (key[j] == T) { if (eb < quota) slot = (int)(gb + eb); ++eb; }
                F.SLOT[(size_t)(row0 + n) * NE + e] = slot;
                if (slot >= 0) { F.RIDX[e * EPAD + base + slot] = row0 + n; F.GATE[e * EPAD + base + slot] = __uint_as_float(key[j]); }
            } }
    }
    __syncthreads();
}

#ifndef PHMASK
#define PHMASK 0xffffffffu
#endif
#define REFRESH() do { asm volatile("" : "+v"(F.tid)); F.lane = F.tid & 63; F.wave = __builtin_amdgcn_readfirstlane(F.tid >> 6); } while (0)
#define PHX(i, call) do { if ((PHMASK >> (i)) & 1u) { REFRESH(); call; } } while (0)
constexpr int PH_PER_LAYER = 9;
constexpr int NPH = 1 + DEPTH * PH_PER_LAYER + 1;

__global__ void __launch_bounds__(NTHR, 2) mk_fwd(Args args) {
    extern __shared__ __attribute__((aligned(16))) unsigned char lds[];
    Frame F;
    F.lds = (LAS unsigned char*)lds;
    F.tid = threadIdx.x; F.lane = F.tid & 63; F.wave = __builtin_amdgcn_readfirstlane(F.tid >> 6);
    F.G = gridDim.x; F.bid = blockIdx.x;
    F.in = args.in; F.out = args.out; F.ws = args.ws;
    unsigned char* ws = args.ws;
    F.tab = (float*)(ws + WS_TAB); F.H = (float*)(ws + WS_H); F.U = (bf16_t*)(ws + WS_U); F.AFF = (float*)(ws + WS_AFF); F.SLOT = (int*)(ws + WS_SLOT);
    F.RIDX = (int*)(ws + WS_RIDX); F.GATE = (float*)(ws + WS_RIDX + 256 * 1024);
    F.SEAM = (bf16_t*)(ws + WS_SEAM); F.Y = (bf16_t*)(ws + WS_Y); F.HE = (bf16_t*)(ws + WS_HE); F.YE = (bf16_t*)(ws + WS_YE); F.P = (float*)(ws + WS_P);
    for (int u = F.tid; u < (LDS_BYTES - LDSCTL_OFF) / 4; u += NTHR) ((LAS unsigned*)(F.lds + LDSCTL_OFF))[u] = 0u;
    __syncthreads();
    XcdBarrier bar; bar.bar = (unsigned*)(ws + WS_CTL) + CW_BAR; bar.x = 0; bar.st = nullptr;
    const bool one = (MK_N_LAUNCHES == 1);
    if (one) bar = xcd_barrier_post((unsigned*)(ws + WS_CTL) + CW_BAR, (volatile LAS unsigned*)(F.lds + MISC_OFF) + 8);
    const int lo = args.ph_lo, hi = args.ph_hi;
#define IN(k) (lo <= (k) && (k) < hi)
#define SEAM_BAR(k) do { if (one && (k) + 1 < hi) xcd_barrier(bar); } while (0)
    if (IN(0)) { PHX(0, phase_prologue(F)); REFRESH(); phase_fold_bias(F); REFRESH(); phase_convert(F); SEAM_BAR(0); }
#pragma unroll 1
    for (int l = 0; l < DEPTH; ++l) {
        const int pb = 1 + l * PH_PER_LAYER; const bool wc = (l < DEPTH - 1);
        if (IN(pb + 0)) { REFRESH(); if (l == 0) phase_norm<0>(F, 0, true, -1, true); else phase_norm<0>(F, l, false, l - 1, true); SEAM_BAR(pb + 0); }
        if (IN(pb + 1)) { if (FAST_INPROJ) { REFRESH(); phase_inproj_fast(F, l); } else { PHX(1, phase_inproj_naive(F, l)); } SEAM_BAR(pb + 1); }
        if (IN(pb + 2)) { if (!FAST_INPROJ) { PHX(2, phase_post_naive(F, l)); SEAM_BAR(pb + 2); } }
        if (IN(pb + 3)) { if (FAST_CONV) { REFRESH(); phase_conv_fast(F, l, wc); } if (FAST_ATTN) { REFRESH(); phase_attn_fast(F, l, wc); } PHX(3, phase_mixers_naive(F, l, wc)); SEAM_BAR(pb + 3); }
        if (IN(pb + 4)) { if (FAST_OUTPROJ) { REFRESH(); phase_outproj_fast(F, l, wc); } else { PHX(4, phase_outproj_naive(F, l, wc)); } SEAM_BAR(pb + 4); }
        if (IN(pb + 5)) { PHX(5, phase_norm2_router(F, l, wc)); SEAM_BAR(pb + 5); }
        if (IN(pb + 6)) { if (FAST_SELECT) { REFRESH(); phase_select_fast(F, wc); } else { PHX(6, phase_select_naive(F, wc)); } SEAM_BAR(pb + 6); }
        if (IN(pb + 7)) { if (FAST_MOE) { REFRESH(); phase_moe1_fast(F, l, wc); } else { PHX(7, phase_moe1_naive(F, l, wc)); } SEAM_BAR(pb + 7); }
        if (IN(pb + 8)) { if (FAST_MOE) { REFRESH(); phase_moe2_fast(F, l, wc); } else { PHX(8, phase_moe2_naive(F, l, wc)); } SEAM_BAR(pb + 8); }
    }
    if (IN(NPH - 1)) { REFRESH(); phase_norm<2>(F, 0, false, DEPTH - 1, false); }
#undef IN
#undef SEAM_BAR
}

extern "C" void kernel_launch(void* const* d_in, const int* in_sizes, int n_in, void* d_out, int out_size, void* d_ws, size_t ws_size, hipStream_t stream) {
    static int grid = 0;
    if (grid == 0) {
        if (n_in != N_IN || out_size != ROWS_L * D || ws_size < WS_END) { fprintf(stderr, "kernel_launch: unexpected shapes (n_in %d out %d ws %zu)\n", n_in, out_size, ws_size); grid = -1; return; }
        int dev = 0, cus = 0, per_cu = 0;
        if (hipGetDevice(&dev) != hipSuccess || hipDeviceGetAttribute(&cus, hipDeviceAttributeMultiprocessorCount, dev) != hipSuccess) { grid = -1; return; }
        if (hipFuncSetAttribute((const void*)mk_fwd, hipFuncAttributeMaxDynamicSharedMemorySize, LDS_BYTES) != hipSuccess) { fprintf(stderr, "kernel_launch: hipFuncSetAttribute failed\n"); grid = -1; return; }
        if (hipOccupancyMaxActiveBlocksPerMultiprocessor(&per_cu, (const void*)mk_fwd, NTHR, LDS_BYTES) != hipSuccess || per_cu < 1) { fprintf(stderr, "kernel_launch: occupancy query says %d\n", per_cu); per_cu = 1; }
        (void)hipGetLastError();
        grid = cus;
    }
    if (grid < 0) return;
    (void)hipMemsetAsync((char*)d_ws + WS_CTL, 0, CTL_ZERO_BYTES, stream);
    Args a{};
    for (int i = 0; i < N_IN; ++i) a.in[i] = (const float*)d_in[i];
    a.out = (float*)d_out; a.ws = (unsigned char*)d_ws;
    if (MK_N_LAUNCHES == 1) { a.ph_lo = 0; a.ph_hi = NPH; hipLaunchKernelGGL(mk_fwd, dim3(grid), dim3(NTHR), LDS_BYTES, stream, a); }
    else for (int p = 0; p < NPH; ++p) { a.ph_lo = p; a.ph_hi = p + 1; hipLaunchKernelGGL(mk_fwd, dim3(grid), dim3(NTHR), LDS_BYTES, stream, a); }
}
```

```cpp
#include <hip/hip_runtime.h>
#include <cstdio>
#include <cstdint>

#ifndef FAST_CONV
#define FAST_CONV 1
#endif
#ifndef REPEAT_MASK
#define REPEAT_MASK 0
#endif
#define RPT(bit) (1 + ((rep_mask >> (bit)) & 1))
#ifndef MK_N_LAUNCHES
#define MK_N_LAUNCHES 1
#endif

constexpr int D = 1024, NB = 2, S = 8192, LC = 256, DEPTH = 2;
constexpr int ROWS_L = NB * S;
constexpr int ROWS_C = NB * LC;
constexpr int ROWS = ROWS_L + ROWS_C;
constexpr int KV = LC + S;
constexpr int DIN = 2560;
constexpr int NE = 16, CAP_L = 1024, CAP_C = 32;
constexpr int ESLOTS = 2 * CAP_L + 2 * CAP_C;
constexpr int EPAD = 2304;
constexpr float EPS = 1e-6f;
constexpr float LOG2E = 1.4426950408889634f;
constexpr int NWAVES = 8, NTHR = 512;

typedef unsigned short bf16_t;
typedef unsigned u32x4 __attribute__((ext_vector_type(4)));
typedef unsigned u32x2 __attribute__((ext_vector_type(2)));
typedef float f32x4 __attribute__((ext_vector_type(4)));

constexpr size_t MiB = 1u << 20;
constexpr size_t WS_CTL = 0;
constexpr size_t CTL_ZERO_BYTES = 64 * 1024;
constexpr size_t WS_TAB = 1 * MiB;
constexpr size_t WS_H = 2 * MiB;
constexpr size_t WS_U = 68 * MiB;
constexpr size_t WS_AFF = 101 * MiB;
constexpr size_t WS_SLOT = 103 * MiB;
constexpr size_t WS_RIDX = 105 * MiB;
constexpr size_t WS_WBF = 106 * MiB;
constexpr size_t WS_R = 314 * MiB;
constexpr size_t WS_END = 458 * MiB;
constexpr size_t WS_P = WS_WBF;
constexpr size_t WS_SEAM = WS_R;
constexpr size_t WS_Y = WS_R + 83 * MiB;
constexpr size_t WS_HE = WS_R;
constexpr size_t WS_YE = WS_R + 72 * MiB;

constexpr size_t SE_QA = 0;
constexpr size_t SE_QAC = SE_QA + (size_t)NB * 4 * S * 64;
constexpr size_t SE_KA = SE_QAC + (size_t)NB * 4 * LC * 64;
constexpr size_t SE_VA = SE_KA + (size_t)NB * 4 * KV * 64;
constexpr size_t SE_Z = SE_VA + (size_t)NB * 4 * KV * 64;
constexpr size_t SE_QG = SE_Z + (size_t)ROWS * 256;
constexpr size_t SE_QGC = SE_QG + (size_t)NB * 4 * S * 64;
constexpr size_t SE_KG = SE_QGC + (size_t)NB * 4 * LC * 64;
constexpr size_t SE_VG = SE_KG + (size_t)NB * 2 * KV * 64;
constexpr size_t SE_QD = SE_VG + (size_t)NB * 2 * KV * 64;
constexpr size_t SE_QDC = SE_QD + (size_t)NB * 4 * S * 64;
constexpr size_t SE_KD = SE_QDC + (size_t)NB * 4 * LC * 64;
constexpr size_t SE_VD = SE_KD + (size_t)NB * 4 * KV * 64;
constexpr size_t SE_END = SE_VD + (size_t)NB * 4 * KV * 64;
static_assert(SE_END == (size_t)ROWS * (DIN - 256), "seam map");
static_assert(SE_END * 2 <= 83 * MiB, "seam fits");

constexpr int TB_C64 = 0;
constexpr int TB_S64 = 2048;
constexpr int TB_C32 = 4096;
constexpr int TB_S32 = 5120;
constexpr int TB_MOD = 8192;
constexpr int TB_LAM = TB_MOD + DEPTH * 3 * 6144;
constexpr int TB_BP_ = TB_LAM + 2 * DEPTH;

constexpr int CW_BAR = 1024;

enum { I_X = 0, I_C, I_CTX, I_CCTX, I_N1G, I_WMOD, I_BMOD, I_WIN, I_RPB, I_DWW, I_DWB, I_LNG, I_LNB, I_PWW, I_PWB,
       I_QNG, I_KNG, I_LQ1, I_LK1, I_LQ2, I_LK2, I_DNG, I_WOUT, I_N2G, I_WR, I_WG, I_WU, I_WD, I_FG, N_IN };

constexpr int LDS_BYTES = 147456;
constexpr int MISC_OFF = 131072 + 320;
constexpr int LDSCTL_OFF = 131072;

#define GAS __attribute__((address_space(1)))
#define LAS __attribute__((address_space(3)))

__device__ __forceinline__ float bf2f(bf16_t v) { return __uint_as_float((unsigned)v << 16); }
__device__ __forceinline__ unsigned f2bf(float f) { unsigned u = __float_as_uint(f); return (u + 0x7fffu + ((u >> 16) & 1u)) >> 16; }
__device__ __forceinline__ unsigned pk2(float lo, float hi) { return f2bf(lo) | (f2bf(hi) << 16); }
__device__ __forceinline__ float bflo(unsigned w) { return __uint_as_float(w << 16); }
__device__ __forceinline__ float bfhi(unsigned w) { return __uint_as_float(w & 0xffff0000u); }
__device__ __forceinline__ float wave_sum(float v) {
#pragma unroll
    for (int o = 1; o < 64; o <<= 1) v += __shfl_xor(v, o);
    return v;
}
__device__ __forceinline__ float silu_f(float x) { return x / (1.f + __expf(-x)); }
__device__ __forceinline__ int vzero() { int z; asm volatile("v_mov_b32 %0, 0" : "=v"(z)); return z; }

#define XB_TMO      128
#define XB_XCNT(j)  (256  + 64 * (j))
#define XB_XSUB(j)  (1280 + 64 * (j))
#define XB_XGEN(j)  (2304 + 64 * (j))
#define XB_TOP      3328
#define XB_TOPGEN   3392
#define XCD_BAR_WORDS 3456
#define XB_SPIN_CAP (1u << 22)
__device__ __forceinline__ unsigned xb_ld(unsigned* p)              { return __hip_atomic_load(p, __ATOMIC_RELAXED, __HIP_MEMORY_SCOPE_AGENT); }
__device__ __forceinline__ unsigned xb_add(unsigned* p, unsigned v) { return __hip_atomic_fetch_add(p, v, __ATOMIC_RELAXED, __HIP_MEMORY_SCOPE_AGENT); }
__device__ __forceinline__ unsigned xb_xcc_id() { return (unsigned)__builtin_amdgcn_s_getreg((3 << 11) | 20) & 0xFu; }
#define XB_SPIN(cond, bar) do { unsigned _sp = 0; while (cond) { __builtin_amdgcn_s_sleep(1); \
    if ((++_sp & 255u) == 0u) { if (xb_ld(&(bar)[XB_TMO])) break; if (_sp > XB_SPIN_CAP) { atomicAdd(&(bar)[XB_TMO], 1u); break; } } } } while (0)
struct XcdBarrier { unsigned* bar; unsigned x; volatile LAS unsigned* st; };
__device__ __forceinline__ XcdBarrier xcd_barrier_post(unsigned* bar, volatile LAS unsigned* st) {
    XcdBarrier b; b.bar = bar; b.x = xb_xcc_id(); b.st = st;
    if (threadIdx.x == 0) (void)xb_add(&bar[XB_XCNT(b.x)], 1u);
    return b;
}
__device__ __forceinline__ void xcd_barrier_complete(unsigned* bar, unsigned x, unsigned& nloc, unsigned& nx) {
    const unsigned G = gridDim.x * gridDim.y * gridDim.z;
    unsigned sum, cnt, mine, sp = 0u;
    for (;;) {
        sum = 0u; cnt = 0u; mine = 0u;
#pragma unroll
        for (unsigned j = 0; j < 16; ++j) { const unsigned c = xb_ld(&bar[XB_XCNT(j)]); sum += c; cnt += (c > 0u) ? 1u : 0u; mine = (j == x) ? c : mine; }
        if (sum == G) break;
        __builtin_amdgcn_s_sleep(1);
        if ((++sp & 255u) == 0u) { if (xb_ld(&bar[XB_TMO])) break; if (sp > XB_SPIN_CAP) { atomicAdd(&bar[XB_TMO], 1u); break; } }
    }
    nloc = mine > 0u ? mine : 1u; nx = cnt > 0u ? cnt : 1u;
}
__device__ __forceinline__ void xcd_barrier(const XcdBarrier& b) {
    asm volatile("s_waitcnt vmcnt(0)" ::: "memory");
    __syncthreads();
    if (threadIdx.x == 0) {
        unsigned* bar = b.bar;
        __builtin_amdgcn_s_waitcnt(0);
        unsigned nloc = b.st[0], nx = b.st[1];
        if (nloc == 0u) { xcd_barrier_complete(bar, b.x, nloc, nx); b.st[0] = nloc; b.st[1] = nx; }
        const unsigned old = xb_add(&bar[XB_XSUB(b.x)], 1u);
        const unsigned gen = old / nloc;
        if (old + 1u == (gen + 1u) * nloc) {
            __builtin_amdgcn_fence(__ATOMIC_RELEASE, "agent");
            asm volatile("s_waitcnt vmcnt(0)" ::: "memory");
            const unsigned og = xb_add(&bar[XB_TOP], 1u);
            const unsigned tg = og / nx;
            if (og + 1u == (tg + 1u) * nx) xb_add(&bar[XB_TOPGEN], 1u);
            else XB_SPIN(xb_ld(&bar[XB_TOPGEN]) == tg, bar);
            __builtin_amdgcn_fence(__ATOMIC_ACQUIRE, "agent");
            xb_add(&bar[XB_XGEN(b.x)], 1u);
            asm volatile("s_waitcnt vmcnt(0)" ::: "memory");
        } else {
            XB_SPIN(xb_ld(&bar[XB_XGEN(b.x)]) == gen, bar);
            __builtin_amdgcn_fence(__ATOMIC_ACQUIRE, "agent");
            asm volatile("s_waitcnt vmcnt(0)" ::: "memory");
        }
    }
    __syncthreads();
}

struct Args { const float* in[N_IN]; float* out; unsigned char* ws; int ph_lo, ph_hi; int rep_mask, pad; };
struct Frame {
    LAS unsigned char* lds;
    int tid, lane, wave, G, bid;
    const float* const* in;
    float* out; unsigned char* ws;
    float* tab; float* H; bf16_t* U; float* AFF; int* SLOT; int* RIDX; float* GATE;
    bf16_t* SEAM; bf16_t* Y; bf16_t* HE; bf16_t* YE; float* P;
};

__device__ __forceinline__ double inv_freq(int f, int nf) {
    const double r16 = 0.5623413251903491;
    const int steps = (nf == 16) ? f : 2 * f;
    double v = 1.0;
    for (int i = 0; i < steps; ++i) v *= r16;
    return v;
}
__device__ __forceinline__ void sincos_d(double x, double& s, double& c) {
    const double TWO_PI = 6.283185307179586476925286766559;
    const double k = __builtin_rint(x / TWO_PI);
    const double r = x - k * TWO_PI;
    const double r2 = r * r;
    double ts = 1.0, tc = 1.0, ss = 1.0, cs = 1.0;
#pragma unroll 1
    for (int n = 1; n <= 14; ++n) {
        tc *= -r2 / (double)((2 * n - 1) * (2 * n));
        ts *= -r2 / (double)((2 * n) * (2 * n + 1));
        cs += tc; ss += ts;
    }
    s = r * ss; c = cs;
}

__device__ __forceinline__ void phase_prologue(Frame& F) {
    const int gt = F.bid * NTHR + F.tid, NGT = F.G * NTHR;
    for (int i = gt; i < 128 * 16 + 128 * 8; i += NGT) {
        if (i < 2048) { const int pos = i >> 4, f = i & 15; double s, c; sincos_d((double)pos * inv_freq(f, 16), s, c); F.tab[TB_C64 + i] = (float)c; F.tab[TB_S64 + i] = (float)s; }
        else { const int j = i - 2048, pos = j >> 3, f = j & 7; double s, c; sincos_d((double)pos * inv_freq(f, 8), s, c); F.tab[TB_C32 + j] = (float)c; F.tab[TB_S32 + j] = (float)s; }
    }
    if (gt < DEPTH) {
        const int l = gt; float a = 0.f, b = 0.f;
        for (int i = 0; i < 32; ++i) { a += F.in[I_LQ1][l * 32 + i] * F.in[I_LK1][l * 32 + i]; b += F.in[I_LQ2][l * 32 + i] * F.in[I_LK2][l * 32 + i]; }
        const float lam_init = 0.8f - 0.6f * expf(-0.3f * (float)l);
        F.tab[TB_LAM + 2 * l] = expf(a) - expf(b) + lam_init; F.tab[TB_LAM + 2 * l + 1] = 1.f - lam_init;
    }
    LAS float* red = (LAS float*)F.lds;
    LAS float* sl = red + 8 * 3 * 64;
    for (int i = F.tid; i < 3 * D; i += NTHR) sl[i] = silu_f(i < 2 * D ? F.in[I_C][i] : F.in[I_CCTX][i - 2 * D]);
    __syncthreads();
    for (int u = F.bid; u < DEPTH * 96; u += F.G) {
        const int l = u / 96, n0 = (u % 96) * 64, ks = F.tid >> 6, nn = F.tid & 63;
        const float* W = F.in[I_WMOD] + (size_t)l * D * 6144 + n0 + nn;
        float a0 = 0.f, a1 = 0.f, a2 = 0.f;
#pragma unroll 8
        for (int k = ks * 128; k < ks * 128 + 128; ++k) {
            const float w = W[(size_t)k * 6144];
            a0 += sl[k] * w; a1 += sl[D + k] * w; a2 += sl[2 * D + k] * w;
        }
        red[(ks * 3 + 0) * 64 + nn] = a0; red[(ks * 3 + 1) * 64 + nn] = a1; red[(ks * 3 + 2) * 64 + nn] = a2;
        __syncthreads();
        if (F.tid < 192) { const int v = F.tid >> 6; float s = 0.f;
            for (int q = 0; q < 8; ++q) s += red[(q * 3 + v) * 64 + nn];
            F.tab[TB_MOD + (l * 3 + v) * 6144 + n0 + nn] = s + F.in[I_BMOD][l * 6144 + n0 + nn]; }
        __syncthreads();
    }
}

template <int MODE> __device__ __forceinline__ void phase_norm(Frame& F, int l, bool src0, int comb_l, bool with_ctx) {
    const int gw = F.bid * NWAVES + F.wave, NGW = F.G * NWAVES;
    const int nrows = with_ctx ? ROWS : ROWS_L;
    for (int r = gw; r < nrows; r += NGW) {
        const bool isc = r >= ROWS_L; const int b = isc ? (r - ROWS_L) / LC : r / S; const int mv = isc ? 2 : b;
        const float* src = src0 ? (isc ? F.in[I_CTX] + (size_t)(r - ROWS_L) * D : F.in[I_X] + (size_t)r * D) : F.H + (size_t)r * D;
        f32x4 v[4];
#pragma unroll
        for (int j = 0; j < 4; ++j) v[j] = *(const f32x4*)(src + 4 * F.lane + 256 * j);
        if (comb_l >= 0) {
            const float* g2 = F.tab + TB_MOD + (comb_l * 3 + mv) * 6144 + 5 * D;
            const int* sl = F.SLOT + (size_t)r * 16;
            f32x4 acc[4];
#pragma unroll
            for (int j = 0; j < 4; ++j) acc[j] = (f32x4){0.f, 0.f, 0.f, 0.f};
            for (int e = 0; e < NE; ++e) {
                const int s_ = sl[e];
                if (s_ >= 0) {
                    const int base = isc ? 2 * CAP_L + b * CAP_C : b * CAP_L;
                    const bf16_t* y = F.YE + ((size_t)e * EPAD + base + s_) * D;
#pragma unroll
                    for (int j = 0; j < 4; ++j) { const uint2 w = *(const uint2*)(y + 4 * F.lane + 256 * j);
                        acc[j][0] += bflo(w.x); acc[j][1] += bfhi(w.x); acc[j][2] += bflo(w.y); acc[j][3] += bfhi(w.y); }
                }
            }
#pragma unroll
            for (int j = 0; j < 4; ++j) { const f32x4 g = *(const f32x4*)(g2 + 4 * F.lane + 256 * j); v[j] += g * acc[j]; *(f32x4*)(F.H + (size_t)r * D + 4 * F.lane + 256 * j) = v[j]; }
        }
        float ss = 0.f;
#pragma unroll
        for (int j = 0; j < 4; ++j) ss += (v[j][0] * v[j][0] + v[j][1] * v[j][1]) + (v[j][2] * v[j][2] + v[j][3] * v[j][3]);
        const float rs = 1.f / sqrtf(wave_sum(ss) * (1.f / D) + EPS);
        if (MODE == 2) {
#pragma unroll
            for (int j = 0; j < 4; ++j) { const f32x4 g = *(const f32x4*)(F.in[I_FG] + 4 * F.lane + 256 * j); *(f32x4*)(F.out + (size_t)r * D + 4 * F.lane + 256 * j) = v[j] * rs * g; }
        } else {
            const float* md = F.tab + TB_MOD + (l * 3 + mv) * 6144;
            const float* ng = F.in[I_N1G] + l * D;
#pragma unroll
            for (int j = 0; j < 4; ++j) { const int c0 = 4 * F.lane + 256 * j; const f32x4 g = *(const f32x4*)(ng + c0), sh = *(const f32x4*)(md + c0), sc = *(const f32x4*)(md + D + c0);
                const f32x4 u = (v[j] * rs * g) * (1.f + sc) + sh; uint2 w; w.x = pk2(u[0], u[1]); w.y = pk2(u[2], u[3]); *(uint2*)(F.U + (size_t)r * D + c0) = w; }
        }
    }
}

__device__ __forceinline__ void phase_norm2_router(Frame& F, int l, bool with_ctx) {
    LAS float* wr = (LAS float*)F.lds;
    LAS float* lgs = (LAS float*)(F.lds + 65536) + F.wave * 16;
    for (int i = F.tid; i < D * NE / 4; i += NTHR) { const f32x4 t = *(const f32x4*)(F.in[I_WR] + (size_t)l * D * NE + 4 * i); const int k = i >> 2, e0 = (i & 3) * 4;
        wr[(e0 + 0) * D + k] = t[0]; wr[(e0 + 1) * D + k] = t[1]; wr[(e0 + 2) * D + k] = t[2]; wr[(e0 + 3) * D + k] = t[3]; }
    __syncthreads();
    const int gw = F.bid * NWAVES + F.wave, NGW = F.G * NWAVES;
    const int nrows = with_ctx ? ROWS : ROWS_L;
#pragma unroll 1
    for (int r = gw; r < nrows; r += NGW) {
        const bool isc = r >= ROWS_L; const int b = isc ? (r - ROWS_L) / LC : r / S; const int mv = isc ? 2 : b;
        const float* src = F.H + (size_t)r * D;
        const float* md = F.tab + TB_MOD + (l * 3 + mv) * 6144;
        const float* ng = F.in[I_N2G] + l * D;
        f32x4 v[4]; float ss = 0.f;
#pragma unroll
        for (int j = 0; j < 4; ++j) { v[j] = *(const f32x4*)(src + 4 * F.lane + 256 * j); ss += (v[j][0] * v[j][0] + v[j][1] * v[j][1]) + (v[j][2] * v[j][2] + v[j][3] * v[j][3]); }
        const float rs = 1.f / sqrtf(wave_sum(ss) * (1.f / D) + EPS);
        float lg[NE];
#pragma unroll
        for (int e = 0; e < NE; ++e) lg[e] = 0.f;
#pragma unroll
        for (int j = 0; j < 4; ++j) { const int c0 = 4 * F.lane + 256 * j; const f32x4 g = *(const f32x4*)(ng + c0), sh = *(const f32x4*)(md + 3 * D + c0), sc = *(const f32x4*)(md + 4 * D + c0);
            const f32x4 u = (v[j] * rs * g) * (1.f + sc) + sh; uint2 w; w.x = pk2(u[0], u[1]); w.y = pk2(u[2], u[3]); *(uint2*)(F.U + (size_t)r * D + c0) = w;
#pragma unroll
            for (int e = 0; e < NE; ++e) { const f32x4 ww = *(const LAS f32x4*)(wr + e * D + c0); lg[e] += (u[0] * ww[0] + u[1] * ww[1]) + (u[2] * ww[2] + u[3] * ww[3]); }
            asm volatile("" ::: "memory");
        }
#define RS_STEP(N, OFF) _Pragma("unroll") for (int i = 0; i < (N) / 2; ++i) { const bool up = (F.lane & (OFF)) != 0; const float keep = up ? lg[i + (N) / 2] : lg[i], send = up ? lg[i] : lg[i + (N) / 2]; lg[i] = keep + __shfl_xor(send, (OFF)); }
        RS_STEP(16, 32) RS_STEP(8, 16) RS_STEP(4, 8) RS_STEP(2, 4)
#undef RS_STEP
        float x = lg[0]; x += __shfl_xor(x, 2); x += __shfl_xor(x, 1);
        const int ex = ((F.lane >> 5) & 1) * 8 + ((F.lane >> 4) & 1) * 4 + ((F.lane >> 3) & 1) * 2 + ((F.lane >> 2) & 1);
        if ((F.lane & 3) == 0) lgs[ex] = x;
        asm volatile("s_waitcnt lgkmcnt(0)" ::: "memory");
        float q[NE]; float mx = -1e30f;
#pragma unroll
        for (int e4 = 0; e4 < 4; ++e4) { const f32x4 t = *(const LAS f32x4*)(lgs + 4 * e4); q[4 * e4] = t[0]; q[4 * e4 + 1] = t[1]; q[4 * e4 + 2] = t[2]; q[4 * e4 + 3] = t[3]; }
#pragma unroll
        for (int e = 0; e < NE; ++e) mx = fmaxf(mx, q[e]);
        float sm = 0.f, mine = 0.f;
#pragma unroll
        for (int e = 0; e < NE; ++e) { q[e] = expf(q[e] - mx); sm += q[e]; mine = (F.lane == e) ? q[e] : mine; }
        if (F.lane < NE) F.AFF[(size_t)r * NE + F.lane] = mine / sm;
        asm volatile("s_waitcnt lgkmcnt(0)" ::: "memory");
    }
    __syncthreads();
}

__device__ __forceinline__ void phase_select_naive(Frame& F, bool with_ctx) {
    LAS float* col = (LAS float*)F.lds;
    const int NU = 32 * 16 + (with_ctx ? 32 : 0);
    for (int i = F.bid * NTHR + F.tid; i < NE * EPAD; i += F.G * NTHR) { const int sl = i % EPAD; if (sl >= (with_ctx ? ESLOTS : 2 * CAP_L)) { F.RIDX[i] = -1; F.GATE[i] = 0.f; } }
    for (int u = F.bid; u < NU; u += F.G) {
        const bool isc = u >= 512; const int li = isc ? u - 512 : u / 16, ch = isc ? 0 : u % 16, b = li / NE, e = li % NE;
        const int N = isc ? LC : S, C = isc ? CAP_C : CAP_L, row0 = isc ? ROWS_L + b * LC : b * S;
        __syncthreads();
        for (int i = F.tid; i < N; i += NTHR) col[i] = F.AFF[(size_t)(row0 + i) * NE + e];
        __syncthreads();
        const int n = ch * 512 + F.tid;
        if (n < N) {
            const float a = col[n]; int rank = 0;
            for (int m = 0; m < N; ++m) { const float x = col[m]; rank += (x > a || (x == a && m < n)) ? 1 : 0; }
            if (rank < C) { const int sl = (isc ? 2 * CAP_L + b * CAP_C : b * CAP_L) + rank; F.RIDX[e * EPAD + sl] = row0 + n; F.GATE[e * EPAD + sl] = a; F.SLOT[(size_t)(row0 + n) * NE + e] = rank; }
            else F.SLOT[(size_t)(row0 + n) * NE + e] = -1;
        }
    }
    __syncthreads();
}

struct NaiveEpi { int mode; int l; float* P; const float* hin; float* hout; const float* mod; bf16_t* HE; bf16_t* YE; const float* gate; };
template <bool DUAL> __device__ __forceinline__ void naive_gemm_tile(Frame& F, const bf16_t* A, int lda, const int* ridx, int m0, int M, const float* W, const float* W2, int ldw, int n0, int K, const NaiveEpi& E, int erow0) {
    LAS float* As = (LAS float*)F.lds;
    LAS float* Bs = As + 16 * 132;
    LAS float* Bs2 = Bs + 16 * 64;
    const int ty = F.tid >> 4, tx = F.tid & 15;
    float acc[4][4], acc2[4][4];
#pragma unroll
    for (int i = 0; i < 4; ++i)
#pragma unroll
        for (int j = 0; j < 4; ++j) { acc[i][j] = 0.f; acc2[i][j] = 0.f; }
    const int ar = F.tid >> 1, ah = F.tid & 1;
    long arow = -1;
    if (F.tid < 256) { const int m = m0 + ar; if (m < M) arow = ridx ? (long)ridx[m] : (long)m; }
    const int bk = (F.tid - 256) >> 4, bc = (F.tid - 256) & 15;
    for (int k0 = 0; k0 < K; k0 += 16) {
        __syncthreads();
        if (F.tid < 256) {
            u32x4 w = (u32x4){0u, 0u, 0u, 0u};
            if (arow >= 0) w = *(const u32x4*)(A + (size_t)arow * lda + k0 + ah * 8);
            const int kb = ah * 8;
            As[(kb + 0) * 132 + ar] = bflo(w.x); As[(kb + 1) * 132 + ar] = bfhi(w.x); As[(kb + 2) * 132 + ar] = bflo(w.y); As[(kb + 3) * 132 + ar] = bfhi(w.y);
            As[(kb + 4) * 132 + ar] = bflo(w.z); As[(kb + 5) * 132 + ar] = bfhi(w.z); As[(kb + 6) * 132 + ar] = bflo(w.w); As[(kb + 7) * 132 + ar] = bfhi(w.w);
        } else {
            *(LAS f32x4*)(Bs + bk * 64 + bc * 4) = *(const f32x4*)(W + (size_t)(k0 + bk) * ldw + n0 + bc * 4);
            if (DUAL) *(LAS f32x4*)(Bs2 + bk * 64 + bc * 4) = *(const f32x4*)(W2 + (size_t)(k0 + bk) * ldw + n0 + bc * 4);
        }
        __syncthreads();
#pragma unroll
        for (int k = 0; k < 16; ++k) {
            const f32x4 a = *(const LAS f32x4*)(As + k * 132 + ty * 4), b = *(const LAS f32x4*)(Bs + k * 64 + tx * 4);
#pragma unroll
            for (int i = 0; i < 4; ++i)
#pragma unroll
                for (int j = 0; j < 4; ++j) acc[i][j] += a[i] * b[j];
            if (DUAL) { const f32x4 b2 = *(const LAS f32x4*)(Bs2 + k * 64 + tx * 4);
#pragma unroll
                for (int i = 0; i < 4; ++i)
#pragma unroll
                    for (int j = 0; j < 4; ++j) acc2[i][j] += a[i] * b2[j]; }
        }
    }
#pragma unroll
    for (int i = 0; i < 4; ++i) {
        const int m = m0 + ty * 4 + i; if (m >= M) continue;
        const int c0 = n0 + tx * 4;
        if (E.mode == 0) { *(f32x4*)(E.P + (size_t)m * DIN + c0) = (f32x4){acc[i][0], acc[i][1], acc[i][2], acc[i][3]}; }
        else if (E.mode == 1) {
            const bool isc = m >= ROWS_L; const int b = isc ? (m - ROWS_L) / LC : m / S; const int mv = isc ? 2 : b;
            const f32x4 g = *(const f32x4*)(E.mod + (E.l * 3 + mv) * 6144 + 2 * D + c0);
            const float* hi_ = (E.hin == nullptr) ? (isc ? F.in[I_CTX] + (size_t)(m - ROWS_L) * D : F.in[I_X] + (size_t)m * D) : E.hin + (size_t)m * D;
            const f32x4 h = *(const f32x4*)(hi_ + c0);
            *(f32x4*)(E.hout + (size_t)m * D + c0) = h + g * (f32x4){acc[i][0], acc[i][1], acc[i][2], acc[i][3]};
        } else if (E.mode == 2) {
            uint2 w; w.x = pk2(silu_f(acc[i][0]) * acc2[i][0], silu_f(acc[i][1]) * acc2[i][1]); w.y = pk2(silu_f(acc[i][2]) * acc2[i][2], silu_f(acc[i][3]) * acc2[i][3]);
            *(uint2*)(E.HE + (size_t)(erow0 + m) * D + c0) = w;
        } else {
            const float g = E.gate[erow0 + m];
            uint2 w; w.x = pk2(g * acc[i][0], g * acc[i][1]); w.y = pk2(g * acc[i][2], g * acc[i][3]);
            *(uint2*)(E.YE + (size_t)(erow0 + m) * D + c0) = w;
        }
    }
}

__device__ __forceinline__ void phase_inproj_naive(Frame& F, int l) {
    NaiveEpi E{}; E.mode = 0; E.P = F.P;
    const int nM = ROWS / 128, nN = DIN / 64;
    for (int u = F.bid; u < nM * nN; u += F.G) { const int pm = u / nN, pn = u % nN;
        naive_gemm_tile<false>(F, F.U, D, nullptr, pm * 128, ROWS, F.in[I_WIN] + (size_t)l * D * DIN, nullptr, DIN, pn * 64, D, E, 0); }
    __syncthreads();
}
__device__ __forceinline__ void phase_outproj_naive(Frame& F, int l, bool with_ctx) {
    NaiveEpi E{}; E.mode = 1; E.l = l; E.hin = (l == 0) ? nullptr : F.H; E.hout = F.H; E.mod = F.tab + TB_MOD;
    const int M = with_ctx ? ROWS : ROWS_L; const int nM = M / 128, nN = D / 64;
    for (int u = F.bid; u < nM * nN; u += F.G) { const int pm = u / nN, pn = u % nN;
        naive_gemm_tile<false>(F, F.Y, D, nullptr, pm * 128, M, F.in[I_WOUT] + (size_t)l * D * D, nullptr, D, pn * 64, D, E, 0); }
    __syncthreads();
}
__device__ __forceinline__ void phase_moe1_naive(Frame& F, int l, bool with_ctx) {
    NaiveEpi E{}; E.mode = 2; E.HE = F.HE;
    const int M = with_ctx ? ESLOTS : 2 * CAP_L; const int nM = (M + 127) / 128, nN = D / 64;
    for (int u = F.bid; u < NE * nM * nN; u += F.G) { const int e = u / (nM * nN), r = u % (nM * nN), pm = r / nN, pn = r % nN;
        naive_gemm_tile<true>(F, F.U, D, F.RIDX + e * EPAD, pm * 128, M, F.in[I_WG] + ((size_t)l * NE + e) * D * D, F.in[I_WU] + ((size_t)l * NE + e) * D * D, D, pn * 64, D, E, e * EPAD); }
    __syncthreads();
}
__device__ __forceinline__ void phase_moe2_naive(Frame& F, int l, bool with_ctx) {
    NaiveEpi E{}; E.mode = 3; E.YE = F.YE; E.gate = F.GATE;
    const int M = with_ctx ? ESLOTS : 2 * CAP_L; const int nM = (M + 127) / 128, nN = D / 64;
    for (int u = F.bid; u < NE * nM * nN; u += F.G) { const int e = u / (nM * nN), r = u % (nM * nN), pm = r / nN, pn = r % nN;
        naive_gemm_tile<false>(F, F.HE + (size_t)e * EPAD * D, D, nullptr, pm * 128, M, F.in[I_WD] + ((size_t)l * NE + e) * D * D, nullptr, D, pn * 64, D, E, e * EPAD); }
    __syncthreads();
}

__device__ __forceinline__ void store64(bf16_t* dst, const float (&v)[64]) {
#pragma unroll
    for (int i = 0; i < 8; ++i) { u32x4 w; w.x = pk2(v[8 * i], v[8 * i + 1]); w.y = pk2(v[8 * i + 2], v[8 * i + 3]); w.z = pk2(v[8 * i + 4], v[8 * i + 5]); w.w = pk2(v[8 * i + 6], v[8 * i + 7]); *(u32x4*)(dst + 8 * i) = w; }
}
template <int DIM, int OFF> __device__ __forceinline__ void rope_vec(float (&v)[64], const float* tab, int t) {
    constexpr int half = DIM / 2, nf = half / 2;
    const int pr = t >> 6, pc = t & 63;
    const float* C = tab + (DIM == 64 ? TB_C64 : TB_C32); const float* Sn = tab + (DIM == 64 ? TB_S64 : TB_S32);
#pragma unroll
    for (int i = 0; i < half; ++i) {
        const int pos = (i < nf) ? pr : pc, f = (i < nf) ? i : i - nf;
        const float c = C[pos * nf + f], s = Sn[pos * nf + f];
        const float x1 = v[OFF + i], x2 = v[OFF + half + i];
        v[OFF + i] = x1 * c - x2 * s; v[OFF + half + i] = x2 * c + x1 * s;
    }
}
__device__ __forceinline__ void phase_post_naive(Frame& F, int l) {
    const long NT = (long)ROWS * 40;
    for (long it = (long)F.bid * NTHR + F.tid; it < NT; it += (long)F.G * NTHR) {
        const int r = (int)(it / 40), u = (int)(it % 40);
        if (u >= 16 && u < 20) continue;
        const bool isc = r >= ROWS_L; const int b = isc ? (r - ROWS_L) / LC : r / S; const int t = isc ? (r - ROWS_L) % LC : r % S;
        const int key = isc ? t : LC + t;
        const float* p = F.P + (size_t)r * DIN + 64 * u;
        float v[64];
#pragma unroll
        for (int i = 0; i < 16; ++i) { const f32x4 x = *(const f32x4*)(p + 4 * i); v[4 * i] = x[0]; v[4 * i + 1] = x[1]; v[4 * i + 2] = x[2]; v[4 * i + 3] = x[3]; }
        bf16_t* dst;
        if (u < 4) {
            const float sc = 0.125f * LOG2E;
#pragma unroll
            for (int i = 0; i < 64; ++i) v[i] *= sc;
            dst = isc ? F.SEAM + SE_QAC + (((size_t)b * 4 + u) * LC + t) * 64 : F.SEAM + SE_QA + (((size_t)b * 4 + u) * S + t) * 64;
        } else if (u < 8) { dst = F.SEAM + SE_KA + (((size_t)b * 4 + (u - 4)) * KV + key) * 64; }
        else if (u < 12) { dst = F.SEAM + SE_VA + (((size_t)b * 4 + (u - 8)) * KV + key) * 64; }
        else if (u < 16) {
            const float* pg = p + 256;
#pragma unroll
            for (int i = 0; i < 16; ++i) { const f32x4 g = *(const f32x4*)(pg + 4 * i);
                v[4 * i] *= 1.f / (1.f + __expf(-g[0])); v[4 * i + 1] *= 1.f / (1.f + __expf(-g[1])); v[4 * i + 2] *= 1.f / (1.f + __expf(-g[2])); v[4 * i + 3] *= 1.f / (1.f + __expf(-g[3])); }
            dst = F.SEAM + SE_Z + (size_t)r * 256 + 64 * (u - 12);
        } else if (u < 24) {
            const int hq = u - 20; const float* g = F.in[I_QNG] + l * 64; float ss = 0.f;
#pragma unroll
            for (int i = 0; i < 64; ++i) ss += v[i] * v[i];
            const float rs = 1.f / sqrtf(ss * (1.f / 64.f) + EPS);
#pragma unroll
            for (int i = 0; i < 64; ++i) v[i] = v[i] * rs * g[i];
            if (!isc) rope_vec<64, 0>(v, F.tab, t);
            const float sc = 0.125f * LOG2E;
#pragma unroll
            for (int i = 0; i < 64; ++i) v[i] *= sc;
            dst = isc ? F.SEAM + SE_QGC + (((size_t)b * 4 + hq) * LC + t) * 64 : F.SEAM + SE_QG + (((size_t)b * 4 + hq) * S + t) * 64;
        } else if (u < 26) {
            const int hk = u - 24; const float* g = F.in[I_KNG] + l * 64; float ss = 0.f;
#pragma unroll
            for (int i = 0; i < 64; ++i) ss += v[i] * v[i];
            const float rs = 1.f / sqrtf(ss * (1.f / 64.f) + EPS);
#pragma unroll
            for (int i = 0; i < 64; ++i) v[i] = v[i] * rs * g[i];
            if (!isc) rope_vec<64, 0>(v, F.tab, t);
            dst = F.SEAM + SE_KG + (((size_t)b * 2 + hk) * KV + key) * 64;
        } else if (u < 28) { dst = F.SEAM + SE_VG + (((size_t)b * 2 + (u - 26)) * KV + key) * 64; }
        else if (u < 32) {
            const int h = u - 28;
            if (!isc) { rope_vec<32, 0>(v, F.tab, t); rope_vec<32, 32>(v, F.tab, t); }
            const float sc = 0.17677669529663687f * LOG2E;
#pragma unroll
            for (int i = 0; i < 64; ++i) v[i] *= sc;
            dst = isc ? F.SEAM + SE_QDC + (((size_t)b * 4 + h) * LC + t) * 64 : F.SEAM + SE_QD + (((size_t)b * 4 + h) * S + t) * 64;
        } else if (u < 36) {
            const int h = u - 32;
            if (!isc) { rope_vec<32, 0>(v, F.tab, t); rope_vec<32, 32>(v, F.tab, t); }
            dst = F.SEAM + SE_KD + (((size_t)b * 4 + h) * KV + key) * 64;
        } else { dst = F.SEAM + SE_VD + (((size_t)b * 4 + (u - 36)) * KV + key) * 64; }
        store64(dst, v);
    }
}

__device__ __forceinline__ void load64(float (&v)[64], const bf16_t* p) {
#pragma unroll
    for (int i = 0; i < 8; ++i) { const u32x4 w = *(const u32x4*)(p + 8 * i);
        v[8 * i] = bflo(w.x); v[8 * i + 1] = bfhi(w.x); v[8 * i + 2] = bflo(w.y); v[8 * i + 3] = bfhi(w.y); v[8 * i + 4] = bflo(w.z); v[8 * i + 5] = bfhi(w.z); v[8 * i + 6] = bflo(w.w); v[8 * i + 7] = bfhi(w.w); }
}
struct Q64 { u32x4 w[8]; };
__device__ __forceinline__ void loadq(Q64& q, const bf16_t* p) {
#pragma unroll
    for (int i = 0; i < 8; ++i) q.w[i] = *(const u32x4*)(p + 8 * i);
}
__device__ __forceinline__ float dot8(u32x4 a, const u32x4 w, float s) {
    asm volatile("" : "+v"(a));
    s += bflo(a.x) * bflo(w.x); s += bfhi(a.x) * bfhi(w.x); s += bflo(a.y) * bflo(w.y); s += bfhi(a.y) * bfhi(w.y);
    s += bflo(a.z) * bflo(w.z); s += bfhi(a.z) * bfhi(w.z); s += bflo(a.w) * bflo(w.w); s += bfhi(a.w) * bfhi(w.w); return s;
}
__device__ __forceinline__ float dot64(const Q64& q, const bf16_t* k) {
    float s0 = 0.f, s1 = 0.f;
#pragma unroll
    for (int i = 0; i < 8; i += 2) { s0 = dot8(q.w[i], *(const u32x4*)(k + 8 * i), s0); s1 = dot8(q.w[i + 1], *(const u32x4*)(k + 8 * i + 8), s1); }
    return s0 + s1;
}
template <int OFF> __device__ __forceinline__ float dot32(const Q64& q, const bf16_t* k) {
    float s0 = 0.f, s1 = 0.f;
#pragma unroll
    for (int i = 0; i < 4; i += 2) { s0 = dot8(q.w[OFF / 8 + i], *(const u32x4*)(k + OFF + 8 * i), s0); s1 = dot8(q.w[OFF / 8 + i + 1], *(const u32x4*)(k + OFF + 8 * i + 8), s1); }
    return s0 + s1;
}
__device__ __forceinline__ void axpy64(float (&o)[64], float p, const bf16_t* vrow) {
#pragma unroll
    for (int i = 0; i < 8; ++i) { const u32x4 w = *(const u32x4*)(vrow + 8 * i);
        o[8 * i] += p * bflo(w.x); o[8 * i + 1] += p * bfhi(w.x); o[8 * i + 2] += p * bflo(w.y); o[8 * i + 3] += p * bfhi(w.y);
        o[8 * i + 4] += p * bflo(w.z); o[8 * i + 5] += p * bfhi(w.z); o[8 * i + 6] += p * bflo(w.w); o[8 * i + 7] += p * bfhi(w.w); }
}
#define OSM_STEP(m, lsum, o, s, vrow) do { if ((s) > (m)) { const float f_ = exp2f((m) - (s)); (lsum) *= f_; _Pragma("unroll") for (int i_ = 0; i_ < 64; ++i_) (o)[i_] *= f_; (m) = (s); } \
    const float p_ = exp2f((s) - (m)); (lsum) += p_; axpy64((o), p_, (vrow)); } while (0)

__device__ __forceinline__ void axpy32(float (&o)[32], float p, const bf16_t* vrow) {
#pragma unroll
    for (int i = 0; i < 4; ++i) { const u32x4 w = *(const u32x4*)(vrow + 8 * i);
        o[8 * i] += p * bflo(w.x); o[8 * i + 1] += p * bfhi(w.x); o[8 * i + 2] += p * bflo(w.y); o[8 * i + 3] += p * bfhi(w.y);
        o[8 * i + 4] += p * bflo(w.z); o[8 * i + 5] += p * bfhi(w.z); o[8 * i + 6] += p * bflo(w.w); o[8 * i + 7] += p * bfhi(w.w); }
}
#define OSM_STEP32(m, lsum, o, s, vrow) do { if ((s) > (m)) { const float f_ = exp2f((m) - (s)); (lsum) *= f_; _Pragma("unroll") for (int i_ = 0; i_ < 32; ++i_) (o)[i_] *= f_; (m) = (s); } \
    const float p_ = exp2f((s) - (m)); (lsum) += p_; axpy32((o), p_, (vrow)); } while (0)
__device__ __forceinline__ void naive_diff(Frame& F, int l, const bf16_t* qp, const bf16_t* K, const bf16_t* V, int nk, int dh, bf16_t* dst) {
    Q64 q; loadq(q, qp);
    float o1[32], o2[32]; float m1 = -1e30f, l1 = 0.f, m2 = -1e30f, l2 = 0.f;
#pragma unroll
    for (int i = 0; i < 32; ++i) { o1[i] = 0.f; o2[i] = 0.f; }
    const int z = vzero();
#pragma unroll 1
    for (int j = 0; j < nk; ++j) {
        const bf16_t* kr = K + (size_t)(j + z) * 64; const bf16_t* vr = V + (size_t)(j + z) * 64 + 32 * dh;
        const float s1 = dot32<0>(q, kr), s2 = dot32<32>(q, kr);
        OSM_STEP32(m1, l1, o1, s1, vr); OSM_STEP32(m2, l2, o2, s2, vr);
    }
    const float lam = F.tab[TB_LAM + 2 * l], oml = F.tab[TB_LAM + 2 * l + 1];
    const float i1 = 1.f / l1, i2 = lam / l2; float ss = 0.f;
#pragma unroll
    for (int i = 0; i < 32; ++i) { o1[i] = o1[i] * i1 - o2[i] * i2; ss += o1[i] * o1[i]; }
    ss += __shfl_xor(ss, 1);
    const float rs = oml / sqrtf(ss * (1.f / 64.f) + EPS);
    const float* g = F.in[I_DNG] + l * 64 + 32 * dh;
#pragma unroll
    for (int i = 0; i < 4; ++i) { u32x4 w; w.x = pk2(o1[8 * i] * rs * g[8 * i], o1[8 * i + 1] * rs * g[8 * i + 1]); w.y = pk2(o1[8 * i + 2] * rs * g[8 * i + 2], o1[8 * i + 3] * rs * g[8 * i + 3]);
        w.z = pk2(o1[8 * i + 4] * rs * g[8 * i + 4], o1[8 * i + 5] * rs * g[8 * i + 5]); w.w = pk2(o1[8 * i + 6] * rs * g[8 * i + 6], o1[8 * i + 7] * rs * g[8 * i + 7]); *(u32x4*)(dst + 8 * i) = w; }
}
__device__ __forceinline__ void store32n(bf16_t* dst, const float (&o)[32], float inv) {
#pragma unroll
    for (int i = 0; i < 4; ++i) { u32x4 w; w.x = pk2(o[8 * i] * inv, o[8 * i + 1] * inv); w.y = pk2(o[8 * i + 2] * inv, o[8 * i + 3] * inv);
        w.z = pk2(o[8 * i + 4] * inv, o[8 * i + 5] * inv); w.w = pk2(o[8 * i + 6] * inv, o[8 * i + 7] * inv); *(u32x4*)(dst + 8 * i) = w; }
}
__device__ __forceinline__ void naive_attn(const bf16_t* qp, const bf16_t* K, const bf16_t* V, int nk, int dh, bf16_t* dst) {
    Q64 q; loadq(q, qp);
    float o[32]; float m = -1e30f, ls = 0.f;
#pragma unroll
    for (int i = 0; i < 32; ++i) o[i] = 0.f;
    const int z = vzero();
#pragma unroll 1
    for (int j = 0; j < nk; ++j) { const float s = dot64(q, K + (size_t)(j + z) * 64); OSM_STEP32(m, ls, o, s, V + (size_t)(j + z) * 64 + 32 * dh); }
    store32n(dst, o, 1.f / ls);
}
__device__ __forceinline__ void naive_na(Frame& F, int l, int b, int h, int t, int dh, bf16_t* dst) {
    Q64 q; loadq(q, F.SEAM + SE_QA + (((size_t)b * 4 + h) * S + t) * 64);
    const bf16_t* K = F.SEAM + SE_KA + ((size_t)b * 4 + h) * KV * 64; const bf16_t* V = F.SEAM + SE_VA + ((size_t)b * 4 + h) * KV * 64 + 32 * dh;
    const float* rpb = F.in[I_RPB] + ((size_t)l * 4 + h) * 15 * 31;
    const int r = t >> 6, jq = t & 63;
    int rs = r - 4; rs = rs < 0 ? 0 : (rs > 120 ? 120 : rs);
    int cs = jq - 8; cs = cs < 0 ? 0 : (cs > 48 ? 48 : cs);
    float o[32]; float m = -1e30f, ls = 0.f;
#pragma unroll
    for (int i = 0; i < 32; ++i) o[i] = 0.f;
#pragma unroll 1
    for (int kk = 0; kk < 128 + LC; ++kk) {
        int key; float bias = 0.f;
        if (kk < 128) { const int rr = rs + (kk >> 4), cc = cs + (kk & 15); key = LC + rr * 64 + cc;
            const int dr = rr - r + 7; int dc = cc - jq; dc = dc < -15 ? -15 : (dc > 15 ? 15 : dc); dc += 15; bias = rpb[dr * 31 + dc] * LOG2E; }
        else key = kk - 128;
        const float s = dot64(q, K + (size_t)key * 64) + bias;
        OSM_STEP32(m, ls, o, s, V + (size_t)key * 64);
    }
    store32n(dst, o, 1.f / ls);
}
__device__ __forceinline__ void phase_conv_naive(Frame& F, int l, int unit, bool ctxu) {
    LAS float* zc = (LAS float*)F.lds;
    const int row0 = ctxu ? ROWS_L + unit * 16 : unit * 16;
    const int seqlen = ctxu ? LC : S; const int t0 = (ctxu ? unit * 16 : unit * 16) % seqlen; const int seqrow0 = row0 - t0;
    const bf16_t* Z = F.SEAM + SE_Z;
    const float* dww = F.in[I_DWW] + (size_t)l * 31 * 256; const float* dwb = F.in[I_DWB] + l * 256;
    __syncthreads();
#pragma unroll 1
    for (int i = F.tid; i < 16 * 256; i += NTHR) {
        const int tt = i >> 8, c = i & 255; float a = dwb[c];
#pragma unroll 4
        for (int k = 0; k < 31; ++k) { const int ts = t0 + tt + k - 15; if (ts >= 0 && ts < seqlen) a += bf2f(Z[(size_t)(seqrow0 + ts) * 256 + c]) * dww[k * 256 + c]; }
        zc[i] = a;
    }
    __syncthreads();
    for (int tt = F.wave * 2; tt < F.wave * 2 + 2; ++tt) {
        float x[4]; float s = 0.f;
#pragma unroll
        for (int j = 0; j < 4; ++j) { x[j] = zc[tt * 256 + F.lane + 64 * j]; s += x[j]; }
        const float mu = wave_sum(s) * (1.f / 256.f); float q = 0.f;
#pragma unroll
        for (int j = 0; j < 4; ++j) { x[j] -= mu; q += x[j] * x[j]; }
        const float rs = 1.f / sqrtf(wave_sum(q) * (1.f / 256.f) + EPS);
#pragma unroll
        for (int j = 0; j < 4; ++j) { const int c = F.lane + 64 * j; const float y = x[j] * rs * F.in[I_LNG][l * 256 + c] + F.in[I_LNB][l * 256 + c]; zc[tt * 256 + c] = silu_f(y); }
    }
    __syncthreads();
    const float* pw = F.in[I_PWW] + (size_t)l * 256 * 256; const float* pb = F.in[I_PWB] + l * 256;
#pragma unroll 1
    for (int i = F.tid; i < 16 * 256; i += NTHR) {
        const int tt = i >> 8, c = i & 255; float a = pb[c];
#pragma unroll 8
        for (int k = 0; k < 256; ++k) a += zc[tt * 256 + k] * pw[k * 256 + c];
        F.Y[(size_t)(row0 + tt) * D + 256 + c] = (bf16_t)f2bf(a);
    }
}
#ifndef FAST_ATTN_SKIP
#define FAST_ATTN_SKIP 1
#endif
#ifndef FAST_NA_LAT
#define FAST_NA_LAT 1
#endif
#ifndef FAST_NA_CTX
#define FAST_NA_CTX 1
#endif
__device__ __forceinline__ void phase_mixers_naive(Frame& F, int l, bool with_ctx) {
    const int NA_U = with_ctx ? 264 : 256;
#define UNIT_DECODE const bool cu = u >= 256; const int nq = cu ? LC : S; const int idx = cu ? u - 256 : u; const int q0 = idx * 256 + (F.tid >> 1), dh = F.tid & 1; \
        const int b = q0 / (4 * nq), h = (q0 / nq) % 4, t = q0 % nq; const int row = cu ? ROWS_L + b * LC + t : b * S + t;
#pragma unroll 1
    for (int u = F.bid; u < (FAST_ATTN_SKIP ? 0 : NA_U); u += F.G) { UNIT_DECODE
        const bf16_t* qp = F.SEAM + (cu ? SE_QGC : SE_QG) + (((size_t)b * 4 + h) * nq + t) * 64;
        const size_t kvo = ((size_t)b * 2 + (h >> 1)) * KV * 64;
        naive_attn(qp, F.SEAM + SE_KG + kvo, F.SEAM + SE_VG + kvo, cu ? LC : KV, dh, F.Y + (size_t)row * D + 512 + h * 64 + 32 * dh);
    }
    asm volatile("" ::: "memory");
#pragma unroll 1
    for (int u = F.G - 1 - F.bid; u < (FAST_ATTN_SKIP ? 0 : NA_U); u += F.G) { UNIT_DECODE
        const bf16_t* qp = F.SEAM + (cu ? SE_QDC : SE_QD) + (((size_t)b * 4 + h) * nq + t) * 64;
        const size_t kvo = ((size_t)b * 4 + h) * KV * 64;
        naive_diff(F, l, qp, F.SEAM + SE_KD + kvo, F.SEAM + SE_VD + kvo, cu ? LC : KV, dh, F.Y + (size_t)row * D + 768 + h * 64 + 32 * dh);
    }
    asm volatile("" ::: "memory");
#pragma unroll 1
    for (int u = F.bid; u < NA_U; u += F.G) { UNIT_DECODE
        if (cu ? FAST_NA_CTX : FAST_NA_LAT) continue;
        if (cu) { const bf16_t* qp = F.SEAM + SE_QAC + (((size_t)b * 4 + h) * LC + t) * 64; const size_t kvo = ((size_t)b * 4 + h) * KV * 64;
            naive_attn(qp, F.SEAM + SE_KA + kvo, F.SEAM + SE_VA + kvo, LC, dh, F.Y + (size_t)row * D + h * 64 + 32 * dh); }
        else naive_na(F, l, b, h, t, dh, F.Y + (size_t)row * D + h * 64 + 32 * dh);
    }
#undef UNIT_DECODE
    asm volatile("" ::: "memory");
#pragma unroll 1
    for (int u = F.bid; u < (FAST_CONV ? 0 : (with_ctx ? 1056 : 1024)); u += F.G) { if (u < 1024) phase_conv_naive(F, l, u, false); else phase_conv_naive(F, l, u - 1024, true); }
    __syncthreads();
}


#ifndef FAST_INPROJ
#define FAST_INPROJ 1
#endif
#ifndef FAST_OUTPROJ
#define FAST_OUTPROJ 1
#endif
#ifndef FAST_MOE
#define FAST_MOE 1
#endif
constexpr size_t WB_GU = 0;
constexpr size_t WB_DN = 128 * MiB;
constexpr size_t WB_IN = 192 * MiB;
constexpr size_t WB_OUT = 202 * MiB;
static_assert(!(FAST_MOE && !FAST_INPROJ), "naive P overlays the MoE weight copies");
constexpr int GOFS_OFF = 131072 + 1024;

namespace pg8 {
typedef short bf16x8 __attribute__((ext_vector_type(8)));
constexpr int BM = 256, BK = 64, HALF = 128, HTB = HALF * BK * 2, STAGE_BYTES = 8 * HTB;
__device__ __forceinline__ int lds_byte(int r, int c) { const int st = (r >> 4) * 2 + (c >> 5), rr = r & 15, cc = c & 31, ob = rr * 64 + cc * 2; return st * 1024 + (ob ^ (((ob >> 9) & 1) << 5)); }
__device__ __forceinline__ void stage_rc(int b, int& R, int& C) { const int st = b / 1024, sb = b % 1024, swz = sb ^ (((sb >> 9) & 1) << 5); R = (st >> 1) * 16 + swz / 64; C = (st & 1) * 32 + (swz % 64) / 2; }
__device__ __forceinline__ int perm32(int rho) { const int n = rho >> 4, i = rho & 15; return 8 * (i >> 2) + 4 * n + (i & 3); }
struct Unit { int pm, pn; };
struct Gemm { const bf16_t* A; const bf16_t* Bt; int K; };

template <class Epi, class Sched, bool GATHER>
__device__ __forceinline__ void gemm_phase(LAS unsigned char* lds, const Gemm g, const Sched& S, const Epi& E, const LAS unsigned* gofs) {
    const int tid = threadIdx.x, wid = __builtin_amdgcn_readfirstlane(tid >> 6), lane = tid & 63, wr = wid >> 2, wc = wid & 3, fr = lane & 15, fq = lane >> 4;
    const int K = g.K, nt = K / BK;
    unsigned voffB[2];
#pragma unroll
    for (int i = 0; i < 2; ++i) { int R, C; stage_rc(tid * 16 + i * 8192, R, C); const int Rb = (R & ~31) + perm32(R & 31);
        voffB[i] = (unsigned)(Rb * K + C) * 2u; }
    const size_t kstep = (size_t)(BK * 2);
    const size_t hstep = (size_t)HALF * K * 2;
    const size_t tstep = 2 * hstep;
    const unsigned ldsw = (unsigned)wid * 1024u;
    const int aoff = lds_byte(wr * 64 + fr, fq * 8), boff = lds_byte(wc * 32 + fr, fq * 8);
#define PG8_SA(b, h) (((b) * 2 + (h)) * HTB)
#define PG8_SB(b, h) ((4 + (b) * 2 + (h)) * HTB)
#define PG8_STAGE(bufoff, gbase, voff) do { _Pragma("unroll") for (int _i = 0; _i < 2; ++_i) \
        __builtin_amdgcn_global_load_lds((const unsigned*)((const char*)(gbase) + (voff)[_i]), (LAS unsigned*)(lds + (bufoff) + ldsw + _i * 8192), 16, 0, 0); } while (0)
#define PG8_LDA(dst, b, h) do { _Pragma("unroll") for (int m = 0; m < 4; ++m) _Pragma("unroll") for (int k = 0; k < 2; ++k) dst[m][k] = *(const LAS bf16x8*)(lds + PG8_SA(b, h) + aoff + m * 2048 + k * 1024); } while (0)
#define PG8_LDB(dst, b, h) do { _Pragma("unroll") for (int n = 0; n < 2; ++n) _Pragma("unroll") for (int k = 0; k < 2; ++k) dst[n][k] = *(const LAS bf16x8*)(lds + PG8_SB(b, h) + boff + n * 2048 + k * 1024); } while (0)
#define PG8_MMA(ai, bj, At, Bt) do { __builtin_amdgcn_s_setprio(1); _Pragma("unroll") for (int m = 0; m < 4; ++m) _Pragma("unroll") for (int n = 0; n < 2; ++n) _Pragma("unroll") for (int k = 0; k < 2; ++k) \
        acc[ai][bj][m][n] = __builtin_amdgcn_mfma_f32_16x16x32_bf16(Bt[n][k], At[m][k], acc[ai][bj][m][n], 0, 0, 0); __builtin_amdgcn_s_setprio(0); } while (0)
#define PG8_WAIT_V(n) asm volatile("s_waitcnt vmcnt(" #n ")" ::: "memory")
#define PG8_WAIT_L(n) asm volatile("s_waitcnt lgkmcnt(" #n ")" ::: "memory")
#define PG8_BAR __builtin_amdgcn_s_barrier()
#define PG8_SCHED __builtin_amdgcn_sched_barrier(0)
#define PG8_AOFF(dst, u, slot) do { int _t = tid; asm volatile("" : "+v"(_t)); _Pragma("unroll") for (int _i = 0; _i < 2; ++_i) { int _R, _C; stage_rc(_t * 16 + _i * 8192, _R, _C); \
        _Pragma("unroll") for (int _h = 0; _h < 2; ++_h) \
        dst[_h][_i] = (GATHER ? gofs[(slot) * 256 + _h * HALF + _R] : (unsigned)((u).pm * BM + _h * HALF + _R) * (unsigned)(K * 2)) + (unsigned)_C * 2u; } } while (0)
    Unit cur, nxt; int ui = 0;
    if (!S.next(0, cur)) return;
    f32x4 acc[2][2][4][2];
#pragma unroll
    for (int a = 0; a < 2; ++a)
#pragma unroll
        for (int b = 0; b < 2; ++b)
#pragma unroll
            for (int m = 0; m < 4; ++m)
#pragma unroll
                for (int n = 0; n < 2; ++n) acc[a][b][m][n] = (f32x4){0.f, 0.f, 0.f, 0.f};
    bf16x8 At[4][2], B0[2][2], B1[2][2];
    unsigned ca[2][2];
    PG8_AOFF(ca, cur, 0);
    const char* Ab = (const char*)g.A; const char* cB = (const char*)g.Bt + (size_t)cur.pn * tstep;
    PG8_STAGE(PG8_SB(0, 0), cB, voffB); PG8_STAGE(PG8_SB(0, 1), cB + hstep, voffB); PG8_STAGE(PG8_SA(0, 0), Ab, ca[0]); PG8_STAGE(PG8_SA(0, 1), Ab, ca[1]);
    if (wr == 1) PG8_BAR;
    PG8_WAIT_V(2); PG8_BAR;
    PG8_STAGE(PG8_SB(1, 0), cB + kstep, voffB); PG8_STAGE(PG8_SA(1, 0), Ab + kstep, ca[0]); PG8_STAGE(PG8_SB(1, 1), cB + hstep + kstep, voffB);
    PG8_WAIT_V(6); PG8_BAR;
    for (;;) {
        const bool has_next = S.next(ui + 1, nxt);
        const char* nB = has_next ? (const char*)g.Bt + (size_t)nxt.pn * tstep : cB;
        for (int t = 0; t < nt; t += 2) {
            const bool last = (t == nt - 2);
            const char* a1 = Ab + (size_t)(t + 1) * kstep;
            const char* a2 = last ? Ab : Ab + (size_t)(t + 2) * kstep; const char* b2 = last ? nB : cB + (size_t)(t + 2) * kstep;
            const char* a3 = a2 + kstep; const char* b3 = b2 + kstep;
            PG8_LDB(B0, 0, 0); PG8_LDB(B1, 0, 1); PG8_SCHED; PG8_LDA(At, 0, 0); PG8_STAGE(PG8_SA(1, 1), a1, ca[1]);
            if (last && has_next) { PG8_AOFF(ca, nxt, ui + 1); }
            PG8_WAIT_V(8); PG8_WAIT_L(0); PG8_BAR; PG8_MMA(0, 0, At, B0); PG8_MMA(0, 1, At, B1); PG8_BAR; PG8_SCHED;
            PG8_LDA(At, 0, 1); PG8_STAGE(PG8_SB(0, 0), b2, voffB); PG8_STAGE(PG8_SB(0, 1), b2 + hstep, voffB); PG8_STAGE(PG8_SA(0, 0), a2, ca[0]);
            PG8_WAIT_V(8); PG8_WAIT_L(0); PG8_BAR; PG8_MMA(1, 0, At, B0); PG8_MMA(1, 1, At, B1); PG8_BAR; PG8_SCHED;
            PG8_LDB(B0, 1, 0); PG8_LDB(B1, 1, 1); PG8_SCHED; PG8_LDA(At, 1, 0); PG8_STAGE(PG8_SA(0, 1), a2, ca[1]);
            PG8_WAIT_V(8); PG8_WAIT_L(0); PG8_BAR; PG8_MMA(0, 0, At, B0); PG8_MMA(0, 1, At, B1); PG8_BAR; PG8_SCHED;
            PG8_LDA(At, 1, 1); PG8_STAGE(PG8_SB(1, 0), b3, voffB); PG8_STAGE(PG8_SB(1, 1), b3 + hstep, voffB); PG8_STAGE(PG8_SA(1, 0), a3, ca[0]);
            PG8_WAIT_V(8); PG8_WAIT_L(0); PG8_BAR; PG8_MMA(1, 0, At, B0); PG8_MMA(1, 1, At, B1); PG8_BAR; PG8_SCHED;
        }
        if (wr == 0) PG8_BAR;
        { int fr_ = fr, fq_ = fq, wr_ = wr, wc_ = wc; asm volatile("" : "+v"(fr_), "+v"(fq_), "+s"(wr_), "+s"(wc_));
          E(acc, cur, wr_, wc_, fr_, fq_); }
        if (!has_next) break;
#pragma unroll
        for (int a = 0; a < 2; ++a)
#pragma unroll
            for (int b = 0; b < 2; ++b)
#pragma unroll
                for (int m = 0; m < 4; ++m)
#pragma unroll
                    for (int n = 0; n < 2; ++n) acc[a][b][m][n] = (f32x4){0.f, 0.f, 0.f, 0.f};
        cur = nxt; cB = nB; ++ui;
        if (wr == 1) PG8_BAR;
    }
    PG8_WAIT_V(0);
    PG8_BAR;
#undef PG8_SA
#undef PG8_SB
#undef PG8_STAGE
#undef PG8_LDA
#undef PG8_LDB
#undef PG8_MMA
#undef PG8_WAIT_V
#undef PG8_WAIT_L
#undef PG8_BAR
#undef PG8_SCHED
#undef PG8_AOFF
}

struct OrderDense {
    int nM, nN, G, v;
    __device__ __forceinline__ bool next(int i, Unit& u) const {
        const int id = i * G + v; if (id >= nM * nN) return false;
        const int nig = 8 * nN, gid = id / nig, fm = gid * 8, gsz = (nM - fm) < 8 ? (nM - fm) : 8;
        u.pm = __builtin_amdgcn_readfirstlane(fm + ((id % nig) % gsz)); u.pn = __builtin_amdgcn_readfirstlane((id % nig) / gsz); return true;
    }
};
struct OrderMoe {
    int nM, nN, G, v;
    __device__ __forceinline__ bool next(int i, Unit& u) const {
        const int id = i * G + v; if (id >= NE * nM * nN) return false;
        const int e = id / (nM * nN), r = id % (nM * nN);
        u.pm = __builtin_amdgcn_readfirstlane(e * 9 + (r % nM)); u.pn = __builtin_amdgcn_readfirstlane(e * nN + (r / nM)); return true;
    }
};
}

__device__ __forceinline__ unsigned cvt_pk_bf16(float lo, float hi) { unsigned r; asm volatile("v_cvt_pk_bf16_f32 %0, %1, %2" : "=v"(r) : "v"(lo), "v"(hi)); return r; }
__device__ __forceinline__ u32x4 pack8(const f32x4 a, const f32x4 b) { u32x4 w; w.x = cvt_pk_bf16(a[0], a[1]); w.y = cvt_pk_bf16(a[2], a[3]); w.z = cvt_pk_bf16(b[0], b[1]); w.w = cvt_pk_bf16(b[2], b[3]); return w; }
__device__ __forceinline__ float fast_sigmoid(float x) { return __builtin_amdgcn_rcpf(1.f + __expf(-x)); }

struct EpiIn {
    bf16_t* SEAM; const float* tab; const float* qng; const float* kng;
    __device__ __forceinline__ void operator()(const f32x4 (&acc)[2][2][4][2], const pg8::Unit& u, int wr, int wc, int fr, int fq) const {
        const bool isc = u.pm >= 64; const int b = isc ? u.pm - 64 : u.pm >> 5; const int pn = u.pn; const int nq = isc ? LC : S;
        f32x4 gn[2][2];
        if (pn == 5 || pn == 6) { const float* g = (pn == 5) ? qng : kng;
#pragma unroll
            for (int bj = 0; bj < 2; ++bj)
#pragma unroll
                for (int n = 0; n < 2; ++n) gn[bj][n] = *(const f32x4*)(g + 32 * bj + 8 * fq + 4 * n); }
#pragma unroll
        for (int ai = 0; ai < 2; ++ai)
#pragma unroll
            for (int m = 0; m < 4; ++m) {
                const int rl = 128 * ai + 64 * wr + 16 * m + fr; const int r = u.pm * 256 + rl; const int t = isc ? rl : (r & (S - 1)); const int key = isc ? t : LC + t;
                const int e0 = 8 * fq;
                if (pn <= 2 || pn == 9 || (pn == 6 && wc >= 2)) {
                    bf16_t* base;
                    if (pn == 0) base = isc ? SEAM + SE_QAC + (((size_t)b * 4 + wc) * LC + t) * 64 : SEAM + SE_QA + (((size_t)b * 4 + wc) * S + t) * 64;
                    else if (pn == 1) base = SEAM + SE_KA + (((size_t)b * 4 + wc) * KV + key) * 64;
                    else if (pn == 2) base = SEAM + SE_VA + (((size_t)b * 4 + wc) * KV + key) * 64;
                    else if (pn == 9) base = SEAM + SE_VD + (((size_t)b * 4 + wc) * KV + key) * 64;
                    else base = SEAM + SE_VG + (((size_t)b * 2 + (wc - 2)) * KV + key) * 64;
                    const float sc = (pn == 0) ? 0.125f * LOG2E : 1.f;
#pragma unroll
                    for (int bj = 0; bj < 2; ++bj) *(u32x4*)(base + 32 * bj + e0) = pack8(acc[ai][bj][m][0] * sc, acc[ai][bj][m][1] * sc);
                } else if (pn == 3 || pn == 4) {
                    f32x4 z0, z1;
#pragma unroll
                    for (int j = 0; j < 4; ++j) { z0[j] = acc[ai][0][m][0][j] * fast_sigmoid(acc[ai][1][m][0][j]); z1[j] = acc[ai][0][m][1][j] * fast_sigmoid(acc[ai][1][m][1][j]); }
                    *(u32x4*)(SEAM + SE_Z + (size_t)r * 256 + 128 * (pn - 3) + 32 * wc + e0) = pack8(z0, z1);
                } else if (pn == 5 || pn == 6) {
                    float ss = 0.f;
#pragma unroll
                    for (int bj = 0; bj < 2; ++bj)
#pragma unroll
                        for (int n = 0; n < 2; ++n) { const f32x4 x = acc[ai][bj][m][n]; ss += (x[0] * x[0] + x[1] * x[1]) + (x[2] * x[2] + x[3] * x[3]); }
                    ss += __shfl_xor(ss, 16); ss += __shfl_xor(ss, 32);
                    const float rs = 1.f / sqrtf(ss * (1.f / 64.f) + EPS);
                    f32x4 x1[2], x2[2];
#pragma unroll
                    for (int n = 0; n < 2; ++n) { x1[n] = acc[ai][0][m][n] * rs * gn[0][n]; x2[n] = acc[ai][1][m][n] * rs * gn[1][n]; }
                    if (!isc) { const int pos = (fq < 2) ? (t >> 6) : (t & 63);
#pragma unroll
                        for (int n = 0; n < 2; ++n) { const f32x4 c = *(const f32x4*)(tab + TB_C64 + pos * 16 + 8 * (fq & 1) + 4 * n), sn = *(const f32x4*)(tab + TB_S64 + pos * 16 + 8 * (fq & 1) + 4 * n);
                            const f32x4 a = x1[n] * c - x2[n] * sn, bb = x2[n] * c + x1[n] * sn; x1[n] = a; x2[n] = bb; } }
                    bf16_t* base;
                    if (pn == 5) { base = isc ? SEAM + SE_QGC + (((size_t)b * 4 + wc) * LC + t) * 64 : SEAM + SE_QG + (((size_t)b * 4 + wc) * S + t) * 64;
                        const float sc = 0.125f * LOG2E;
#pragma unroll
                        for (int n = 0; n < 2; ++n) { x1[n] = x1[n] * sc; x2[n] = x2[n] * sc; } }
                    else base = SEAM + SE_KG + (((size_t)b * 2 + wc) * KV + key) * 64;
                    *(u32x4*)(base + e0) = pack8(x1[0], x1[1]); *(u32x4*)(base + 32 + e0) = pack8(x2[0], x2[1]);
                } else {
                    bf16_t* base;
                    if (pn == 7) base = isc ? SEAM + SE_QDC + (((size_t)b * 4 + wc) * LC + t) * 64 : SEAM + SE_QD + (((size_t)b * 4 + wc) * S + t) * 64;
                    else base = SEAM + SE_KD + (((size_t)b * 4 + wc) * KV + key) * 64;
                    const float sc = (pn == 7) ? 0.17677669529663687f * LOG2E : 1.f;
                    f32x4 c = (f32x4){1.f, 1.f, 1.f, 1.f}, sn = (f32x4){0.f, 0.f, 0.f, 0.f};
                    if (!isc) { const int pos = (fq < 2) ? (t >> 6) : (t & 63); c = *(const f32x4*)(tab + TB_C32 + pos * 8 + 4 * (fq & 1)); sn = *(const f32x4*)(tab + TB_S32 + pos * 8 + 4 * (fq & 1)); }
#pragma unroll
                    for (int bj = 0; bj < 2; ++bj) { const f32x4 x1 = acc[ai][bj][m][0], x2 = acc[ai][bj][m][1];
                        const f32x4 a = (x1 * c - x2 * sn) * sc, bb = (x2 * c + x1 * sn) * sc;
                        uint2 w1, w2; w1.x = cvt_pk_bf16(a[0], a[1]); w1.y = cvt_pk_bf16(a[2], a[3]); w2.x = cvt_pk_bf16(bb[0], bb[1]); w2.y = cvt_pk_bf16(bb[2], bb[3]);
                        *(uint2*)(base + 32 * bj + 4 * fq) = w1; *(uint2*)(base + 32 * bj + 16 + 4 * fq) = w2; }
                }
            }
    }
};
__device__ __forceinline__ int inproj_srccol(int nrow) {
    const int pn = nrow >> 8, p = nrow & 255, bj = p >> 7, wc = (p >> 5) & 3, j32 = p & 31;
    if (pn == 3 || pn == 4) return (bj ? 1024 : 768) + 128 * (pn - 3) + (p & 127);
    if (pn == 7 || pn == 8) { const int fq = j32 >> 3, n = (j32 >> 2) & 1, j = j32 & 3; return 256 * pn + 64 * wc + 32 * bj + 16 * n + 4 * fq + j; }
    return 256 * pn + 64 * wc + 32 * bj + j32;
}
struct EpiOut {
    const float* xl; const float* xc; const float* hin; float* hout; const float* modl; const float* bp;
    __device__ __forceinline__ void operator()(const f32x4 (&acc)[2][2][4][2], const pg8::Unit& u, int wr, int wc, int fr, int fq) const {
        const bool isc = u.pm >= 64; const int b = isc ? u.pm - 64 : u.pm >> 5; const float* g1 = modl + (isc ? 2 : b) * 6144 + 2 * D;
        const int col0 = u.pn * 256 + 32 * wc + 8 * fq;
        const int r0 = u.pm * 256 + 64 * wr + fr;
        const float* src0 = hin ? hin + (size_t)r0 * D : (isc ? xc + (size_t)(r0 - ROWS_L) * D : xl + (size_t)r0 * D);
        float* dst0 = hout + (size_t)r0 * D;
#pragma unroll
        for (int bj = 0; bj < 2; ++bj)
#pragma unroll
            for (int n = 0; n < 2; ++n) { const int c = col0 + 128 * bj + 4 * n;
                const f32x4 g = *(const f32x4*)(g1 + c), bb = *(const f32x4*)(bp + c);
#pragma unroll
                for (int ai = 0; ai < 2; ++ai)
#pragma unroll
                    for (int m = 0; m < 4; ++m) { const size_t ro = (size_t)(128 * ai + 16 * m) * D + c;
                        const f32x4 h = *(const f32x4*)(src0 + ro); *(f32x4*)(dst0 + ro) = h + g * (acc[ai][bj][m][n] + bb); }
                asm volatile("" ::: "memory"); }
    }
};
struct EpiMoe1 {
    bf16_t* HE;
    __device__ __forceinline__ void operator()(const f32x4 (&acc)[2][2][4][2], const pg8::Unit& u, int wr, int wc, int fr, int fq) const {
        const int f0 = (u.pn & 7) * 128 + 32 * wc + 8 * fq;
#pragma unroll
        for (int ai = 0; ai < 2; ++ai)
#pragma unroll
            for (int m = 0; m < 4; ++m) { const size_t r = (size_t)u.pm * 256 + 128 * ai + 64 * wr + 16 * m + fr;
                f32x4 h0, h1;
#pragma unroll
                for (int j = 0; j < 4; ++j) { const float a0 = acc[ai][0][m][0][j], a1 = acc[ai][0][m][1][j]; h0[j] = a0 * fast_sigmoid(a0) * acc[ai][1][m][0][j]; h1[j] = a1 * fast_sigmoid(a1) * acc[ai][1][m][1][j]; }
                *(u32x4*)(HE + r * D + f0) = pack8(h0, h1); }
    }
};
struct EpiMoe2 {
    bf16_t* YE; const float* gate;
    __device__ __forceinline__ void operator()(const f32x4 (&acc)[2][2][4][2], const pg8::Unit& u, int wr, int wc, int fr, int fq) const {
        const int c0 = (u.pn & 3) * 256 + 32 * wc + 8 * fq;
#pragma unroll
        for (int ai = 0; ai < 2; ++ai)
#pragma unroll
            for (int m = 0; m < 4; ++m) { const size_t r = (size_t)u.pm * 256 + 128 * ai + 64 * wr + 16 * m + fr; const float gt = gate[r];
#pragma unroll
                for (int bj = 0; bj < 2; ++bj) *(u32x4*)(YE + r * D + c0 + 128 * bj) = pack8(acc[ai][bj][m][0] * gt, acc[ai][bj][m][1] * gt); }
    }
};

__device__ __forceinline__ int vcu_of(const Frame& F) { return (F.G % 8 == 0) ? (F.bid % 8) * (F.G / 8) + F.bid / 8 : F.bid; }

__device__ __forceinline__ void phase_inproj_fast(Frame& F, int l) {
    pg8::Gemm g{F.U, (const bf16_t*)(F.ws + WS_WBF + WB_IN + (size_t)l * 5 * MiB), D};
    pg8::OrderDense S{ROWS / 256, DIN / 256, F.G, vcu_of(F)};
    EpiIn E{F.SEAM, F.tab, F.in[I_QNG] + l * 64, F.in[I_KNG] + l * 64};
    pg8::gemm_phase<EpiIn, pg8::OrderDense, false>(F.lds, g, S, E, nullptr);
}
__device__ __forceinline__ void phase_outproj_fast(Frame& F, int l, bool with_ctx) {
    pg8::Gemm g{F.Y, (const bf16_t*)(F.ws + WS_WBF + WB_OUT + (size_t)l * 2 * MiB), D};
    pg8::OrderDense S{(with_ctx ? ROWS : ROWS_L) / 256, D / 256, F.G, vcu_of(F)};
    EpiOut E{F.in[I_X], F.in[I_CTX], (l == 0) ? nullptr : F.H, F.H, F.tab + TB_MOD + l * 3 * 6144, F.tab + TB_BP_ + l * D};
    pg8::gemm_phase<EpiOut, pg8::OrderDense, false>(F.lds, g, S, E, nullptr);
}
__device__ __forceinline__ void phase_moe1_fast(Frame& F, int l, bool with_ctx) {
    pg8::Gemm g{F.U, (const bf16_t*)(F.ws + WS_WBF + WB_GU + (size_t)l * 64 * MiB), D};
    pg8::OrderMoe S{with_ctx ? 9 : 8, 8, F.G, vcu_of(F)};
    LAS unsigned* gofs = (LAS unsigned*)(F.lds + GOFS_OFF);
    { pg8::Unit u;
      for (int i = 0; i < 8 && S.next(i, u); ++i)
          for (int j = F.tid; j < 256; j += NTHR) { const int ri = F.RIDX[u.pm * 256 + j]; gofs[i * 256 + j] = (unsigned)(ri < 0 ? 0 : ri) * (unsigned)(D * 2); }
      __syncthreads(); }
    EpiMoe1 E{F.HE};
    pg8::gemm_phase<EpiMoe1, pg8::OrderMoe, true>(F.lds, g, S, E, gofs);
}
__device__ __forceinline__ void phase_moe2_fast(Frame& F, int l, bool with_ctx) {
    pg8::Gemm g{F.HE, (const bf16_t*)(F.ws + WS_WBF + WB_DN + (size_t)l * 32 * MiB), D};
    pg8::OrderMoe S{with_ctx ? 9 : 8, 4, F.G, vcu_of(F)};
    EpiMoe2 E{F.YE, F.GATE};
    pg8::gemm_phase<EpiMoe2, pg8::OrderMoe, false>(F.lds, g, S, E, nullptr);
}

#ifndef FAST_CONV_FOLD
#define FAST_CONV_FOLD 1
#endif
__device__ __forceinline__ void transpose_item(const float* W, int ldw, int srccol, int k0, bf16_t* WTrow0, int K, LAS float* scr, int lane) {
#pragma unroll 8
    for (int i = 0; i < 32; ++i) { const int kk = 2 * i + (lane >> 5); scr[kk * 33 + (lane & 31)] = W[(size_t)(k0 + kk) * ldw + srccol]; }
    asm volatile("s_waitcnt lgkmcnt(0)" ::: "memory");
    const int c = lane & 7;
#pragma unroll
    for (int j = 0; j < 4; ++j) { const int n = (lane >> 3) + 8 * j; const LAS float* s_ = scr + (8 * c) * 33 + n;
        u32x4 o; o.x = pk2(s_[0 * 33], s_[1 * 33]); o.y = pk2(s_[2 * 33], s_[3 * 33]); o.z = pk2(s_[4 * 33], s_[5 * 33]); o.w = pk2(s_[6 * 33], s_[7 * 33]);
        *(u32x4*)(WTrow0 + (size_t)n * K + k0 + 8 * c) = o; }
    asm volatile("s_waitcnt lgkmcnt(0)" ::: "memory");
}
__device__ __forceinline__ void phase_convert(Frame& F) {
    LAS float* scr = (LAS float*)(F.lds + F.wave * 16384);
    const int gw = F.bid * NWAVES + F.wave, NGW = F.G * NWAVES;
    constexpr int IT_IN = 16 * 80, IT_OUT = 16 * 32, IT_E = 16 * 32;
    constexpr int PER_L = IT_IN + IT_OUT + NE * 3 * IT_E;
    const int nn = F.lane & 31;
    for (int it = gw; it < DEPTH * PER_L; it += NGW) {
        const int l = it / PER_L; int r = it % PER_L;
        if (r < IT_IN) { if (!FAST_INPROJ) continue; const int kb = r / 80, nb = r % 80;
            transpose_item(F.in[I_WIN] + (size_t)l * D * DIN, DIN, inproj_srccol(nb * 32 + nn), kb * 64, (bf16_t*)(F.ws + WS_WBF + WB_IN + (size_t)l * 5 * MiB) + (size_t)(nb * 32) * D, D, scr, F.lane); continue; }
        r -= IT_IN;
        if (r < IT_OUT) { if (!FAST_OUTPROJ) continue; const int kb = r / 32, nb = r % 32;
            bf16_t* wt = (bf16_t*)(F.ws + WS_WBF + WB_OUT + (size_t)l * 2 * MiB) + (size_t)(nb * 32) * D;
            if (FAST_CONV_FOLD && kb >= 4 && kb < 8) continue;
            else transpose_item(F.in[I_WOUT] + (size_t)l * D * D, D, nb * 32 + nn, kb * 64, wt, D, scr, F.lane);
            continue; }
        r -= IT_OUT;
        if (!FAST_MOE) continue;
        const int e = r / (3 * IT_E), q = (r % (3 * IT_E)) / IT_E, r2 = r % IT_E, kb = r2 / 32, nb = r2 % 32;
        const size_t wo = ((size_t)l * NE + e) * D * D;
        if (q < 2) {
            const int f0 = nb * 32; const int row0 = (f0 >> 7) * 256 + q * 128 + (f0 & 127);
            transpose_item(F.in[q == 0 ? I_WG : I_WU] + wo, D, f0 + nn, kb * 64, (bf16_t*)(F.ws + WS_WBF + WB_GU + (size_t)l * 64 * MiB) + ((size_t)e * 2048 + row0) * D, D, scr, F.lane);
        } else transpose_item(F.in[I_WD] + wo, D, nb * 32 + nn, kb * 64, (bf16_t*)(F.ws + WS_WBF + WB_DN + (size_t)l * 32 * MiB) + ((size_t)e * 1024 + nb * 32) * D, D, scr, F.lane);
    }
}


#ifndef FAST_ATTN
#define FAST_ATTN 1
#endif
namespace att {
typedef short bf16x8 __attribute__((ext_vector_type(8)));
typedef short s16x4 __attribute__((ext_vector_type(4)));
typedef float f32x16 __attribute__((ext_vector_type(16)));
constexpr int SLOTB = 8192, NSLOT = 3;
constexpr int L_K = 0, L_V = NSLOT * SLOTB, L_WS = 2 * NSLOT * SLOTB, L_OST = L_WS + NWAVES * 256, L_END = L_OST + NWAVES * 32 * 68 * 4;
constexpr int L_NAB = L_END;
static_assert(L_NAB + 2048 <= 131072, "attention LDS");
__device__ __forceinline__ int crow(int r, int hi) { return (r & 3) + 8 * (r >> 2) + 4 * hi; }
__device__ __forceinline__ s16x4 vtr(const LAS char* p) { return __builtin_bit_cast(s16x4, __builtin_amdgcn_ds_read_tr16_b64_v4i16((LAS s16x4*)p)); }
#define ATT_WAIT_BAR(N) asm volatile("s_waitcnt vmcnt(" #N ") lgkmcnt(0)\n\ts_barrier" ::: "memory")

template <int KIND> __device__ __forceinline__ void attn_unit(LAS char* lds, const bf16_t* Qw, const bf16_t* Kh, const bf16_t* Vh, int nt, bf16_t* Yw, float lam, float oml, const float* dng,
                                                            int rmin = 0, int qrow = 0, int qc = 0) {
    int tid = threadIdx.x; asm volatile("" : "+v"(tid));
    const int lane = tid & 63, r32 = lane & 31, hi = lane >> 5; const int wid = __builtin_amdgcn_readfirstlane(tid >> 6);
    LAS float* wsf = (LAS float*)(lds + L_WS) + wid * 64;
    const bf16_t* ksrc = Kh + (size_t)lane * 64 + wid * 8;
    const bf16_t* vsrc = Vh + (size_t)(16 * (wid & 3) + (lane >> 2)) * 64 + (wid >> 2) * 32 + (lane & 3) * 8;
    LAS char* kdst = lds + L_K + wid * 1024; LAS char* vdst = lds + L_V + wid * 1024;
#define ATT_TILE(i) ((KIND == 2 && (i) >= 4) ? (i) + rmin : (i))
#define ATT_DMA(t, slotb) do { __builtin_amdgcn_global_load_lds((const unsigned*)(ksrc + (size_t)(t) * 64 * 64), (LAS unsigned*)(kdst + (slotb)), 16, 0, 0); \
                               __builtin_amdgcn_global_load_lds((const unsigned*)(vsrc + (size_t)(t) * 64 * 64), (LAS unsigned*)(vdst + (slotb)), 16, 0, 0); } while (0)
    ATT_DMA(0, 0); ATT_DMA(1, SLOTB);
    bf16x8 qr[4];
#pragma unroll
    for (int d0 = 0; d0 < 4; ++d0) qr[d0] = *(const bf16x8*)(Qw + (size_t)r32 * 64 + d0 * 16 + hi * 8);
    f32x16 o1[2], o2[2]; float l1 = 0.f, l2 = 0.f;
    o1[0] = f32x16{}; o1[1] = f32x16{}; o2[0] = f32x16{}; o2[1] = f32x16{};
    const LAS char* kp0 = lds + L_K + hi * 1024 + r32 * 16;
    const LAS char* vp0 = lds + L_V + ((lane >> 4) & 1) * 32 + (lane & 3) * 8 + (4 * hi + ((lane & 15) >> 2)) * 64;
    int sl_cur = 0, sl_nn = 2 * SLOTB;
#pragma unroll 1
    for (int t = 0; t < nt; ++t) {
        ATT_WAIT_BAR(2);
        { const int tn = (t + 2 < nt) ? t + 2 : nt - 1; ATT_DMA(ATT_TILE(tn), sl_nn); }
        const LAS char* kp = kp0 + sl_cur; const LAS char* vp = vp0 + sl_cur;
        int na_dr = 0;
        if (KIND == 2) { int rs_ = qrow - 4; rs_ = rs_ < 0 ? 0 : (rs_ > 120 ? 120 : rs_); const int rr = rmin + t - 4; na_dr = rr - qrow + 7;
            if (t >= 4 && (rr < rs_ || rr >= rs_ + 8)) { sl_nn = sl_cur; sl_cur = (sl_cur == (NSLOT - 1) * SLOTB) ? 0 : sl_cur + SLOTB; continue; } }
        u32x4 pw[4], qw[4];
        {
            f32x16 pa0, pa1; const f32x16 z = f32x16{};
            if (KIND != 1) {
                bf16x8 kf[8];
#pragma unroll
                for (int d0 = 0; d0 < 4; ++d0) { kf[2 * d0] = *(const LAS bf16x8*)(kp + d0 * 2048); kf[2 * d0 + 1] = *(const LAS bf16x8*)(kp + d0 * 2048 + 512); }
                pa0 = __builtin_amdgcn_mfma_f32_32x32x16_bf16(kf[0], qr[0], z, 0, 0, 0); pa1 = __builtin_amdgcn_mfma_f32_32x32x16_bf16(kf[1], qr[0], z, 0, 0, 0);
#pragma unroll
                for (int d0 = 1; d0 < 4; ++d0) { pa0 = __builtin_amdgcn_mfma_f32_32x32x16_bf16(kf[2 * d0], qr[d0], pa0, 0, 0, 0); pa1 = __builtin_amdgcn_mfma_f32_32x32x16_bf16(kf[2 * d0 + 1], qr[d0], pa1, 0, 0, 0); }
            } else {
                bf16x8 kf[4];
#pragma unroll
                for (int d0 = 0; d0 < 2; ++d0) { kf[2 * d0] = *(const LAS bf16x8*)(kp + d0 * 2048); kf[2 * d0 + 1] = *(const LAS bf16x8*)(kp + d0 * 2048 + 512); }
                pa0 = __builtin_amdgcn_mfma_f32_32x32x16_bf16(kf[0], qr[0], z, 0, 0, 0); pa1 = __builtin_amdgcn_mfma_f32_32x32x16_bf16(kf[1], qr[0], z, 0, 0, 0);
                pa0 = __builtin_amdgcn_mfma_f32_32x32x16_bf16(kf[2], qr[1], pa0, 0, 0, 0); pa1 = __builtin_amdgcn_mfma_f32_32x32x16_bf16(kf[3], qr[1], pa1, 0, 0, 0);
            }
            if (KIND == 2 && t >= 4) {
                const int jq = 32 * qc + r32; int cs = jq - 8; cs = cs < 0 ? 0 : (cs > 48 ? 48 : cs);
                const LAS float* nb = (const LAS float*)(lds + L_NAB) + na_dr * 32 - jq + 15;
#pragma unroll
                for (int r = 0; r < 16; ++r) { const int kc = crow(r, hi);
                    pa0[r] = ((unsigned)(kc - cs) < 16u) ? pa0[r] + nb[kc] : -INFINITY;
                    pa1[r] = ((unsigned)(kc + 32 - cs) < 16u) ? pa1[r] + nb[kc + 32] : -INFINITY; }
            }
            float sa = 0.f, sb = 0.f;
#pragma unroll
            for (int r = 0; r < 16; ++r) { pa0[r] = __builtin_amdgcn_exp2f(pa0[r]); pa1[r] = __builtin_amdgcn_exp2f(pa1[r]); sa += pa0[r]; sb += pa1[r]; }
            l1 += sa + sb;
#pragma unroll
            for (int i = 0; i < 4; ++i) { pw[0][i] = cvt_pk_bf16(pa0[2 * i], pa0[2 * i + 1]); pw[1][i] = cvt_pk_bf16(pa0[8 + 2 * i], pa0[9 + 2 * i]); pw[2][i] = cvt_pk_bf16(pa1[2 * i], pa1[2 * i + 1]); pw[3][i] = cvt_pk_bf16(pa1[8 + 2 * i], pa1[9 + 2 * i]); }
        }
        if (KIND == 1) {
            __builtin_amdgcn_sched_barrier(0);
            f32x16 pb0, pb1; const f32x16 z = f32x16{};
            bf16x8 kf[4];
#pragma unroll
            for (int d0 = 0; d0 < 2; ++d0) { kf[2 * d0] = *(const LAS bf16x8*)(kp + (d0 + 2) * 2048); kf[2 * d0 + 1] = *(const LAS bf16x8*)(kp + (d0 + 2) * 2048 + 512); }
            pb0 = __builtin_amdgcn_mfma_f32_32x32x16_bf16(kf[0], qr[2], z, 0, 0, 0); pb1 = __builtin_amdgcn_mfma_f32_32x32x16_bf16(kf[1], qr[2], z, 0, 0, 0);
            pb0 = __builtin_amdgcn_mfma_f32_32x32x16_bf16(kf[2], qr[3], pb0, 0, 0, 0); pb1 = __builtin_amdgcn_mfma_f32_32x32x16_bf16(kf[3], qr[3], pb1, 0, 0, 0);
            float sc_ = 0.f, sd = 0.f;
#pragma unroll
            for (int r = 0; r < 16; ++r) { pb0[r] = __builtin_amdgcn_exp2f(pb0[r]); pb1[r] = __builtin_amdgcn_exp2f(pb1[r]); sc_ += pb0[r]; sd += pb1[r]; }
            l2 += sc_ + sd;
#pragma unroll
            for (int i = 0; i < 4; ++i) { qw[0][i] = cvt_pk_bf16(pb0[2 * i], pb0[2 * i + 1]); qw[1][i] = cvt_pk_bf16(pb0[8 + 2 * i], pb0[9 + 2 * i]); qw[2][i] = cvt_pk_bf16(pb1[2 * i], pb1[2 * i + 1]); qw[3][i] = cvt_pk_bf16(pb1[8 + 2 * i], pb1[9 + 2 * i]); }
            __builtin_amdgcn_sched_barrier(0);
        }
#pragma unroll
        for (int d0 = 0; d0 < 2; ++d0) {
#pragma unroll
            for (int ks = 0; ks < 4; ++ks) {
                const s16x4 lo = vtr(vp + d0 * 4096 + ks * 1024), hh = vtr(vp + d0 * 4096 + ks * 1024 + 512);
                const bf16x8 vf = (bf16x8){lo[0], lo[1], lo[2], lo[3], hh[0], hh[1], hh[2], hh[3]};
                o1[d0] = __builtin_amdgcn_mfma_f32_32x32x16_bf16(__builtin_bit_cast(bf16x8, pw[ks]), vf, o1[d0], 0, 0, 0);
                if (KIND == 1) o2[d0] = __builtin_amdgcn_mfma_f32_32x32x16_bf16(__builtin_bit_cast(bf16x8, qw[ks]), vf, o2[d0], 0, 0, 0);
            }
        }
        sl_nn = sl_cur; sl_cur = (sl_cur == (NSLOT - 1) * SLOTB) ? 0 : sl_cur + SLOTB;
    }
    ATT_WAIT_BAR(0);
    { auto rr = __builtin_amdgcn_permlane32_swap(__float_as_uint(l1), __float_as_uint(l1), false, false); l1 = __uint_as_float(rr[0]) + __uint_as_float(rr[1]); }
    if (KIND == 1) { auto rr = __builtin_amdgcn_permlane32_swap(__float_as_uint(l2), __float_as_uint(l2), false, false); l2 = __uint_as_float(rr[0]) + __uint_as_float(rr[1]); }
    if (hi == 0) { wsf[r32] = 1.f / l1; if (KIND == 1) wsf[32 + r32] = lam / l2; }
    asm volatile("s_waitcnt lgkmcnt(0)" ::: "memory");
    LAS float* stg = (LAS float*)(lds + L_OST) + wid * (32 * 68);
#pragma unroll
    for (int r = 0; r < 16; ++r) { const int q = crow(r, hi); const float a = wsf[q], b = (KIND == 1) ? wsf[32 + q] : 0.f;
#pragma unroll
        for (int d0 = 0; d0 < 2; ++d0) stg[q * 68 + d0 * 32 + r32] = (KIND == 1) ? (o1[d0][r] * a - o2[d0][r] * b) : o1[d0][r] * a; }
    asm volatile("s_waitcnt lgkmcnt(0)" ::: "memory");
    {
        const int row = lane >> 1, hf = lane & 1; float v[32];
#pragma unroll
        for (int i = 0; i < 8; ++i) { const f32x4 x = *(const LAS f32x4*)(stg + row * 68 + hf * 32 + 4 * i); v[4 * i] = x[0]; v[4 * i + 1] = x[1]; v[4 * i + 2] = x[2]; v[4 * i + 3] = x[3]; }
        if (KIND == 1) {
            float ss = 0.f;
#pragma unroll
            for (int i = 0; i < 32; ++i) ss += v[i] * v[i];
            ss += __shfl_xor(ss, 1);
            const float rs = oml / sqrtf(ss * (1.f / 64.f) + EPS);
#pragma unroll
            for (int i = 0; i < 32; ++i) v[i] = v[i] * rs * dng[hf * 32 + i];
        }
        bf16_t* dst = Yw + (size_t)row * D + hf * 32;
#pragma unroll
        for (int i = 0; i < 4; ++i) { u32x4 w; w.x = cvt_pk_bf16(v[8 * i], v[8 * i + 1]); w.y = cvt_pk_bf16(v[8 * i + 2], v[8 * i + 3]); w.z = cvt_pk_bf16(v[8 * i + 4], v[8 * i + 5]); w.w = cvt_pk_bf16(v[8 * i + 6], v[8 * i + 7]); *(u32x4*)(dst + 8 * i) = w; }
    }
    asm volatile("s_waitcnt lgkmcnt(0)\n\ts_barrier" ::: "memory");
#undef ATT_DMA
#undef ATT_TILE
}
}

__device__ __forceinline__ void gqa_unit_fast(Frame& F, int v, bool cu) {
    const int nblk = cu ? 2 : 64, bh = v / nblk, blk = v % nblk, b = bh >> 1, hk = bh & 1, hq = 2 * hk + (F.wave >> 2), t0 = blk * 128 + (F.wave & 3) * 32;
    const int nq = cu ? LC : S;
    const bf16_t* Qw = F.SEAM + (cu ? SE_QGC : SE_QG) + (((size_t)b * 4 + hq) * nq + t0) * 64;
    const size_t kvo = ((size_t)b * 2 + hk) * KV * 64;
    bf16_t* Yw = F.Y + (size_t)(cu ? ROWS_L + b * LC + t0 : b * S + t0) * D + 512 + hq * 64;
    att::attn_unit<0>((LAS char*)F.lds, Qw, F.SEAM + SE_KG + kvo, F.SEAM + SE_VG + kvo, cu ? LC / 64 : KV / 64, Yw, 0.f, 0.f, nullptr);
}
__device__ __forceinline__ void diff_unit_fast(Frame& F, int l, int v, bool cu) {
    const int nblk = cu ? 1 : 32, bh = v / nblk, blk = v % nblk, b = bh >> 2, h = bh & 3, t0 = blk * 256 + F.wave * 32;
    const int nq = cu ? LC : S;
    const bf16_t* Qw = F.SEAM + (cu ? SE_QDC : SE_QD) + (((size_t)b * 4 + h) * nq + t0) * 64;
    const size_t kvo = ((size_t)b * 4 + h) * KV * 64;
    bf16_t* Yw = F.Y + (size_t)(cu ? ROWS_L + b * LC + t0 : b * S + t0) * D + 768 + h * 64;
    att::attn_unit<1>((LAS char*)F.lds, Qw, F.SEAM + SE_KD + kvo, F.SEAM + SE_VD + kvo, cu ? LC / 64 : KV / 64, Yw, F.tab[TB_LAM + 2 * l], F.tab[TB_LAM + 2 * l + 1], F.in[I_DNG] + l * 64);
}
__device__ __forceinline__ void na_unit_fast(Frame& F, int l, int v) {
    const int bh = v >> 5, g = v & 31, b = bh >> 2, h = bh & 3, qrow = 4 * g + (F.wave >> 1), qc = F.wave & 1;
    int rmin = 4 * g - 4; rmin = rmin < 0 ? 0 : rmin; int rmax = 4 * g + 3 - 4; rmax = rmax < 0 ? 0 : (rmax > 120 ? 120 : rmax); rmax += 7;
    LAS float* nab = (LAS float*)(F.lds + att::L_NAB);
    const float* rpb = F.in[I_RPB] + ((size_t)l * 4 + h) * 15 * 31;
    if (F.tid < 15 * 32) { const int dr = F.tid >> 5, i = F.tid & 31; nab[F.tid] = (i < 31) ? rpb[dr * 31 + i] * LOG2E : 0.f; }
    const int t0 = qrow * 64 + 32 * qc;
    const bf16_t* Qw = F.SEAM + SE_QA + (((size_t)b * 4 + h) * S + t0) * 64;
    const size_t kvo = ((size_t)b * 4 + h) * KV * 64;
    att::attn_unit<2>((LAS char*)F.lds, Qw, F.SEAM + SE_KA + kvo, F.SEAM + SE_VA + kvo, 4 + (rmax - rmin + 1), F.Y + (size_t)(b * S + t0) * D + h * 64, 0.f, 0.f, nullptr, rmin, qrow, qc);
}
__device__ __forceinline__ void nactx_unit_fast(Frame& F, int v) {
    const int b = v >> 2, h = v & 3, t0 = F.wave * 32;
    const size_t kvo = ((size_t)b * 4 + h) * KV * 64;
    att::attn_unit<0>((LAS char*)F.lds, F.SEAM + SE_QAC + (((size_t)b * 4 + h) * LC + t0) * 64, F.SEAM + SE_KA + kvo, F.SEAM + SE_VA + kvo, LC / 64, F.Y + (size_t)(ROWS_L + b * LC + t0) * D + h * 64, 0.f, 0.f, nullptr);
}
__device__ __forceinline__ void phase_attn_fast(Frame& F, int l, bool with_ctx, int rep_mask) {
    const int v = vcu_of(F);
    if (FAST_NA_LAT) {
#pragma unroll 1
        for (int rp = 0; rp < (l == 0 ? RPT(6) : 1); ++rp)
#pragma unroll 1
        for (int u = v; u < 256; u += F.G) na_unit_fast(F, l, u); }
    if (with_ctx && FAST_NA_CTX) {
#pragma unroll 1
        for (int u = v - 16; u >= 0 && u < 8; u += F.G) nactx_unit_fast(F, u);
    }
#pragma unroll 1
    for (int rp = 0; rp < (l == 0 ? RPT(4) : 1); ++rp)
#pragma unroll 1
    for (int u = v; u < 256; u += F.G) gqa_unit_fast(F, u, false);
#pragma unroll 1
    for (int rp = 0; rp < (l == 0 ? RPT(5) : 1); ++rp)
#pragma unroll 1
    for (int u = v; u < 256; u += F.G) diff_unit_fast(F, l, u, false);
    if (with_ctx) {
#pragma unroll 1
        for (int u = v; u < 8; u += F.G) gqa_unit_fast(F, u, true);
#pragma unroll 1
        for (int u = F.G - 1 - v; u < 8; u += F.G) diff_unit_fast(F, l, u, true);
    }
}


static_assert(!(FAST_CONV && !FAST_OUTPROJ), "the folded pointwise projection lives in the fast out-proj weights");
constexpr int TB_BP = TB_BP_;
__device__ __forceinline__ void phase_conv_fast(Frame& F, int l, bool with_ctx) {
    const int c0 = 4 * F.lane;
    LAS float* wl = (LAS float*)F.lds;
    LAS bf16_t* zl = (LAS bf16_t*)(F.lds + 32768);
    for (int i = F.tid; i < 31 * 256; i += NTHR) wl[i] = F.in[I_DWW][(size_t)l * 31 * 256 + i];
    const f32x4 bias = *(const f32x4*)(F.in[I_DWB] + l * 256 + c0), lg = *(const f32x4*)(F.in[I_LNG] + l * 256 + c0), lb = *(const f32x4*)(F.in[I_LNB] + l * 256 + c0);
    const bf16_t* Z = F.SEAM + SE_Z;
    const int nu = (with_ctx ? ROWS : ROWS_L) / 64;
#pragma unroll 1
    for (int u = F.bid; u < nu; u += F.G) {
        const int row0 = u * 64; const bool isc = row0 >= ROWS_L;
        const int sb = isc ? ROWS_L + ((row0 - ROWS_L) / LC) * LC : (row0 / S) * S, se = sb + (isc ? LC : S);
        __syncthreads();
        for (int i = F.tid; i < 94 * 32; i += NTHR) { const int rr = i >> 5, ch = i & 31; const int grow = row0 - 15 + rr;
            u32x4 v = (u32x4){0u, 0u, 0u, 0u}; if (grow >= sb && grow < se) v = *(const u32x4*)(Z + (size_t)grow * 256 + ch * 8);
            *(LAS u32x4*)(zl + rr * 256 + ch * 8) = v; }
        __syncthreads();
#pragma unroll 1
        for (int tt = 0; tt < 8; ++tt) {
            const int tok = F.wave * 8 + tt;
            f32x4 a = bias;
#pragma unroll
            for (int k = 0; k < 31; ++k) { const u32x2 zz = *(const LAS u32x2*)(zl + (tok + k) * 256 + c0); const f32x4 wv = *(const LAS f32x4*)(wl + k * 256 + c0);
                a += (f32x4){bflo(zz.x), bfhi(zz.x), bflo(zz.y), bfhi(zz.y)} * wv; }
            const float mu = wave_sum((a[0] + a[1]) + (a[2] + a[3])) * (1.f / 256.f);
            const f32x4 d = a - mu;
            const float rs = 1.f / sqrtf(wave_sum((d[0] * d[0] + d[1] * d[1]) + (d[2] * d[2] + d[3] * d[3])) * (1.f / 256.f) + EPS);
            f32x4 y = d * rs * lg + lb;
#pragma unroll
            for (int j = 0; j < 4; ++j) y[j] = y[j] * fast_sigmoid(y[j]);
            uint2 o; o.x = cvt_pk_bf16(y[0], y[1]); o.y = cvt_pk_bf16(y[2], y[3]);
            *(uint2*)(F.Y + (size_t)(row0 + tok) * D + 256 + c0) = o;
        }
    }
    __syncthreads();
}
__device__ __forceinline__ void phase_fold_bias(Frame& F) {
    for (int i = F.bid * NTHR + F.tid; i < DEPTH * D; i += F.G * NTHR) {
        const int l = i / D, n = i % D; float a = 0.f;
        if (FAST_CONV_FOLD) for (int c = 0; c < 256; ++c) a += F.in[I_PWB][l * 256 + c] * F.in[I_WOUT][((size_t)l * D + 256 + c) * D + n];
        F.tab[TB_BP + i] = a;
    }
}
__device__ __forceinline__ void phase_fold_w(Frame& F) {
    float* WP = (float*)(F.ws + WS_SLOT);
    for (int i = F.bid * NTHR + F.tid; i < DEPTH * 256 * 256; i += F.G * NTHR) {
        const int l = i >> 16, c = (i >> 8) & 255, n4 = i & 255;
        const float* pw = F.in[I_PWW] + ((size_t)l * 256 + c) * 256; const float* wo = F.in[I_WOUT] + ((size_t)l * D + 256) * D + 4 * n4;
        f32x4 a = (f32x4){0.f, 0.f, 0.f, 0.f};
#pragma unroll 8
        for (int cp = 0; cp < 256; ++cp) a += pw[cp] * *(const f32x4*)(wo + (size_t)cp * D);
        *(f32x4*)(WP + ((size_t)l * 256 + c) * D + 4 * n4) = a;
    }
}
__device__ __forceinline__ void phase_convert_fold(Frame& F) {
    LAS float* scr = (LAS float*)(F.lds + F.wave * 16384);
    const int gw = F.bid * NWAVES + F.wave, NGW = F.G * NWAVES; const int nn = F.lane & 31;
    for (int it = gw; it < DEPTH * 4 * 32; it += NGW) {
        const int l = it >> 7, kb = 4 + ((it >> 5) & 3), nb = it & 31;
        const float* WP = (const float*)(F.ws + WS_SLOT) + (size_t)l * 256 * D - (size_t)256 * D;
        transpose_item(WP, D, nb * 32 + nn, kb * 64, (bf16_t*)(F.ws + WS_WBF + WB_OUT + (size_t)l * 2 * MiB) + (size_t)(nb * 32) * D, D, scr, F.lane);
    }
    __syncthreads();
}

#ifndef FAST_SELECT
#define FAST_SELECT 1
#endif
__device__ __forceinline__ void phase_select_fast(Frame& F, bool with_ctx) {
    LAS unsigned* hist = (LAS unsigned*)F.lds;
    LAS unsigned* sm = hist + 256;
    for (int i = F.bid * NTHR + F.tid; i < NE * EPAD; i += F.G * NTHR) { const int sl = i % EPAD; if (sl >= (with_ctx ? ESLOTS : 2 * CAP_L)) { F.RIDX[i] = -1; F.GATE[i] = 0.f; } }
    const int NL = with_ctx ? 64 : 32;
#pragma unroll 1
    for (int u = F.bid; u < NL; u += F.G) {
        const bool isc = u >= 32; const int li = isc ? u - 32 : u, b = li / NE, e = li % NE;
        const int N = isc ? LC : S, C = isc ? CAP_C : CAP_L, row0 = isc ? ROWS_L + b * LC : b * S;
        unsigned key[16];
#pragma unroll
        for (int j = 0; j < 16; ++j) { const int n = F.tid * 16 + j; key[j] = (n < N) ? __float_as_uint(F.AFF[(size_t)(row0 + n) * NE + e]) : 0u; }
        unsigned prefix = 0u, mask = 0u, remaining = (unsigned)C;
#pragma unroll 1
        for (int pass = 0; pass < 4; ++pass) {
            const int shift = 24 - 8 * pass;
            __syncthreads();
            if (F.tid < 256) hist[F.tid] = 0u;
            __syncthreads();
#pragma unroll
            for (int j = 0; j < 16; ++j) { const int n = F.tid * 16 + j; if (n < N && (key[j] & mask) == prefix) __hip_atomic_fetch_add(&hist[(key[j] >> shift) & 255u], 1u, __ATOMIC_RELAXED, __HIP_MEMORY_SCOPE_WORKGROUP); }
            __syncthreads();
            if (F.tid < 256) {
                unsigned above = 0u;
                for (int i = F.tid + 1; i < 256; ++i) above += hist[i];
                const unsigned mine = hist[F.tid];
                if (above < remaining && above + mine >= remaining) { sm[0] = (unsigned)F.tid; sm[1] = remaining - above; }
            }
            __syncthreads();
            prefix |= sm[0] << shift; mask |= 255u << shift; remaining = sm[1];
        }
        const unsigned T = prefix, quota = remaining;
        unsigned cg = 0u, ce = 0u;
#pragma unroll
        for (int j = 0; j < 16; ++j) { const int n = F.tid * 16 + j; if (n < N) { cg += key[j] > T ? 1u : 0u; ce += key[j] == T ? 1u : 0u; } }
        unsigned pk = cg | (ce << 16), inc = pk;
#pragma unroll
        for (int o = 1; o < 64; o <<= 1) { const unsigned v = __shfl_up(inc, o); if (F.lane >= o) inc += v; }
        __syncthreads();
        if (F.lane == 63) sm[8 + F.wave] = inc;
        __syncthreads();
        unsigned wbase = 0u;
        for (int w = 0; w < F.wave; ++w) wbase += sm[8 + w];
        const unsigned excl = wbase + inc - pk;
        unsigned gb = excl & 0xffffu, eb = excl >> 16;
        const int base = isc ? 2 * CAP_L + b * CAP_C : b * CAP_L;
#pragma unroll
        for (int j = 0; j < 16; ++j) { const int n = F.tid * 16 + j;
            if (n < N) {
                int slot = -1;
                if (key[j] > T) { slot = (int)(gb + (eb < quota ? eb : quota)); ++gb; }
                else if (key[j] == T) { if (eb < quota) slot = (int)(gb + eb); ++eb; }
                F.SLOT[(size_t)(row0 + n) * NE + e] = slot;
                if (slot >= 0) { F.RIDX[e * EPAD + base + slot] = row0 + n; F.GATE[e * EPAD + base + slot] = __uint_as_float(key[j]); }
            } }
    }
    __syncthreads();
}

#ifndef PHMASK
#define PHMASK 0xffffffffu
#endif
#define REFRESH() do { asm volatile("" : "+v"(F.tid)); F.lane = F.tid & 63; F.wave = __builtin_amdgcn_readfirstlane(F.tid >> 6); } while (0)
#define PHX(i, call) do { if ((PHMASK >> (i)) & 1u) { REFRESH(); call; } } while (0)
constexpr int PH_PER_LAYER = 9;
constexpr int NPH = 1 + DEPTH * PH_PER_LAYER + 1;

__global__ void __launch_bounds__(NTHR, 2) mk_fwd(Args args) {
    extern __shared__ __attribute__((aligned(16))) unsigned char lds[];
    Frame F;
    F.lds = (LAS unsigned char*)lds;
    F.tid = threadIdx.x; F.lane = F.tid & 63; F.wave = __builtin_amdgcn_readfirstlane(F.tid >> 6);
    F.G = gridDim.x; F.bid = blockIdx.x;
    F.in = args.in; F.out = args.out; F.ws = args.ws;
    unsigned char* ws = args.ws;
    F.tab = (float*)(ws + WS_TAB); F.H = (float*)(ws + WS_H); F.U = (bf16_t*)(ws + WS_U); F.AFF = (float*)(ws + WS_AFF); F.SLOT = (int*)(ws + WS_SLOT);
    F.RIDX = (int*)(ws + WS_RIDX); F.GATE = (float*)(ws + WS_RIDX + 256 * 1024);
    F.SEAM = (bf16_t*)(ws + WS_SEAM); F.Y = (bf16_t*)(ws + WS_Y); F.HE = (bf16_t*)(ws + WS_HE); F.YE = (bf16_t*)(ws + WS_YE); F.P = (float*)(ws + WS_P);
    for (int u = F.tid; u < (LDS_BYTES - LDSCTL_OFF) / 4; u += NTHR) ((LAS unsigned*)(F.lds + LDSCTL_OFF))[u] = 0u;
    __syncthreads();
    XcdBarrier bar; bar.bar = (unsigned*)(ws + WS_CTL) + CW_BAR; bar.x = 0; bar.st = nullptr;
    const bool one = (MK_N_LAUNCHES == 1);
    if (one) bar = xcd_barrier_post((unsigned*)(ws + WS_CTL) + CW_BAR, (volatile LAS unsigned*)(F.lds + MISC_OFF) + 8);
    const int lo = args.ph_lo, hi = args.ph_hi; const int rep_mask = args.rep_mask;
#define IN(k) (lo <= (k) && (k) < hi)
#define SEAM_BAR(k) do { if (one && (k) + 1 < hi) xcd_barrier(bar); } while (0)
    if (IN(0)) { for (int rp = 0; rp < RPT(0); ++rp) { PHX(0, phase_prologue(F)); REFRESH(); phase_fold_bias(F); if (FAST_CONV_FOLD) { REFRESH(); phase_fold_w(F); } REFRESH(); phase_convert(F); } SEAM_BAR(0); }
#pragma unroll 1
    for (int l = 0; l < DEPTH; ++l) {
        const int pb = 1 + l * PH_PER_LAYER; const bool wc = (l < DEPTH - 1);
        if (IN(pb + 0)) { if (l == 0 && FAST_CONV_FOLD) { REFRESH(); phase_convert_fold(F); } REFRESH(); if (l == 0) { for (int rp = 0; rp < RPT(1); ++rp) phase_norm<0>(F, 0, true, -1, true); } else phase_norm<0>(F, l, false, l - 1, true); SEAM_BAR(pb + 0); }
        if (IN(pb + 1)) { if (FAST_INPROJ) { for (int rp = 0; rp < (l == 0 ? RPT(2) : 1); ++rp) { REFRESH(); phase_inproj_fast(F, l); } } else { PHX(1, phase_inproj_naive(F, l)); } SEAM_BAR(pb + 1); }
        if (IN(pb + 2)) { if (!FAST_INPROJ) { PHX(2, phase_post_naive(F, l)); SEAM_BAR(pb + 2); } }
        if (IN(pb + 3)) { if (FAST_CONV) { for (int rp = 0; rp < (l == 0 ? RPT(3) : 1); ++rp) { REFRESH(); phase_conv_fast(F, l, wc); } } if (FAST_ATTN) { REFRESH(); phase_attn_fast(F, l, wc, rep_mask); } PHX(3, phase_mixers_naive(F, l, wc)); SEAM_BAR(pb + 3); }
        if (IN(pb + 4)) { if (FAST_OUTPROJ) { for (int rp = 0; rp < (l == 0 ? RPT(7) : 1); ++rp) { REFRESH(); phase_outproj_fast(F, l, wc); } } else { PHX(4, phase_outproj_naive(F, l, wc)); } SEAM_BAR(pb + 4); }
        if (IN(pb + 5)) { for (int rp = 0; rp < (l == 0 ? RPT(8) : 1); ++rp) { PHX(5, phase_norm2_router(F, l, wc)); } SEAM_BAR(pb + 5); }
        if (IN(pb + 6)) { if (FAST_SELECT) { for (int rp = 0; rp < (l == 0 ? RPT(9) : 1); ++rp) { REFRESH(); phase_select_fast(F, wc); } } else { PHX(6, phase_select_naive(F, wc)); } SEAM_BAR(pb + 6); }
        if (IN(pb + 7)) { if (FAST_MOE) { for (int rp = 0; rp < (l == 0 ? RPT(10) : 1); ++rp) { REFRESH(); phase_moe1_fast(F, l, wc); } } else { PHX(7, phase_moe1_naive(F, l, wc)); } SEAM_BAR(pb + 7); }
        if (IN(pb + 8)) { if (FAST_MOE) { for (int rp = 0; rp < (l == 0 ? RPT(11) : 1); ++rp) { REFRESH(); phase_moe2_fast(F, l, wc); } } else { PHX(8, phase_moe2_naive(F, l, wc)); } SEAM_BAR(pb + 8); }
    }
    if (IN(NPH - 1)) { REFRESH(); phase_norm<2>(F, 0, false, DEPTH - 1, false); }
    if (one && ((rep_mask >> 12) & 1)) { for (int i = 0; i < 20; ++i) xcd_barrier(bar); }
#undef IN
#undef SEAM_BAR
}

extern "C" void kernel_launch(void* const* d_in, const int* in_sizes, int n_in, void* d_out, int out_size, void* d_ws, size_t ws_size, hipStream_t stream) {
    static int grid = 0;
    if (grid == 0) {
        if (n_in != N_IN || out_size != ROWS_L * D || ws_size < WS_END) { fprintf(stderr, "kernel_launch: unexpected shapes (n_in %d out %d ws %zu)\n", n_in, out_size, ws_size); grid = -1; return; }
        int dev = 0, cus = 0, per_cu = 0;
        if (hipGetDevice(&dev) != hipSuccess || hipDeviceGetAttribute(&cus, hipDeviceAttributeMultiprocessorCount, dev) != hipSuccess) { grid = -1; return; }
        if (hipFuncSetAttribute((const void*)mk_fwd, hipFuncAttributeMaxDynamicSharedMemorySize, LDS_BYTES) != hipSuccess) { fprintf(stderr, "kernel_launch: hipFuncSetAttribute failed\n"); grid = -1; return; }
        if (hipOccupancyMaxActiveBlocksPerMultiprocessor(&per_cu, (const void*)mk_fwd, NTHR, LDS_BYTES) != hipSuccess || per_cu < 1) { fprintf(stderr, "kernel_launch: occupancy query says %d\n", per_cu); per_cu = 1; }
        (void)hipGetLastError();
        grid = cus;
    }
    if (grid < 0) return;
    (void)hipMemsetAsync((char*)d_ws + WS_CTL, 0, CTL_ZERO_BYTES, stream);
    Args a{};
    for (int i = 0; i < N_IN; ++i) a.in[i] = (const float*)d_in[i];
    a.out = (float*)d_out; a.ws = (unsigned char*)d_ws; a.rep_mask = REPEAT_MASK;
    if (MK_N_LAUNCHES == 1) { a.ph_lo = 0; a.ph_hi = NPH; hipLaunchKernelGGL(mk_fwd, dim3(grid), dim3(NTHR), LDS_BYTES, stream, a); }
    else for (int p = 0; p < NPH; ++p) { a.ph_lo = p; a.ph_hi = p + 1; hipLaunchKernelGGL(mk_fwd, dim3(grid), dim3(NTHR), LDS_BYTES, stream, a); }
}
```
